# Optimizing an MI355X kernel written in HIP

```python
import math
import jax, jax.numpy as jnp
from jax import lax
import numpy as np

D_MODEL = 1024
BATCH = 4
SEQ = 4096
DEPTH = 4

D_MIX = D_MODEL
MIX_CHUNK = 128
SPATIAL_CHUNK = 128
M_WIDTH = 3 * D_MODEL // 8
M_HEADS = 4
M_HEAD_DIM = M_WIDTH // M_HEADS
M_CONV = 4
M_BLOCK = 4
M_NBLOCKS = M_WIDTH // M_BLOCK
R_WIDTH = 3 * D_MODEL // 8
R_HEADS = 6
R_HEAD_DIM = R_WIDTH // R_HEADS
ROPE_THETA = 10000.0
G_WIDTH = D_MIX - M_WIDTH - R_WIDTH
G_GROUPS = 4
G_GROUP_DIM = G_WIDTH // G_GROUPS
D_FF = 4 * D_MODEL
EPS = 1e-6
IN_SIZES = (M_WIDTH, M_WIDTH, M_HEADS, M_HEADS, R_WIDTH, R_WIDTH, R_WIDTH, R_WIDTH, G_WIDTH, G_WIDTH)
N_IN = 2 * M_WIDTH + 2 * M_HEADS + 4 * R_WIDTH + 2 * G_WIDTH

kernel_name = "hybrid_mlstm_retention_gmlp_trunk"


def rmsnorm(x, g):
    xf = x.astype(jnp.float32)
    y = xf * lax.rsqrt(jnp.mean(jnp.square(xf), axis=-1, keepdims=True) + EPS)
    return (y * g.astype(jnp.float32)).astype(x.dtype)


def causal_depthwise_conv(x, w, b):
    k_w = w.shape[0]
    s = x.shape[1]
    xp = jnp.pad(x, ((0, 0), (k_w - 1, 0), (0, 0)))
    return sum(xp[:, j:j + s] * w[j] for j in range(k_w)) + b


def rotary(x):
    s, d = x.shape[1], x.shape[3]
    half = d // 2
    pos = jnp.arange(s, dtype=jnp.float32)
    freqs = ROPE_THETA ** (-jnp.arange(half, dtype=jnp.float32) / half)
    ang = pos[:, None] * freqs[None, :]
    cos = jnp.cos(ang)[None, :, None, :]
    sin = jnp.sin(ang)[None, :, None, :]
    xf = x.astype(jnp.float32)
    x1, x2 = xf[..., :half], xf[..., half:]
    return jnp.concatenate([x1 * cos - x2 * sin, x2 * cos + x1 * sin], axis=-1)


def to_chunks(x, chunk):
    b, s = x.shape[0], x.shape[1]
    xc = x.astype(jnp.float32).reshape((b, s // chunk, chunk) + x.shape[2:])
    perm = (0, 3, 1, 2) + tuple(range(4, xc.ndim))
    return xc.transpose(perm)


def from_chunks(x):
    b, h, nc, l, d = x.shape
    return x.transpose(0, 2, 3, 1, 4).reshape(b, nc * l, h, d)


def mlstm_chunkwise(q, k, v, i_pre, f_pre):
    d = q.shape[-1]
    l = MIX_CHUNK
    qc = to_chunks(q, l)
    kc = to_chunks(k, l) * (d ** -0.5)
    vc = to_chunks(v, l)
    ig = to_chunks(i_pre, l)
    logf = jax.nn.log_sigmoid(to_chunks(f_pre, l))
    bcum = jnp.cumsum(logf, axis=-1)
    b_end = bcum[..., -1]
    causal = jnp.tril(jnp.ones((l, l), dtype=bool))
    dmat = jnp.where(causal, bcum[..., :, None] - bcum[..., None, :] + ig[..., None, :], -jnp.inf)
    w_end = b_end[..., None] - bcum + ig
    a_c = jnp.max(w_end, axis=-1)
    e_end = jnp.exp(w_end - a_c[..., None])
    c_chunk = jnp.einsum('bhcl,bhcld,bhcle->bhcde', e_end, kc, vc)
    n_chunk = jnp.einsum('bhcl,bhcld->bhcd', e_end, kc)

    def step(carry, inp):
        c_st, n_st, m_st = carry
        be, ac, cc, nc = inp
        m_new = jnp.maximum(be + m_st, ac)
        s_old = jnp.exp(be + m_st - m_new)
        s_new = jnp.exp(ac - m_new)
        c_new = s_old[..., None, None] * c_st + s_new[..., None, None] * cc
        n_new = s_old[..., None] * n_st + s_new[..., None] * nc
        return (c_new, n_new, m_new), (c_st, n_st, m_st)

    bsz, h = qc.shape[0], qc.shape[1]
    init = (jnp.zeros((bsz, h, d, d), jnp.float32), jnp.zeros((bsz, h, d), jnp.float32),
            jnp.zeros((bsz, h), jnp.float32))
    xs = (jnp.moveaxis(b_end, 2, 0), jnp.moveaxis(a_c, 2, 0),
          jnp.moveaxis(c_chunk, 2, 0), jnp.moveaxis(n_chunk, 2, 0))
    _, (c_prev, n_prev, m_prev) = lax.scan(step, init, xs)
    c_prev = jnp.moveaxis(c_prev, 0, 2)
    n_prev = jnp.moveaxis(n_prev, 0, 2)
    m_prev = jnp.moveaxis(m_prev, 0, 2)

    inter_log = bcum + m_prev[..., None]
    m_t = jnp.maximum(inter_log, jnp.max(dmat, axis=-1))
    s_inter = jnp.exp(inter_log - m_t)
    wts = jnp.exp(dmat - m_t[..., None])
    scores = jnp.einsum('bhcld,bhcsd->bhcls', qc, kc) * wts
    num = (jnp.einsum('bhcls,bhcse->bhcle', scores, vc)
           + s_inter[..., None] * jnp.einsum('bhcld,bhcde->bhcle', qc, c_prev))
    den = jnp.sum(scores, axis=-1) + s_inter * jnp.einsum('bhcld,bhcd->bhcl', qc, n_prev)
    hout = num / jnp.maximum(jnp.abs(den), jnp.exp(-m_t))[..., None]
    return from_chunks(hout)


def retention_chunkwise(q, k, v):
    h, d = q.shape[2], q.shape[3]
    l = MIX_CHUNK
    qc = to_chunks(q, l)
    kc = to_chunks(k, l) * (d ** -0.5)
    vc = to_chunks(v, l)
    log_gamma = jnp.log(1.0 - 2.0 ** (-5.0 - jnp.arange(h, dtype=jnp.float32)))
    pos = jnp.arange(l, dtype=jnp.float32)
    causal = jnp.tril(jnp.ones((l, l), dtype=bool))
    rel = jnp.where(causal, pos[:, None] - pos[None, :], 0.0)
    decay = jnp.where(causal, jnp.exp(rel[None] * log_gamma[:, None, None]), 0.0)
    scores = jnp.einsum('bhcld,bhcsd->bhcls', qc, kc) * decay[None, :, None]
    intra = jnp.einsum('bhcls,bhcse->bhcle', scores, vc)
    zeta = jnp.exp((l - 1.0 - pos)[None, :] * log_gamma[:, None])
    kv_chunk = jnp.einsum('bhcld,bhcle,hl->bhcde', kc, vc, zeta)
    chunk_decay = jnp.exp(l * log_gamma)[None, :, None, None]

    def step(r_st, kv):
        return chunk_decay * r_st + kv, r_st

    bsz = qc.shape[0]
    _, r_prev = lax.scan(step, jnp.zeros((bsz, h, d, d), jnp.float32), jnp.moveaxis(kv_chunk, 2, 0))
    r_prev = jnp.moveaxis(r_prev, 0, 2)
    xi = jnp.exp((pos + 1.0)[None, :] * log_gamma[:, None])
    cross = jnp.einsum('bhcld,bhcde->bhcle', qc, r_prev) * xi[None, :, None, :, None]
    return from_chunks(intra + cross)


def chunked_spatial_gating(u, v, w_s, b_s):
    bsz, s, g, e = v.shape
    l = SPATIAL_CHUNK
    causal = jnp.tril(jnp.ones((l, l), dtype=bool))
    w = jnp.where(causal[None], w_s, 0.0).astype(v.dtype)
    vc = v.reshape(bsz, s // l, l, g, e)
    mixed = jnp.einsum('gts,bcsge->bctge', w, vc) + b_s.T.astype(v.dtype)[None, None, :, :, None]
    return u * mixed.reshape(bsz, s, g, e)


def hybrid_mixer(h, w_in, m_conv_w, m_conv_b, m_wq, m_wk, m_wv, m_i_bias, m_f_bias, m_norm_g,
                 m_skip, r_norm_g, g_norm_g, g_ws, g_bs, w_out):
    bsz, s, _ = h.shape
    dt = h.dtype
    proj = h @ w_in
    split_at = list(np.cumsum(IN_SIZES)[:-1])
    m_x, m_z, m_i, m_f, r_q, r_k, r_v, r_g, g_u, g_v = jnp.split(proj, split_at, axis=-1)

    x_c = jax.nn.silu(causal_depthwise_conv(m_x, m_conv_w, m_conv_b))
    xc_b = x_c.reshape(bsz, s, M_NBLOCKS, M_BLOCK)
    xm_b = m_x.reshape(bsz, s, M_NBLOCKS, M_BLOCK)
    q = jnp.einsum('bsni,nij->bsnj', xc_b, m_wq).reshape(bsz, s, M_HEADS, M_HEAD_DIM)
    k = jnp.einsum('bsni,nij->bsnj', xc_b, m_wk).reshape(bsz, s, M_HEADS, M_HEAD_DIM)
    v = jnp.einsum('bsni,nij->bsnj', xm_b, m_wv).reshape(bsz, s, M_HEADS, M_HEAD_DIM)
    hm = mlstm_chunkwise(q, k, v, m_i + m_i_bias, m_f + m_f_bias)
    hm = rmsnorm(hm, m_norm_g.reshape(M_HEADS, M_HEAD_DIM)).reshape(bsz, s, M_WIDTH).astype(dt)
    out_m = (hm + m_skip * x_c) * jax.nn.silu(m_z)

    rq = rotary(r_q.reshape(bsz, s, R_HEADS, R_HEAD_DIM))
    rk = rotary(r_k.reshape(bsz, s, R_HEADS, R_HEAD_DIM))
    hr = retention_chunkwise(rq, rk, r_v.reshape(bsz, s, R_HEADS, R_HEAD_DIM))
    hr = rmsnorm(hr, r_norm_g.reshape(R_HEADS, R_HEAD_DIM)).reshape(bsz, s, R_WIDTH).astype(dt)
    out_r = hr * jax.nn.silu(r_g)

    gu = jax.nn.gelu(g_u)
    gv = rmsnorm(jax.nn.gelu(g_v), g_norm_g)
    out_g = chunked_spatial_gating(gu.reshape(bsz, s, G_GROUPS, G_GROUP_DIM),
                                   gv.reshape(bsz, s, G_GROUPS, G_GROUP_DIM),
                                   g_ws, g_bs).reshape(bsz, s, G_WIDTH)

    return jnp.concatenate([out_m, out_r, out_g], axis=-1) @ w_out


def setup_inputs(seed: int = 0) -> dict:
    key = jax.random.key(seed)
    ks = jax.random.split(key, 24)
    f32 = jnp.float32

    def nrm(k, shape, scale):
        return jax.random.normal(k, shape, f32) * scale

    def gain(k, shape):
        return 1.0 + 0.05 * jax.random.normal(k, shape, f32)

    x = jax.random.normal(ks[0], (BATCH, SEQ, D_MODEL), f32)
    norm_mix_g = gain(ks[1], (DEPTH, D_MODEL))
    w_in = nrm(ks[2], (DEPTH, D_MODEL, N_IN), D_MODEL ** -0.5)
    m_conv_w = nrm(ks[3], (DEPTH, M_CONV, M_WIDTH), M_CONV ** -0.5)
    m_conv_b = nrm(ks[4], (DEPTH, M_WIDTH), 0.02)
    m_wq = nrm(ks[5], (DEPTH, M_NBLOCKS, M_BLOCK, M_BLOCK), M_BLOCK ** -0.5)
    m_wk = nrm(ks[6], (DEPTH, M_NBLOCKS, M_BLOCK, M_BLOCK), M_BLOCK ** -0.5)
    m_wv = nrm(ks[7], (DEPTH, M_NBLOCKS, M_BLOCK, M_BLOCK), M_BLOCK ** -0.5)
    m_i_bias = nrm(ks[8], (DEPTH, M_HEADS), 0.1)
    m_f_bias = (jnp.linspace(3.0, 6.0, M_HEADS, dtype=f32)[None, :]
                + nrm(ks[9], (DEPTH, M_HEADS), 0.1))
    m_norm_g = gain(ks[10], (DEPTH, M_WIDTH))
    m_skip = gain(ks[11], (DEPTH, M_WIDTH))
    r_norm_g = gain(ks[12], (DEPTH, R_WIDTH))
    g_norm_g = gain(ks[13], (DEPTH, G_WIDTH))
    g_ws = nrm(ks[14], (DEPTH, G_GROUPS, SPATIAL_CHUNK, SPATIAL_CHUNK), SPATIAL_CHUNK ** -0.5)
    g_bs = gain(ks[15], (DEPTH, G_GROUPS, SPATIAL_CHUNK))
    w_out = nrm(ks[16], (DEPTH, D_MIX, D_MODEL), D_MIX ** -0.5)
    norm_ff_g = gain(ks[17], (DEPTH, D_MODEL))
    w_ff1 = nrm(ks[18], (DEPTH, D_MODEL, D_FF), D_MODEL ** -0.5)
    w_ff2 = nrm(ks[19], (DEPTH, D_FF, D_MODEL), D_FF ** -0.5)
    final_norm_g = gain(ks[20], (D_MODEL,))
    return {"x": x, "norm_mix_g": norm_mix_g, "w_in": w_in, "m_conv_w": m_conv_w,
            "m_conv_b": m_conv_b, "m_wq": m_wq, "m_wk": m_wk, "m_wv": m_wv,
            "m_i_bias": m_i_bias, "m_f_bias": m_f_bias, "m_norm_g": m_norm_g,
            "m_skip": m_skip, "r_norm_g": r_norm_g, "g_norm_g": g_norm_g,
            "g_ws": g_ws, "g_bs": g_bs, "w_out": w_out, "norm_ff_g": norm_ff_g,
            "w_ff1": w_ff1, "w_ff2": w_ff2, "final_norm_g": final_norm_g}


def reference(x, norm_mix_g, w_in, m_conv_w, m_conv_b, m_wq, m_wk, m_wv, m_i_bias, m_f_bias,
              m_norm_g, m_skip, r_norm_g, g_norm_g, g_ws, g_bs, w_out, norm_ff_g, w_ff1, w_ff2,
              final_norm_g):
    for layer in range(DEPTH):
        h = rmsnorm(x, norm_mix_g[layer])
        x = x + hybrid_mixer(h, w_in[layer], m_conv_w[layer], m_conv_b[layer], m_wq[layer],
                             m_wk[layer], m_wv[layer], m_i_bias[layer], m_f_bias[layer],
                             m_norm_g[layer], m_skip[layer], r_norm_g[layer], g_norm_g[layer],
                             g_ws[layer], g_bs[layer], w_out[layer])
        h2 = rmsnorm(x, norm_ff_g[layer])
        x = x + jnp.square(jax.nn.relu(h2 @ w_ff1[layer])) @ w_ff2[layer]
    return rmsnorm(x, final_norm_g)
```

```cpp
#define EPI_BATCH 1
#include <hip/hip_runtime.h>
#include <hip/hip_cooperative_groups.h>
#include <cstdio>
#include <cstdint>
namespace cg = cooperative_groups;
namespace pg8 {
#define PG8_LAS __attribute__((address_space(3)))
typedef unsigned short bf16_t;
typedef short bf16x8 __attribute__((ext_vector_type(8)));
typedef float f32x4 __attribute__((ext_vector_type(4)));
typedef unsigned u32x4 __attribute__((ext_vector_type(4)));
constexpr int BM = 256, BK = 64, HALF = 128, HTB = HALF * BK * 2  , STAGE_BYTES = 8 * HTB, NXCD = 8, WGM = 8;

__host__ __device__ __forceinline__ int lds_byte(int r, int c) { const int st = (r >> 4) * 2 + (c >> 5), rr = r & 15, cc = c & 31, ob = rr * 64 + cc * 2; return st * 1024 + (ob ^ (((ob >> 9) & 1) << 5)); }
__host__ __device__ __forceinline__ void stage_rc(int b, int& R, int& C) { const int st = b / 1024, sb = b % 1024, swz = sb ^ (((sb >> 9) & 1) << 5); R = (st >> 1) * 16 + swz / 64; C = (st & 1) * 32 + (swz % 64) / 2; }
__host__ __device__ __forceinline__ int perm32(int rho) { const int n = rho >> 4, i = rho & 15; return 8 * (i >> 2) + 4 * n + (i & 3); }

struct Unit { int pm, pn; };
struct Gemm { const bf16_t* A; const bf16_t* Bt; int M, N, K; };

struct StaticOrder {
    int nM, nN, nwg, G, c;
    __host__ __device__ void init(int M, int N, int G_, int c_) { nM = M / BM; nN = N / BM; nwg = nM * nN; G = G_; c = c_; }
    __host__ __device__ bool next(int i, Unit& u) const {
        const long L = (long)i * G + c; if (L >= nwg) return false;
        int wgid = (int)L; { const int q = nwg / NXCD, r = nwg % NXCD, xcd = wgid % NXCD, off = wgid / NXCD; wgid = (xcd < r ? xcd * (q + 1) : r * (q + 1) + (xcd - r) * q) + off; }
        const int nig = WGM * nN, gid = wgid / nig, fm = gid * WGM, gsz = (nM - fm) < WGM ? (nM - fm) : WGM;
        u.pm = fm + ((wgid % nig) % gsz); u.pn = (wgid % nig) / gsz; return true;
    }
    __device__ __forceinline__ void a_ready(const Unit&) const {}
    __device__ __forceinline__ void done(const Unit&) const {}
};

__device__ __forceinline__ unsigned cvt_pk_bf16(float lo, float hi) { unsigned r; asm volatile("v_cvt_pk_bf16_f32 %0, %1, %2" : "=v"(r) : "v"(lo), "v"(hi)); return r; }
typedef float f32x2 __attribute__((ext_vector_type(2)));
template <int ACT> struct EpiBf16 {
    static constexpr bool PERM = true, AFTER_DRAIN = false;
    bf16_t* O; int ldc;
    __device__ __forceinline__ void operator()(const f32x4 (&acc)[2][2][4][2], const Unit& u, int wr, int wc, int fr, int fq) const {
        const int row0 = u.pm * BM + wr * 64 + fr; const int col0 = u.pn * BM + wc * 32 + 8 * fq;
#pragma unroll
        for (int ai = 0; ai < 2; ++ai)
#pragma unroll
            for (int m = 0; m < 4; ++m) { bf16_t* rowp = O + (size_t)(row0 + ai * HALF + m * 16) * ldc + col0;
#pragma unroll
                for (int bj = 0; bj < 2; ++bj) { f32x4 v0 = acc[ai][bj][m][0], v1 = acc[ai][bj][m][1];
                    if (ACT == 2) {
#pragma unroll
                        for (int e = 0; e < 4; ++e) { float a = fmaxf(v0[e], 0.f), b = fmaxf(v1[e], 0.f); v0[e] = a * a; v1[e] = b * b; } }
                    u32x4 w; w.x = cvt_pk_bf16(v0[0], v0[1]); w.y = cvt_pk_bf16(v0[2], v0[3]); w.z = cvt_pk_bf16(v1[0], v1[1]); w.w = cvt_pk_bf16(v1[2], v1[3]);
                    *(u32x4*)(rowp + bj * HALF) = w; } }
    }
};
struct EpiResid {
    static constexpr bool PERM = false, AFTER_DRAIN = false;
    const float* base; float* out; int ldc;
    __device__ __forceinline__ void operator()(const f32x4 (&acc)[2][2][4][2], const Unit& u, int wr, int wc, int fr, int fq) const {
        const int col0 = u.pn * BM + wc * 32 + 4 * fq;
#pragma unroll
        for (int ai = 0; ai < 2; ++ai)
#pragma unroll
            for (int m = 0; m < 4; ++m) { const size_t off = (size_t)(u.pm * BM + ai * HALF + wr * 64 + m * 16 + fr) * ldc + col0;
#pragma unroll
                for (int bj = 0; bj < 2; ++bj)
#pragma unroll
                    for (int n = 0; n < 2; ++n) { const f32x4 bs = *(const f32x4*)(base + off + bj * HALF + n * 16); *(f32x4*)(out + off + bj * HALF + n * 16) = bs + acc[ai][bj][m][n]; } }
    }
};
__device__ __forceinline__ float row_rstd(const float* ssq, int row) {
    const f32x4* p = (const f32x4*)(ssq + (size_t)row * 16);
    const f32x4 a = p[0], b = p[1], c = p[2], d = p[3];
    const float s = (((a[0] + a[1]) + (a[2] + a[3])) + ((b[0] + b[1]) + (b[2] + b[3]))) + (((c[0] + c[1]) + (c[2] + c[3])) + ((d[0] + d[1]) + (d[2] + d[3])));
    return rsqrtf(s * (1.0f / 1024.0f) + 1e-6f);
}
#ifndef EPI_BATCH
#define EPI_BATCH 2
#endif
template <int ACT> struct EpiScaledBf16 {
    static constexpr bool PERM = true, AFTER_DRAIN = false;
    bf16_t* O; int ldc; const float* ssq; int gate_pn; float* gates; const float* ib; const float* fb;
    __device__ __forceinline__ void operator()(const f32x4 (&acc)[2][2][4][2], const Unit& u, int wr, int wc, int fr, int fq) const {
        const int row0 = u.pm * BM + wr * 64 + fr; const int col0 = u.pn * BM + wc * 32 + 8 * fq;
        const bool gate_tile = (u.pn == gate_pn);
        if (gate_tile && !(wc == 0 && fq == 0)) return;
#pragma unroll
        for (int ai = 0; ai < 2; ++ai)
#pragma unroll
        for (int mh = 0; mh < 4; mh += EPI_BATCH) {
            f32x4 p[EPI_BATCH][4]; float rs[EPI_BATCH];
#pragma unroll
            for (int m = 0; m < EPI_BATCH; ++m)
#pragma unroll
                for (int q = 0; q < 4; ++q) p[m][q] = *((const f32x4*)(ssq + (size_t)(row0 + ai * HALF + (mh + m) * 16) * 16) + q);
#pragma unroll
            for (int m = 0; m < EPI_BATCH; ++m) { const f32x4 t = (p[m][0] + p[m][1]) + (p[m][2] + p[m][3]); rs[m] = rsqrtf(((t[0] + t[1]) + (t[2] + t[3])) * (1.0f / 1024.0f) + 1e-6f); }
#pragma unroll
            for (int mm = 0; mm < EPI_BATCH; ++mm) { const int m = mh + mm; const int row = row0 + ai * HALF + m * 16; const float r = rs[mm];
                if (gate_tile) {
                    const f32x4 bi = *(const f32x4*)ib, bf = *(const f32x4*)fb;
                    *(f32x4*)(gates + (size_t)row * 8) = acc[ai][0][m][0] * r + bi; *(f32x4*)(gates + (size_t)row * 8 + 4) = acc[ai][0][m][1] * r + bf;
                } else {
                    bf16_t* rowp = O + (size_t)row * ldc + col0;
#pragma unroll
                    for (int bj = 0; bj < 2; ++bj) { f32x4 v0 = acc[ai][bj][m][0] * r, v1 = acc[ai][bj][m][1] * r;
                        if (ACT == 2) {
#pragma unroll
                            for (int e = 0; e < 4; ++e) { float a = fmaxf(v0[e], 0.f), b = fmaxf(v1[e], 0.f); v0[e] = a * a; v1[e] = b * b; } }
                        u32x4 w; w.x = cvt_pk_bf16(v0[0], v0[1]); w.y = cvt_pk_bf16(v0[2], v0[3]); w.z = cvt_pk_bf16(v1[0], v1[1]); w.w = cvt_pk_bf16(v1[2], v1[3]);
                        *(u32x4*)(rowp + bj * HALF) = w; }
                }
            }
            asm volatile("" ::: "memory");
        }
    }
};
struct EpiResidNorm {
    static constexpr bool PERM = false, AFTER_DRAIN = false;
    const float* base; float* out; bf16_t* xb; float* ssq; const float* xP; int ldc;
    __device__ __forceinline__ void operator()(const f32x4 (&acc)[2][2][4][2], const Unit& u, int wr, int wc, int fr, int fq) const {
        typedef unsigned u32x2v __attribute__((ext_vector_type(2)));
        const int col0 = u.pn * BM + wc * 32 + 4 * fq;
#pragma unroll
        for (int ai = 0; ai < 2; ++ai)
#pragma unroll
        for (int mh = 0; mh < 4; mh += EPI_BATCH) {
            f32x4 pre[EPI_BATCH][2][2];
#pragma unroll
            for (int mm = 0; mm < EPI_BATCH; ++mm) { const int m = mh + mm; const int row = u.pm * BM + ai * HALF + wr * 64 + m * 16 + fr; const bool p0 = xP != nullptr && (row & 4095) == 0;
                const float* src = p0 ? xP + (size_t)(row >> 12) * ldc + col0 : base + (size_t)row * ldc + col0;
#pragma unroll
                for (int bj = 0; bj < 2; ++bj)
#pragma unroll
                    for (int n = 0; n < 2; ++n) pre[mm][bj][n] = *(const f32x4*)(src + bj * HALF + n * 16); }
#pragma unroll
            for (int mm = 0; mm < EPI_BATCH; ++mm) { const int m = mh + mm; const int row = u.pm * BM + ai * HALF + wr * 64 + m * 16 + fr; const size_t off = (size_t)row * ldc + col0; float s = 0.f;
                const bool p0 = xP != nullptr && (row & 4095) == 0;
#pragma unroll
                for (int bj = 0; bj < 2; ++bj)
#pragma unroll
                    for (int n = 0; n < 2; ++n) { const int co = bj * HALF + n * 16;
                        f32x4 v = pre[mm][bj][n]; if (!p0) v = v + acc[ai][bj][m][n];
                        *(f32x4*)(out + off + co) = v; s += (v[0] * v[0] + v[1] * v[1]) + (v[2] * v[2] + v[3] * v[3]);
                        u32x2v w; w.x = cvt_pk_bf16(v[0], v[1]); w.y = cvt_pk_bf16(v[2], v[3]); *(u32x2v*)(xb + off + co) = w; }
                s += __shfl_xor(s, 16); s += __shfl_xor(s, 32);
                if (fq == 0) ssq[(size_t)row * 16 + u.pn * 4 + wc] = s; }
            asm volatile("" ::: "memory");
        }
    }
};
struct EpiNull {
    static constexpr bool PERM = false, AFTER_DRAIN = false;
    float* sink;
    __device__ __forceinline__ void operator()(const f32x4 (&acc)[2][2][4][2], const Unit& u, int wr, int wc, int fr, int fq) const {
        float s = 0.f;
#pragma unroll
        for (int ai = 0; ai < 2; ++ai)
#pragma unroll
            for (int bj = 0; bj < 2; ++bj)
#pragma unroll
                for (int m = 0; m < 4; ++m)
#pragma unroll
                    for (int n = 0; n < 2; ++n) s += (acc[ai][bj][m][n][0] + acc[ai][bj][m][n][1]) + (acc[ai][bj][m][n][2] + acc[ai][bj][m][n][3]);
        if (s == 1.2345678e33f) sink[0] = s;
    }
};
template <class Epi, class Sched, bool ALIGN_EPI = false, bool SP2 = false>
__device__ __forceinline__ void gemm_phase(PG8_LAS unsigned char* lds, const Gemm g, const Sched& S, const Epi& E) {
    int tid_o = threadIdx.x; asm volatile("" : "+v"(tid_o)); const int tid = tid_o, wid = __builtin_amdgcn_readfirstlane(tid >> 6), lane = tid & 63, wr = wid >> 2, wc = wid & 3, fr = lane & 15, fq = lane >> 4;
    const int K = g.K, nt = K / BK;
    unsigned voffA[2], voffB[2];
#pragma unroll
    for (int i = 0; i < 2; ++i) { int R, C; stage_rc(tid * 16 + i * 8192, R, C); const int Rb = Epi::PERM ? ((R & ~31) + perm32(R & 31)) : R;
        voffA[i] = (unsigned)(R * K + C) * 2u; voffB[i] = (unsigned)(Rb * K + C) * 2u; }
    const size_t kstep = (size_t)(BK * 2);
    const size_t hstep = (size_t)HALF * K * 2;
    const size_t tstep = 2 * hstep;
    const unsigned ldsw = (unsigned)wid * 1024u;
    const int aoff = lds_byte(wr * 64 + fr, fq * 8), boff = lds_byte(wc * 32 + fr, fq * 8);
#define PG8_SA(b, h) (((b) * 2 + (h)) * HTB)
#define PG8_SB(b, h) ((4 + (b) * 2 + (h)) * HTB)
#define PG8_STAGE(bufoff, gbase, voff) do { _Pragma("unroll") for (int _i = 0; _i < 2; ++_i) \
        __builtin_amdgcn_global_load_lds((const unsigned*)((const char*)(gbase) + (voff)[_i]), (PG8_LAS unsigned*)(lds + (bufoff) + ldsw + _i * 8192), 16, 0, 0); } while (0)
#define PG8_LDA(dst, b, h) do { _Pragma("unroll") for (int m = 0; m < 4; ++m) _Pragma("unroll") for (int k = 0; k < 2; ++k) dst[m][k] = *(const PG8_LAS bf16x8*)(lds + PG8_SA(b, h) + aoff + m * 2048 + k * 1024); } while (0)
#define PG8_LDB(dst, b, h) do { _Pragma("unroll") for (int n = 0; n < 2; ++n) _Pragma("unroll") for (int k = 0; k < 2; ++k) dst[n][k] = *(const PG8_LAS bf16x8*)(lds + PG8_SB(b, h) + boff + n * 2048 + k * 1024); } while (0)
#define PG8_MMA(ai, bj, At, Bt) do { __builtin_amdgcn_s_setprio(1); _Pragma("unroll") for (int m = 0; m < 4; ++m) _Pragma("unroll") for (int n = 0; n < 2; ++n) _Pragma("unroll") for (int k = 0; k < 2; ++k) \
        acc[ai][bj][m][n] = __builtin_amdgcn_mfma_f32_16x16x32_bf16(Bt[n][k], At[m][k], acc[ai][bj][m][n], 0, 0, 0); __builtin_amdgcn_s_setprio(0); } while (0)
#define PG8_WAIT_V(n) asm volatile("s_waitcnt vmcnt(" #n ")" ::: "memory")
#define PG8_WAIT_L(n) asm volatile("s_waitcnt lgkmcnt(" #n ")" ::: "memory")
#define PG8_BAR __builtin_amdgcn_s_barrier()
#define PG8_SCHED __builtin_amdgcn_sched_barrier(0)
    Unit cur, nxt; int ui = 0;
    if (!S.next(0, cur)) return;
    f32x4 acc[2][2][4][2];
#pragma unroll
    for (int a = 0; a < 2; ++a)
#pragma unroll
        for (int b = 0; b < 2; ++b)
#pragma unroll
            for (int m = 0; m < 4; ++m)
#pragma unroll
                for (int n = 0; n < 2; ++n) acc[a][b][m][n] = (f32x4){0.f, 0.f, 0.f, 0.f};
    bf16x8 At[4][2], B0[2][2], B1[2][2];
    const char* cA = (const char*)g.A + (size_t)cur.pm * tstep; const char* cB = (const char*)g.Bt + (size_t)cur.pn * tstep;
    S.a_ready(cur);
    if constexpr (SP2) {
        PG8_STAGE(PG8_SB(0, 0), cB, voffB); PG8_STAGE(PG8_SB(0, 1), cB + hstep, voffB); PG8_STAGE(PG8_SA(0, 0), cA, voffA); PG8_STAGE(PG8_SA(0, 1), cA + hstep, voffA);
        if (wr == 1) PG8_BAR;
        PG8_WAIT_V(2); PG8_BAR;
        PG8_STAGE(PG8_SB(1, 0), cB + kstep, voffB); PG8_STAGE(PG8_SA(1, 0), cA + kstep, voffA); PG8_STAGE(PG8_SB(1, 1), cB + hstep + kstep, voffB);
        PG8_WAIT_V(6); PG8_BAR;
    } else {
        PG8_STAGE(PG8_SB(0, 0), cB, voffB); PG8_STAGE(PG8_SA(0, 0), cA, voffA); PG8_STAGE(PG8_SB(0, 1), cB + hstep, voffB); PG8_STAGE(PG8_SA(0, 1), cA + hstep, voffA);
        if (wr == 1) PG8_BAR;
        PG8_WAIT_V(4); PG8_BAR;
        PG8_STAGE(PG8_SB(1, 0), cB + kstep, voffB); PG8_STAGE(PG8_SA(1, 0), cA + kstep, voffA); PG8_STAGE(PG8_SB(1, 1), cB + hstep + kstep, voffB);
        PG8_WAIT_V(6); PG8_BAR;
    }
    for (;;) {
        const bool has_next = S.next(ui + 1, nxt);
        const char* nA = has_next ? (const char*)g.A + (size_t)nxt.pm * tstep : cA; const char* nB = has_next ? (const char*)g.Bt + (size_t)nxt.pn * tstep : cB;
        for (int t = 0; t < nt; t += 2) {
            const bool last = (t == nt - 2);
            const char* a1 = cA + (size_t)(t + 1) * kstep;
            const char* a2 = last ? nA : cA + (size_t)(t + 2) * kstep; const char* b2 = last ? nB : cB + (size_t)(t + 2) * kstep;
            const char* a3 = a2 + kstep; const char* b3 = b2 + kstep;
            if (last && has_next) S.a_ready(nxt);
            if constexpr (SP2) {
            PG8_LDB(B0, 0, 0); PG8_LDB(B1, 0, 1); PG8_SCHED; PG8_LDA(At, 0, 0); PG8_STAGE(PG8_SA(1, 1), a1 + hstep, voffA);
            PG8_WAIT_V(8); PG8_WAIT_L(0); PG8_BAR; PG8_MMA(0, 0, At, B0); PG8_MMA(0, 1, At, B1); PG8_BAR; PG8_SCHED;
            PG8_LDA(At, 0, 1); PG8_STAGE(PG8_SB(0, 0), b2, voffB); PG8_STAGE(PG8_SB(0, 1), b2 + hstep, voffB); PG8_STAGE(PG8_SA(0, 0), a2, voffA);
            PG8_WAIT_V(8); PG8_WAIT_L(0); PG8_BAR; PG8_MMA(1, 0, At, B0); PG8_MMA(1, 1, At, B1); PG8_BAR; PG8_SCHED;
            PG8_LDB(B0, 1, 0); PG8_LDB(B1, 1, 1); PG8_SCHED; PG8_LDA(At, 1, 0); PG8_STAGE(PG8_SA(0, 1), a2 + hstep, voffA);
            PG8_WAIT_V(8); PG8_WAIT_L(0); PG8_BAR; PG8_MMA(0, 0, At, B0); PG8_MMA(0, 1, At, B1); PG8_BAR; PG8_SCHED;
            PG8_LDA(At, 1, 1); PG8_STAGE(PG8_SB(1, 0), b3, voffB); PG8_STAGE(PG8_SB(1, 1), b3 + hstep, voffB); PG8_STAGE(PG8_SA(1, 0), a3, voffA);
            PG8_WAIT_V(8); PG8_WAIT_L(0); PG8_BAR; PG8_MMA(1, 0, At, B0); PG8_MMA(1, 1, At, B1); PG8_BAR; PG8_SCHED;
            } else {
            PG8_LDB(B0, 0, 0); PG8_SCHED; PG8_LDA(At, 0, 0); PG8_STAGE(PG8_SA(1, 1), a1 + hstep, voffA);
            PG8_WAIT_L(8); PG8_BAR; PG8_WAIT_L(0); PG8_MMA(0, 0, At, B0); PG8_BAR; PG8_SCHED;
            PG8_LDB(B1, 0, 1); PG8_STAGE(PG8_SB(0, 0), b2, voffB);
            PG8_BAR; PG8_WAIT_L(0); PG8_MMA(0, 1, At, B1); PG8_BAR;
            PG8_LDA(At, 0, 1); PG8_STAGE(PG8_SA(0, 0), a2, voffA);
            PG8_BAR; PG8_WAIT_L(0); PG8_MMA(1, 0, At, B0); PG8_BAR; PG8_SCHED;
            PG8_STAGE(PG8_SB(0, 1), b2 + hstep, voffB);
            PG8_WAIT_V(6); PG8_BAR; PG8_MMA(1, 1, At, B1); PG8_BAR;
            PG8_LDB(B0, 1, 0); PG8_SCHED; PG8_LDA(At, 1, 0); PG8_STAGE(PG8_SA(0, 1), a2 + hstep, voffA);
            PG8_WAIT_L(8); PG8_BAR; PG8_WAIT_L(0); PG8_MMA(0, 0, At, B0); PG8_BAR; PG8_SCHED;
            PG8_LDB(B1, 1, 1); PG8_STAGE(PG8_SB(1, 0), b3, voffB);
            PG8_BAR; PG8_WAIT_L(0); PG8_MMA(0, 1, At, B1); PG8_BAR;
            PG8_LDA(At, 1, 1); PG8_STAGE(PG8_SA(1, 0), a3, voffA);
            PG8_BAR; PG8_WAIT_L(0); PG8_MMA(1, 0, At, B0); PG8_BAR; PG8_SCHED;
            PG8_STAGE(PG8_SB(1, 1), b3 + hstep, voffB);
            PG8_WAIT_V(6); PG8_BAR; PG8_MMA(1, 1, At, B1); PG8_BAR;
            }
        }
        if constexpr (ALIGN_EPI) { if (wr == 0) PG8_BAR; }
        if constexpr (!Epi::AFTER_DRAIN) { E(acc, cur, wr, wc, fr, fq); S.done(cur); }
        if (!has_next) break;
#pragma unroll
        for (int a = 0; a < 2; ++a)
#pragma unroll
            for (int b = 0; b < 2; ++b)
#pragma unroll
                for (int m = 0; m < 4; ++m)
#pragma unroll
                    for (int n = 0; n < 2; ++n) acc[a][b][m][n] = (f32x4){0.f, 0.f, 0.f, 0.f};
        cur = nxt; cA = nA; cB = nB; ++ui;
        if constexpr (ALIGN_EPI) { if (wr == 1) PG8_BAR; }
    }
    PG8_WAIT_V(0);
    if constexpr (!ALIGN_EPI) { if (wr == 0) PG8_BAR; }
    PG8_BAR;
    if constexpr (Epi::AFTER_DRAIN) { E.fused(acc, cur, wr, wc, fr, fq, lds, wid, lane); S.done(cur); }
#undef PG8_SA
#undef PG8_SB
#undef PG8_STAGE
#undef PG8_LDA
#undef PG8_LDB
#undef PG8_MMA
#undef PG8_WAIT_V
#undef PG8_WAIT_L
#undef PG8_BAR
#undef PG8_SCHED
}
}

constexpr int NWAVES = 8, NTHR = 512;
constexpr int BATCH = 4, SEQ = 4096, DM = 1024, DEPTH = 4, MTOK = BATCH * SEQ;
constexpr int N_IN = 2824, NP = 2816, NPAD = 3072, DFF = 4096;
constexpr int NCH = 32;
constexpr int PC_MX = 0, PC_MZ = 384, PC_RQ = 768, PC_RK = 1152, PC_RV = 1536, PC_RG = 1920, PC_GU = 2304, PC_GV = 2560;
constexpr int CAT_R = 384, CAT_G = 768;
constexpr float EPS = 1e-6f;
constexpr int NE_M = 97 * 96;
constexpr int NE_R = 64 * 64;

constexpr size_t MiB = 1u << 20;
constexpr size_t WS_CTL = 0;
constexpr size_t WS_WIN = 1 * MiB, WS_WOUT = 7 * MiB, WS_W1 = 9 * MiB, WS_W2 = 17 * MiB;
constexpr size_t WS_ROPE = 25 * MiB;
constexpr size_t WS_GATES = 26 * MiB;
constexpr size_t WS_SCAL = 27 * MiB;
constexpr size_t WS_XP = 27 * MiB + 65536;
constexpr size_t WS_PROJP = WS_XP + 16384;
constexpr size_t WS_CATP = WS_PROJP + 49152;
constexpr size_t WS_HIDP = WS_CATP + 16384;
constexpr size_t WS_H = 28 * MiB;
constexpr size_t WS_PROJ = 60 * MiB;
constexpr size_t WS_CAT = 148 * MiB;
constexpr size_t WS_MST = 180 * MiB;
constexpr size_t WS_RST = 199 * MiB;
constexpr size_t WS_HID = 60 * MiB;
constexpr size_t WS_WBUF1 = 210 * MiB;
constexpr size_t WS_SSQ = 236 * MiB;
constexpr size_t WS_END = 237 * MiB;
static_assert(WS_MST + (size_t)512 * NE_M * 4 <= WS_RST && WS_RST + (size_t)768 * NE_R * 4 <= 211 * MiB, "ws map");
static_assert(WS_HID + (size_t)MTOK * DFF * 2 <= WS_RST, "hid overlay");

#ifndef XREP_A
#define XREP_A 0
#endif
#ifndef XREP_C
#define XREP_C 0
#endif
#ifndef XREP_E_END
#define XREP_E_END 1280
#endif
#ifndef XREP_E
#define XREP_E 0
#endif
#ifndef XREP_D
#define XREP_D 0
#endif
#ifndef XREP_B
#define XREP_B 0
#endif
#ifndef XREP_H
#define XREP_H 0
#endif
#ifndef GEMM_SP2
#define GEMM_SP2 true
#endif
#ifndef GEMM_ALIGN
#define GEMM_ALIGN true
#endif
#ifndef XREP_G
#define XREP_G 0
#endif
constexpr int LDS_BYTES = 147456;

#define LAS __attribute__((address_space(3)))
typedef unsigned short bf16;
typedef unsigned v4u __attribute__((ext_vector_type(4)));
typedef unsigned v2u __attribute__((ext_vector_type(2)));
typedef float f32x4 __attribute__((ext_vector_type(4)));
typedef short bf16x8 __attribute__((ext_vector_type(8)));
typedef LAS unsigned char* ldsp;

__device__ __forceinline__ unsigned pk2(float lo, float hi) { return pg8::cvt_pk_bf16(lo, hi); }
__device__ __forceinline__ unsigned short f2bf(float f) { return (unsigned short)(pg8::cvt_pk_bf16(f, 0.f) & 0xffffu); }
__device__ __forceinline__ float bflo(unsigned u) { return __uint_as_float(u << 16); }
__device__ __forceinline__ float bfhi(unsigned u) { return __uint_as_float(u & 0xffff0000u); }
__device__ __forceinline__ float bf2f(unsigned short h) { return __uint_as_float((unsigned)h << 16); }
__device__ __forceinline__ float fast_rcp(float x) { return __builtin_amdgcn_rcpf(x); }
__device__ __forceinline__ float silu_f(float x) { return x * fast_rcp(1.f + __expf(-x)); }
__device__ __forceinline__ float gelu_tanh(float x) { const float u = 0.7978845608f * (x + 0.044715f * x * x * x); const float r = fast_rcp(__expf(2.f * u) + 1.f); return x - x * r; }
__device__ __forceinline__ float wave_sum(float v) {
#pragma unroll
    for (int o = 1; o < 64; o <<= 1) v += __shfl_xor(v, o);
    return v;
}
#define XB_TMO      128
#define XB_XCNT(j)  (256  + 64 * (j))
#define XB_XSUB(j)  (1280 + 64 * (j))
#define XB_XGEN(j)  (2304 + 64 * (j))
#define XB_TOP      3328
#define XB_TOPGEN   3392
#define XCD_BAR_WORDS 3456
#define XB_SPIN_CAP (1u << 18)

__device__ __forceinline__ unsigned xb_ld(unsigned* p)              { return __hip_atomic_load(p, __ATOMIC_RELAXED, __HIP_MEMORY_SCOPE_AGENT); }
__device__ __forceinline__ unsigned xb_add(unsigned* p, unsigned v) { return __hip_atomic_fetch_add(p, v, __ATOMIC_RELAXED, __HIP_MEMORY_SCOPE_AGENT); }
__device__ __forceinline__ unsigned xb_xcc_id() { return (unsigned)__builtin_amdgcn_s_getreg((3 << 11) | 20) & 0xFu; }
#define XB_SPIN(cond, bar) do { unsigned _sp = 0; while (cond) { __builtin_amdgcn_s_sleep(1); \
    if ((++_sp & 255u) == 0u) { if (xb_ld(&(bar)[XB_TMO])) break; if (_sp > XB_SPIN_CAP) { atomicAdd(&(bar)[XB_TMO], 1u); break; } } } } while (0)

struct XcdBarrier {
    unsigned* bar; unsigned x;
    volatile LAS unsigned* st;
};

__device__ __forceinline__ XcdBarrier xcd_barrier_post(unsigned* bar, volatile LAS unsigned* st) {
    XcdBarrier b; b.bar = bar; b.x = xb_xcc_id(); b.st = st;
    if (threadIdx.x == 0) (void)xb_add(&bar[XB_XCNT(b.x)], 1u);
    return b;
}
__device__ __forceinline__ void xcd_barrier_complete(unsigned* bar, unsigned x, unsigned& nloc, unsigned& nx) {
    const unsigned G = gridDim.x * gridDim.y * gridDim.z;
    unsigned sum, cnt, mine, sp = 0u;
    for (;;) {
        sum = 0u; cnt = 0u; mine = 0u;
#pragma unroll
        for (unsigned j = 0; j < 16; ++j) { const unsigned c = xb_ld(&bar[XB_XCNT(j)]); sum += c; cnt += (c > 0u) ? 1u : 0u; mine = (j == x) ? c : mine; }
        if (sum == G) break;
        __builtin_amdgcn_s_sleep(1);
        if ((++sp & 255u) == 0u) { if (xb_ld(&bar[XB_TMO])) break; if (sp > XB_SPIN_CAP) { atomicAdd(&bar[XB_TMO], 1u); break; } }
    }
    nloc = mine > 0u ? mine : 1u; nx = cnt > 0u ? cnt : 1u;
}

__device__ __forceinline__ void xcd_barrier(const XcdBarrier& b) {
    asm volatile("s_waitcnt vmcnt(0)" ::: "memory");
    __syncthreads();
    if (threadIdx.x == 0) {
        unsigned* bar = b.bar;
        __builtin_amdgcn_s_waitcnt(0);
        unsigned nloc = b.st[0], nx = b.st[1];
        if (nloc == 0u) { xcd_barrier_complete(bar, b.x, nloc, nx); b.st[0] = nloc; b.st[1] = nx; }
        const unsigned old = xb_add(&bar[XB_XSUB(b.x)], 1u);
        const unsigned gen = old / nloc;
        if (old + 1u == (gen + 1u) * nloc) {
            __builtin_amdgcn_fence(__ATOMIC_RELEASE, "agent");
            asm volatile("s_waitcnt vmcnt(0)" ::: "memory");
            const unsigned og = xb_add(&bar[XB_TOP], 1u);
            const unsigned tg = og / nx;
            if (og + 1u == (tg + 1u) * nx) xb_add(&bar[XB_TOPGEN], 1u);
            else XB_SPIN(xb_ld(&bar[XB_TOPGEN]) == tg, bar);
            __builtin_amdgcn_fence(__ATOMIC_ACQUIRE, "agent");
            xb_add(&bar[XB_XGEN(b.x)], 1u);
            asm volatile("s_waitcnt vmcnt(0)" ::: "memory");
        } else {
            XB_SPIN(xb_ld(&bar[XB_XGEN(b.x)]) == gen, bar);
            __builtin_amdgcn_fence(__ATOMIC_ACQUIRE, "agent");
            asm volatile("s_waitcnt vmcnt(0)" ::: "memory");
        }
    }
    __syncthreads();
}

typedef float f32x2 __attribute__((ext_vector_type(2)));
__device__ __forceinline__ f32x2 silu2(f32x2 x) { const f32x2 t = x * (-1.4426950408889634f); f32x2 e; e.x = __builtin_amdgcn_exp2f(t.x); e.y = __builtin_amdgcn_exp2f(t.y);
    const f32x2 d = e + 1.0f; f32x2 r; r.x = __builtin_amdgcn_rcpf(d.x); r.y = __builtin_amdgcn_rcpf(d.y); return x * r; }
__device__ __forceinline__ f32x2 gelu2(f32x2 x) { const f32x2 p = (x * x) * 0.10294324f + 2.3022082f; const f32x2 w = p * x; f32x2 e; e.x = __builtin_amdgcn_exp2f(w.x); e.y = __builtin_amdgcn_exp2f(w.y);
    const f32x2 d = e + 1.0f; f32x2 r; r.x = __builtin_amdgcn_rcpf(d.x); r.y = __builtin_amdgcn_rcpf(d.y); return x - x * r; }
#define LDS_WAIT() asm volatile("s_waitcnt lgkmcnt(0)" ::: "memory")
#define MFMA16(a, b, c) __builtin_amdgcn_mfma_f32_16x16x32_bf16((a), (b), (c), 0, 0, 0)

struct Args {
    const float* in[21];
    float* out; unsigned char* ws;
};
typedef const Args __attribute__((address_space(4)))* ArgsP;
enum { I_X = 0, I_NMG, I_WIN, I_CONVW, I_CONVB, I_WQ, I_WK, I_WV, I_IB, I_FB, I_MNG, I_SKIP, I_RNG, I_GNG, I_GWS, I_GBS, I_WOUT, I_NFG, I_WFF1, I_WFF2, I_FNG };

__device__ __forceinline__ void transpose_item(const float* W, int ldw, int col_src0, int nvalid, const float* gk, int K, bf16* WT, int n0, int k0, LAS float* scr, int lane) {
    float vv[32];
    const bool val = (lane & 31) < nvalid;
    const float* wp = W + (size_t)(k0 + (lane >> 5)) * ldw + col_src0 + (lane & 31);
#pragma unroll
    for (int i = 0; i < 32; ++i) vv[i] = val ? wp[(size_t)(2 * i) * ldw] : 0.f;
    if (gk) {
        const float* gp = gk + k0 + (lane >> 5);
#pragma unroll
        for (int i = 0; i < 32; ++i) vv[i] *= gp[2 * i];
    }
#pragma unroll
    for (int i = 0; i < 32; ++i) scr[(2 * i + (lane >> 5)) * 33 + (lane & 31)] = vv[i];
    LDS_WAIT(); asm volatile("" ::: "memory");
    const int c = lane & 7;
#pragma unroll
    for (int j = 0; j < 4; ++j) { const int n = (lane >> 3) + 8 * j; const LAS float* s = scr + (8 * c) * 33 + n;
        v4u o; o.x = pk2(s[0 * 33], s[1 * 33]); o.y = pk2(s[2 * 33], s[3 * 33]); o.z = pk2(s[4 * 33], s[5 * 33]); o.w = pk2(s[6 * 33], s[7 * 33]);
        *(v4u*)(WT + (size_t)(n0 + n) * K + k0 + 8 * c) = o; }
    LDS_WAIT(); asm volatile("" ::: "memory");
}

__device__ __forceinline__ void convert_weights(ArgsP a, int L, size_t wb, ldsp lds, int lane, int wave) {
    LAS float* scr = (LAS float*)(lds + 32768 + wave * 8448);
    const int gw = blockIdx.x * NWAVES + wave, NGW = gridDim.x * NWAVES;
    constexpr int I_IN = (DM / 64) * (NPAD / 32), I_O = (DM / 64) * (DM / 32), I_1 = (DM / 64) * (DFF / 32), I_2 = (DFF / 64) * (DM / 32);
    constexpr int NITEMS = I_IN + I_O + I_1 + I_2;
    unsigned char* ws = a->ws + wb;
    for (int it = gw; it < NITEMS; it += NGW) {
        int r = it;
        if (r < I_IN) { const int nblk = NPAD / 32, kb = r / nblk, nb = r % nblk, n0 = nb * 32;
            const int src = nb < 88 ? n0 + (n0 >= 768 ? 8 : 0) : 768, nv = nb < 88 ? 32 : (nb == 88 ? 8 : 0);
            transpose_item(a->in[I_WIN] + (size_t)L * DM * N_IN, N_IN, src, nv, a->in[I_NMG] + (size_t)L * DM, DM, (bf16*)(ws + WS_WIN), n0, kb * 64, scr, lane); continue; } r -= I_IN;
        if (r < I_O) { const int nblk = DM / 32, kb = r / nblk, nb = r % nblk; transpose_item(a->in[I_WOUT] + (size_t)L * DM * DM, DM, nb * 32, 32, nullptr, DM, (bf16*)(ws + WS_WOUT), nb * 32, kb * 64, scr, lane); continue; } r -= I_O;
        if (r < I_1) { const int nblk = DFF / 32, kb = r / nblk, nb = r % nblk; transpose_item(a->in[I_WFF1] + (size_t)L * DM * DFF, DFF, nb * 32, 32, a->in[I_NFG] + (size_t)L * DM, DM, (bf16*)(ws + WS_W1), nb * 32, kb * 64, scr, lane); continue; } r -= I_1;
        { const int nblk = DM / 32, kb = r / nblk, nb = r % nblk; transpose_item(a->in[I_WFF2] + (size_t)L * DFF * DM, DM, nb * 32, 32, nullptr, DFF, (bf16*)(ws + WS_W2), nb * 32, kb * 64, scr, lane); }
    }
}

template <bool GATES>
__device__ __forceinline__ void norm_rows(const float* x, const float* g, bf16* h, const LAS float* wgT, const float* ib, const float* fb, float* gates, int lane, int wave, const float* xP, float* wb) {
    const int gw = blockIdx.x * NWAVES + wave, NGW = gridDim.x * NWAVES;
    f32x4 gv[4];
#pragma unroll
    for (int j = 0; j < 4; ++j) gv[j] = ((const f32x4*)g)[lane + 64 * j];
    for (int m = gw; m < MTOK; m += NGW) {
        const bool p0 = xP != nullptr && (m & (SEQ - 1)) == 0;
        const f32x4* xr = (const f32x4*)(p0 ? xP + (size_t)(m >> 12) * DM : x + (size_t)m * DM) + lane;
        f32x4 v[4]; float ss = 0.f;
#pragma unroll
        for (int j = 0; j < 4; ++j) { v[j] = xr[64 * j]; ss += (v[j].x * v[j].x + v[j].y * v[j].y) + (v[j].z * v[j].z + v[j].w * v[j].w); }
        if (p0 && wb != nullptr) {
#pragma unroll
            for (int j = 0; j < 4; ++j) ((f32x4*)(wb + (size_t)m * DM) + lane)[64 * j] = v[j]; }
        const float rstd = rsqrtf(wave_sum(ss) * (1.f / DM) + EPS);
        unsigned long long* o8 = (unsigned long long*)(h + (size_t)m * DM) + lane;
#pragma unroll
        for (int j = 0; j < 4; ++j) { v[j] = v[j] * rstd * gv[j]; o8[64 * j] = (unsigned long long)pk2(v[j].x, v[j].y) | ((unsigned long long)pk2(v[j].z, v[j].w) << 32); }
        if (GATES) {
            float mine = 0.f;
#pragma unroll
            for (int c = 0; c < 8; ++c) {
                float p = 0.f;
#pragma unroll
                for (int j = 0; j < 4; ++j) { const f32x4 w = *(const LAS f32x4*)(wgT + c * 1024 + 4 * lane + 256 * j); p += (v[j].x * w.x + v[j].y * w.y) + (v[j].z * w.z + v[j].w * w.w); }
                p = wave_sum(p);
                if (lane == c) mine = p;
            }
            if (lane < 8) gates[(size_t)m * 8 + lane] = mine + (lane < 4 ? ib[lane] : fb[lane - 4]);
        }
    }
}

__device__ __forceinline__ float log_sigmoid_f(float f) { return fminf(f, 0.f) - __logf(1.f + __expf(-fabsf(f))); }
__device__ __forceinline__ void gates_cumsum(float f0, float f1, float& b0, float& b1, int lane) {
    const float l0 = log_sigmoid_f(f0), l1 = log_sigmoid_f(f1);
    float p = l0 + l1;
#pragma unroll
    for (int o = 1; o < 64; o <<= 1) { const float u = __shfl_up(p, o); if (lane >= o) p += u; }
    b1 = p; b0 = p - l1;
}
__device__ __forceinline__ void gates_prefmax(float g0, float g1, float& m0, float& m1, int lane) {
    float q = fmaxf(g0, g1);
#pragma unroll
    for (int o = 1; o < 64; o <<= 1) { const float u = __shfl_up(q, o); if (lane >= o) q = fmaxf(q, u); }
    const float ex = __shfl_up(q, 1);
    m1 = q; m0 = lane == 0 ? g0 : fmaxf(ex, g0);
}

struct MStage { f32x4 cw[4]; f32x4 cb; f32x4 wq[4], wk[4], wv[4]; v2u xr[11]; };
template <bool FULL>
__device__ __forceinline__ void mlstm_stage_load(ArgsP a, int L, int h, int t0, int s0, int tid, MStage& R) {
    if (tid < 384) {
        const bf16* proj = (const bf16*)(a->ws + WS_PROJ);
        const int blk = tid % 24, rg = tid / 24, l0 = rg * 8;
        const int ch0 = h * 96 + blk * 4, nb = h * 24 + blk;
#pragma unroll
        for (int r = 0; r < 11; ++r) { const int l = l0 - 3 + r;
            if (s0 + l >= 0) R.xr[r] = *(const v2u*)(proj + (size_t)(t0 + l) * NP + PC_MX + ch0); else R.xr[r] = (v2u){0u, 0u}; }
#pragma unroll
        for (int j = 0; j < 4; ++j) R.cw[j] = *(const f32x4*)(a->in[I_CONVW] + (size_t)L * 4 * 384 + j * 384 + ch0);
        R.cb = *(const f32x4*)(a->in[I_CONVB] + (size_t)L * 384 + ch0);
#pragma unroll
        for (int i = 0; i < 4; ++i) {
            R.wk[i] = *(const f32x4*)(a->in[I_WK] + ((size_t)L * 96 + nb) * 16 + i * 4);
            R.wv[i] = *(const f32x4*)(a->in[I_WV] + ((size_t)L * 96 + nb) * 16 + i * 4);
            if (FULL) R.wq[i] = *(const f32x4*)(a->in[I_WQ] + ((size_t)L * 96 + nb) * 16 + i * 4);
        }
    }
}
template <bool FULL>
__device__ __forceinline__ void mlstm_stage_compute(const MStage& R, ldsp XC, ldsp Q, ldsp K, ldsp VT, const LAS float* eend, int tid) {
    if (tid < 384) {
        const int blk = tid % 24, rg = tid / 24, l0 = rg * 8;
        f32x4 xm[11];
#pragma unroll
        for (int r = 0; r < 11; ++r) xm[r] = (f32x4){bflo(R.xr[r].x), bfhi(R.xr[r].x), bflo(R.xr[r].y), bfhi(R.xr[r].y)};
        const float kscale = 0.10206207261596575f;
        unsigned vpk[4][4], kpk[4][4];
        float vprev[4], kprev[4];
#pragma unroll
        for (int li = 0; li < 8; ++li) {
            f32x4 xc = R.cb;
#pragma unroll
            for (int j = 0; j < 4; ++j) xc = xc + R.cw[j] * xm[li + j];
            { const f32x2 s01 = silu2((f32x2){xc.x, xc.y}), s23 = silu2((f32x2){xc.z, xc.w}); xc = (f32x4){s01.x, s01.y, s23.x, s23.y}; }
            const f32x4 xr = xm[li + 3];
            f32x4 kk = (xc.x * R.wk[0] + xc.y * R.wk[1]) + (xc.z * R.wk[2] + xc.w * R.wk[3]);
            const f32x4 vv = (xr.x * R.wv[0] + xr.y * R.wv[1]) + (xr.z * R.wv[2] + xr.w * R.wv[3]);
            const int l = l0 + li;
            if (FULL) {
                const f32x4 qq = (xc.x * R.wq[0] + xc.y * R.wq[1]) + (xc.z * R.wq[2] + xc.w * R.wq[3]);
                kk = kk * kscale;
                *(LAS v2u*)(XC + l * 192 + blk * 8) = (v2u){pk2(xc.x, xc.y), pk2(xc.z, xc.w)};
                *(LAS v2u*)(Q + l * 208 + blk * 8) = (v2u){pk2(qq.x, qq.y), pk2(qq.z, qq.w)};
                *(LAS v2u*)(K + l * 208 + blk * 8) = (v2u){pk2(kk.x, kk.y), pk2(kk.z, kk.w)};
            } else {
                kk = kk * (kscale * eend[l]);
            }
            if (li & 1) {
#pragma unroll
                for (int jj = 0; jj < 4; ++jj) { vpk[jj][li >> 1] = pk2(vprev[jj], vv[jj]); if (!FULL) kpk[jj][li >> 1] = pk2(kprev[jj], kk[jj]); }
            } else {
#pragma unroll
                for (int jj = 0; jj < 4; ++jj) { vprev[jj] = vv[jj]; kprev[jj] = kk[jj]; }
            }
        }
#pragma unroll
        for (int jj = 0; jj < 4; ++jj) {
            *(LAS v4u*)(VT + (blk * 4 + jj) * 272 + l0 * 2) = (v4u){vpk[jj][0], vpk[jj][1], vpk[jj][2], vpk[jj][3]};
            if (!FULL) *(LAS v4u*)(K + (blk * 4 + jj) * 272 + l0 * 2) = (v4u){kpk[jj][0], kpk[jj][1], kpk[jj][2], kpk[jj][3]};
        }
    }
}

__device__ __forceinline__ void fill_vt_tail(ldsp VT, int tid) {
    if (tid < 384) return;
    const int i = tid - 384;
#pragma unroll
    for (int r = 0; r < 2; ++r) { const int idx = i + 128 * r;
        const int row = idx >> 4, c16 = idx & 15; const unsigned w = row == 0 ? 0x3f803f80u : 0u;
        *(LAS v4u*)(VT + (96 + row) * 272 + c16 * 16) = (v4u){w, w, w, w}; }
}

__device__ __forceinline__ void phaseC_mlstm(ArgsP a, int L, int item, ldsp lds, int tid, int lane, int wave) {
    const int bh = item >> 5, c = item & 31, b = bh >> 2, h = bh & 3;
    const int t0 = b * SEQ + c * 128, s0 = c * 128;
    ldsp EKT = lds, VT = lds + 26112;
    LAS float* eend = (LAS float*)(lds + 56576);
    const float* gates = (const float*)(a->ws + WS_GATES);
    float* scal = (float*)(a->ws + WS_SCAL);
    float i0 = 0.f, i1 = 0.f, f0 = 0.f, f1 = 0.f;
    if (wave == 7) { const float* gp = gates + (size_t)(t0 + 2 * lane) * 8; i0 = gp[h]; f0 = gp[4 + h]; i1 = gp[8 + h]; f1 = gp[12 + h]; }
    MStage R; mlstm_stage_load<false>(a, L, h, t0, s0, tid, R);
    if (wave == 7) {
        float b0, b1; gates_cumsum(f0, f1, b0, b1, lane);
        const float b_end = __shfl(b1, 63);
        const float w0 = b_end - b0 + i0, w1 = b_end - b1 + i1;
        float mx = fmaxf(w0, w1);
#pragma unroll
        for (int o = 1; o < 64; o <<= 1) mx = fmaxf(mx, __shfl_xor(mx, o));
        eend[2 * lane] = __expf(w0 - mx); eend[2 * lane + 1] = __expf(w1 - mx);
        if (lane == 0) { scal[item] = b_end; scal[512 + item] = mx; }
    }
    fill_vt_tail(VT, tid);
    __syncthreads();
    mlstm_stage_compute<false>(R, lds, lds, EKT, VT, eend, tid);
    __syncthreads();
    float* st = (float*)(a->ws + WS_MST) + (size_t)item * NE_M;
    const int fr = lane & 15, fq = lane >> 4;
    for (int tile = wave; tile < 42; tile += 8) {
        const int et = tile / 6, dt = tile % 6;
        f32x4 acc = {0.f, 0.f, 0.f, 0.f};
#pragma unroll
        for (int ks = 0; ks < 4; ++ks) {
            const bf16x8 av = *(const LAS bf16x8*)(VT + (et * 16 + fr) * 272 + ks * 64 + fq * 16);
            const bf16x8 bv = *(const LAS bf16x8*)(EKT + (dt * 16 + fr) * 272 + ks * 64 + fq * 16);
            acc = MFMA16(av, bv, acc);
        }
#pragma unroll
        for (int j = 0; j < 4; ++j) { const int e = et * 16 + fq * 4 + j; if (e < 97) st[e * 96 + dt * 16 + fr] = acc[j]; }
    }
    __syncthreads();
}

__device__ __forceinline__ float ret_log_gamma(int h) { return __logf(1.f - exp2f(-5.f - (float)h)); }

__device__ __forceinline__ void rotary16(const bf16* rowp, const float* cs, const float* sn, int j0, float scale, v4u& o1, v4u& o2) {
    const v4u u1 = *(const v4u*)(rowp + j0), u2 = *(const v4u*)(rowp + 32 + j0);
    const f32x4 c0 = *(const f32x4*)(cs + j0), c1 = *(const f32x4*)(cs + j0 + 4), s0 = *(const f32x4*)(sn + j0), s1 = *(const f32x4*)(sn + j0 + 4);
    float x1[8] = {bflo(u1.x), bfhi(u1.x), bflo(u1.y), bfhi(u1.y), bflo(u1.z), bfhi(u1.z), bflo(u1.w), bfhi(u1.w)};
    float x2[8] = {bflo(u2.x), bfhi(u2.x), bflo(u2.y), bfhi(u2.y), bflo(u2.z), bfhi(u2.z), bflo(u2.w), bfhi(u2.w)};
    float cc[8] = {c0.x, c0.y, c0.z, c0.w, c1.x, c1.y, c1.z, c1.w}, ss[8] = {s0.x, s0.y, s0.z, s0.w, s1.x, s1.y, s1.z, s1.w};
    float y1[8], y2[8];
#pragma unroll
    for (int i = 0; i < 8; ++i) { y1[i] = (x1[i] * cc[i] - x2[i] * ss[i]) * scale; y2[i] = (x2[i] * cc[i] + x1[i] * ss[i]) * scale; }
    o1 = (v4u){pk2(y1[0], y1[1]), pk2(y1[2], y1[3]), pk2(y1[4], y1[5]), pk2(y1[6], y1[7])};
    o2 = (v4u){pk2(y2[0], y2[1]), pk2(y2[2], y2[3]), pk2(y2[4], y2[5]), pk2(y2[6], y2[7])};
}

__device__ __forceinline__ void store_T8(ldsp dst, int e0, int stride, int l, v4u u) {
    const unsigned w[4] = {u.x, u.y, u.z, u.w};
#pragma unroll
    for (int i = 0; i < 4; ++i) {
        *(LAS unsigned short*)(dst + (e0 + 2 * i) * stride + l * 2) = (unsigned short)(w[i] & 0xffffu);
        *(LAS unsigned short*)(dst + (e0 + 2 * i + 1) * stride + l * 2) = (unsigned short)(w[i] >> 16);
    }
}

__device__ __forceinline__ void phaseC_ret(ArgsP a, int L, int item, ldsp lds, int tid, int lane, int wave) {
    const int bh = item >> 5, c = item & 31, b = bh / 6, h = bh % 6;
    const int t0 = b * SEQ + c * 128, s0 = c * 128;
    ldsp ZKT = lds, VT = lds + 17408;
    const bf16* proj = (const bf16*)(a->ws + WS_PROJ);
    const float* rope = (const float*)(a->ws + WS_ROPE);
    const float lg = ret_log_gamma(h);
    {
        const int l = tid >> 2, jc = tid & 3, j0 = jc * 8;
        const float zeta = __expf((127.f - (float)l) * lg);
        v4u o1, o2;
        rotary16(proj + (size_t)(t0 + l) * NP + PC_RK + h * 64, rope + (size_t)(s0 + l) * 32, rope + 4096 * 32 + (size_t)(s0 + l) * 32, j0, 0.125f * zeta, o1, o2);
        store_T8(ZKT, j0, 272, l, o1); store_T8(ZKT, 32 + j0, 272, l, o2);
        const bf16* vp = proj + (size_t)(t0 + l) * NP + PC_RV + h * 64 + jc * 16;
        const v4u v0 = *(const v4u*)vp, v1 = *(const v4u*)(vp + 8);
        store_T8(VT, jc * 16, 272, l, v0); store_T8(VT, jc * 16 + 8, 272, l, v1);
    }
    __syncthreads();
    float* st = (float*)(a->ws + WS_RST) + (size_t)item * NE_R;
    const int fr = lane & 15, fq = lane >> 4;
#pragma unroll
    for (int tt = 0; tt < 2; ++tt) {
        const int tile = wave * 2 + tt, et = tile >> 2, dt = tile & 3;
        f32x4 acc = {0.f, 0.f, 0.f, 0.f};
#pragma unroll
        for (int ks = 0; ks < 4; ++ks) {
            const bf16x8 av = *(const LAS bf16x8*)(VT + (et * 16 + fr) * 272 + ks * 64 + fq * 16);
            const bf16x8 bv = *(const LAS bf16x8*)(ZKT + (dt * 16 + fr) * 272 + ks * 64 + fq * 16);
            acc = MFMA16(av, bv, acc);
        }
#pragma unroll
        for (int j = 0; j < 4; ++j) st[(et * 16 + fq * 4 + j) * 64 + dt * 16 + fr] = acc[j];
    }
    __syncthreads();
}

__device__ __forceinline__ void phaseC_gmlp(ArgsP a, int L, int item, ldsp lds, int tid, int lane, int wave) {
    const int g = item & 3, bc = item >> 2, b = bc >> 5, c = bc & 31;
    const int t0 = b * SEQ + c * 128;
    ldsp W = lds, GVT = lds + 34816;
    const bf16* proj = (const bf16*)(a->ws + WS_PROJ);
    bf16* cat = (bf16*)(a->ws + WS_CAT);
    {
        const int l = tid >> 2, part = tid & 3;
        const bf16* vp = proj + (size_t)(t0 + l) * NP + PC_GV;
        float ss = 0.f;
#pragma unroll
        for (int i = 0; i < 8; ++i) { const v4u u = *(const v4u*)(vp + part * 64 + i * 8); const unsigned w[4] = {u.x, u.y, u.z, u.w};
#pragma unroll
            for (int q = 0; q < 4; ++q) { const f32x2 g = gelu2((f32x2){bflo(w[q]), bfhi(w[q])}); ss += g.x * g.x + g.y * g.y; } }
        ss += __shfl_xor(ss, 1); ss += __shfl_xor(ss, 2);
        const float rstd = rsqrtf(ss * (1.f / 256.f) + EPS);
        const float* gn = a->in[I_GNG] + (size_t)L * 256 + g * 64 + part * 16;
#pragma unroll
        for (int i = 0; i < 2; ++i) { const v4u u = *(const v4u*)(vp + g * 64 + part * 16 + i * 8); const unsigned w[4] = {u.x, u.y, u.z, u.w}; unsigned o[4];
#pragma unroll
            for (int q = 0; q < 4; ++q) { const f32x2 g = gelu2((f32x2){bflo(w[q]), bfhi(w[q])}) * rstd; o[q] = pk2(g.x * gn[i * 8 + 2 * q], g.y * gn[i * 8 + 2 * q + 1]); }
            store_T8(GVT, part * 16 + i * 8, 272, l, (v4u){o[0], o[1], o[2], o[3]}); }
    }
    {
        const float* wsrc = a->in[I_GWS] + ((size_t)L * 4 + g) * 128 * 128;
#pragma unroll
        for (int i = 0; i < 8; ++i) { const int idx4 = tid + 512 * i, t = idx4 >> 5, s4 = (idx4 & 31) * 4;
            f32x4 w = *(const f32x4*)(wsrc + (size_t)t * 128 + s4);
            if (s4 + 0 > t) w.x = 0.f; if (s4 + 1 > t) w.y = 0.f; if (s4 + 2 > t) w.z = 0.f; if (s4 + 3 > t) w.w = 0.f;
            *(LAS v2u*)(W + t * 272 + s4 * 2) = (v2u){pk2(w.x, w.y), pk2(w.z, w.w)}; }
    }
    __syncthreads();
    const int fr = lane & 15, fq = lane >> 4;
    const float* bs = a->in[I_GBS] + ((size_t)L * 4 + g) * 128;
    float bbv[4]; unsigned short uv[4][4];
#pragma unroll
    for (int j = 0; j < 4; ++j) { bbv[j] = bs[wave * 16 + fq * 4 + j];
#pragma unroll
        for (int n = 0; n < 4; ++n) uv[j][n] = proj[(size_t)(t0 + wave * 16 + fq * 4 + j) * NP + PC_GU + g * 64 + n * 16 + fr]; }
    f32x4 acc[4];
#pragma unroll
    for (int n = 0; n < 4; ++n) acc[n] = (f32x4){0.f, 0.f, 0.f, 0.f};
#pragma unroll
    for (int ks = 0; ks < 4; ++ks) {
        if (ks * 32 <= wave * 16 + 15) {
            const bf16x8 av = *(const LAS bf16x8*)(W + (wave * 16 + fr) * 272 + ks * 64 + fq * 16);
#pragma unroll
            for (int n = 0; n < 4; ++n) { const bf16x8 bv = *(const LAS bf16x8*)(GVT + (n * 16 + fr) * 272 + ks * 64 + fq * 16); acc[n] = MFMA16(av, bv, acc[n]); }
        }
    }
#pragma unroll
    for (int j = 0; j < 4; ++j) { const int t = wave * 16 + fq * 4 + j; const float bb = bbv[j];
#pragma unroll
        for (int n = 0; n < 4; n += 2) { const int e = n * 16 + fr;
            const f32x2 gu = gelu2((f32x2){bf2f(uv[j][n]), bf2f(uv[j][n + 1])});
            cat[(size_t)(t0 + t) * DM + CAT_G + g * 64 + e] = f2bf(gu.x * (acc[n][j] + bb));
            cat[(size_t)(t0 + t) * DM + CAT_G + g * 64 + e + 16] = f2bf(gu.y * (acc[n + 1][j] + bb)); } }
    __syncthreads();
}

__device__ __forceinline__ void phaseD(ArgsP a, ldsp lds, int tid) {
    LAS float* so = (LAS float*)lds; LAS float* sn = so + 512;
    float* scal = (float*)(a->ws + WS_SCAL);
    const int gt = blockIdx.x * NTHR + tid, NT = gridDim.x * NTHR;
    constexpr int TOT_M = 16 * NE_M, TOT_R = 24 * NE_R;
    float v0[32]; float* p0 = nullptr; int bh0 = 0; float dec0 = 0.f; const bool m0 = gt < TOT_M;
    if (m0) { bh0 = gt / NE_M; p0 = (float*)(a->ws + WS_MST) + (size_t)bh0 * NCH * NE_M + (gt - bh0 * NE_M);
#pragma unroll
        for (int c = 0; c < 32; ++c) v0[c] = p0[(size_t)c * NE_M];
    } else if (gt < TOT_M + TOT_R) { const int j = gt - TOT_M; bh0 = j >> 12; dec0 = __expf(128.f * ret_log_gamma(bh0 % 6)); p0 = (float*)(a->ws + WS_RST) + (size_t)bh0 * NCH * NE_R + (j & 4095);
#pragma unroll
        for (int c = 0; c < 32; ++c) v0[c] = p0[(size_t)c * NE_R];
    }
    if (tid < 16) {
        float be[32], ac[32];
#pragma unroll
        for (int c = 0; c < 32; ++c) { be[c] = scal[tid * 32 + c]; ac[c] = scal[512 + tid * 32 + c]; }
        float m = 0.f;
#pragma unroll
        for (int c = 0; c < 32; ++c) { const float mn = fmaxf(be[c] + m, ac[c]); so[tid * 32 + c] = __expf(be[c] + m - mn); sn[tid * 32 + c] = __expf(ac[c] - mn);
            if (blockIdx.x == 0) scal[1024 + tid * 32 + c] = m; m = mn; }
    }
    __syncthreads();
    if (p0 != nullptr) {
        float st = 0.f;
        if (m0) {
#pragma unroll
            for (int c = 0; c < 32; ++c) { p0[(size_t)c * NE_M] = st; st = so[bh0 * 32 + c] * st + sn[bh0 * 32 + c] * v0[c]; }
        } else {
#pragma unroll
            for (int c = 0; c < 32; ++c) { p0[(size_t)c * NE_R] = st; st = dec0 * st + v0[c]; }
        }
    }
    for (int idx = gt + NT; idx < TOT_M + TOT_R; idx += NT) {
        float v[32];
        if (idx < TOT_M) {
            const int bh = idx / NE_M, e = idx - bh * NE_M;
            float* p = (float*)(a->ws + WS_MST) + (size_t)bh * NCH * NE_M + e;
#pragma unroll
            for (int c = 0; c < 32; ++c) v[c] = p[(size_t)c * NE_M];
            float st = 0.f;
#pragma unroll
            for (int c = 0; c < 32; ++c) { p[(size_t)c * NE_M] = st; st = so[bh * 32 + c] * st + sn[bh * 32 + c] * v[c]; }
        } else {
            const int j = idx - TOT_M, bh = j >> 12, e = j & 4095, h = bh % 6;
            const float dec = __expf(128.f * ret_log_gamma(h));
            float* p = (float*)(a->ws + WS_RST) + (size_t)bh * NCH * NE_R + e;
#pragma unroll
            for (int c = 0; c < 32; ++c) v[c] = p[(size_t)c * NE_R];
            float st = 0.f;
#pragma unroll
            for (int c = 0; c < 32; ++c) { p[(size_t)c * NE_R] = st; st = dec * st + v[c]; }
        }
    }
    __syncthreads();
}

__device__ __forceinline__ void phaseE_mlstm(ArgsP a, int L, int item, ldsp lds, int tid, int lane, int wave) {
    const int bh = item >> 5, c = item & 31, b = bh >> 2, h = bh & 3;
    const int t0 = b * SEQ + c * 128, s0 = c * 128;
    ldsp XC = lds, Q = lds + 24576, K = lds + 51200, VT = lds + 77824, SC = lds + 108288, CT = SC;
    LAS float* fl = (LAS float*)(lds + 143104);
    LAS float* bcum = fl, *gsv = fl + 256, *mmv = fl + 384;
    const float* gates = (const float*)(a->ws + WS_GATES);
    const float* scal = (const float*)(a->ws + WS_SCAL);
    const bf16* proj = (const bf16*)(a->ws + WS_PROJ);
    bf16* cat = (bf16*)(a->ws + WS_CAT);
    const float m_prev = scal[1024 + item];
    float i0 = 0.f, i1 = 0.f, f0 = 0.f, f1 = 0.f;
    if (wave == 7) { const float* gp = gates + (size_t)(t0 + 2 * lane) * 8; i0 = gp[h]; f0 = gp[4 + h]; i1 = gp[8 + h]; f1 = gp[12 + h]; }
    MStage R; mlstm_stage_load<true>(a, L, h, t0, s0, tid, R);
    f32x4 ctv[6];
    {   const float* st = (const float*)(a->ws + WS_MST) + (size_t)item * NE_M;
#pragma unroll
        for (int i = 0; i < 6; ++i) { const int idx4 = tid + 512 * i, e = idx4 / 24, d4 = (idx4 % 24) * 4;
            ctv[i] = (f32x4){0.f, 0.f, 0.f, 0.f}; if (e < 97) ctv[i] = *(const f32x4*)(st + e * 96 + d4); } }
    if (wave == 7) {
        float b0, b1; gates_cumsum(f0, f1, b0, b1, lane);
        const float g0 = i0 - b0, g1 = i1 - b1; float p0, p1; gates_prefmax(g0, g1, p0, p1, lane);
        bcum[2 * lane] = b0; bcum[2 * lane + 1] = b1; gsv[2 * lane] = g0; gsv[2 * lane + 1] = g1;
        mmv[2 * lane] = fmaxf(m_prev, p0); mmv[2 * lane + 1] = fmaxf(m_prev, p1);
    }
    mlstm_stage_compute<true>(R, XC, Q, K, VT, nullptr, tid);
    fill_vt_tail(VT, tid);
#pragma unroll
    for (int i = 0; i < 6; ++i) { const int idx4 = tid + 512 * i, e = idx4 / 24, d4 = (idx4 % 24) * 4;
        if (idx4 < 112 * 24) *(LAS v2u*)(CT + e * 208 + d4 * 2) = (v2u){pk2(ctv[i].x, ctv[i].y), pk2(ctv[i].z, ctv[i].w)}; }
    __syncthreads();
    const int fr = lane & 15, fq = lane >> 4;
    const float* mng = a->in[I_MNG] + (size_t)L * 384 + h * 96;
    const float* skp = a->in[I_SKIP] + (size_t)L * 384 + h * 96;
    float gcol[6], scol[6];
#pragma unroll
    for (int n = 0; n < 6; ++n) { gcol[n] = mng[n * 16 + fr]; scol[n] = skp[n * 16 + fr]; }
    v4u zc[3];
#pragma unroll
    for (int i = 0; i < 3; ++i) { const int q = lane + 64 * i, r = q / 12, cc = q % 12; zc[i] = *(const v4u*)(proj + (size_t)(t0 + wave * 16 + r) * NP + PC_MZ + h * 96 + cc * 8); }
    bf16x8 aq[3];
#pragma unroll
    for (int ks = 0; ks < 3; ++ks) aq[ks] = *(const LAS bf16x8*)(Q + (wave * 16 + fr) * 208 + ks * 64 + fq * 16);
    f32x4 acc2[7];
#pragma unroll
    for (int n = 0; n < 7; ++n) { acc2[n] = (f32x4){0.f, 0.f, 0.f, 0.f};
#pragma unroll
        for (int ks = 0; ks < 3; ++ks) { const bf16x8 bv = *(const LAS bf16x8*)(CT + (n * 16 + fr) * 208 + ks * 64 + fq * 16); acc2[n] = MFMA16(aq[ks], bv, acc2[n]); } }
    f32x4 sacc[8];
#pragma unroll
    for (int st = 0; st < 8; ++st) { sacc[st] = (f32x4){0.f, 0.f, 0.f, 0.f};
        if (st <= wave) {
#pragma unroll
            for (int ks = 0; ks < 3; ++ks) { const bf16x8 bv = *(const LAS bf16x8*)(K + (st * 16 + fr) * 208 + ks * 64 + fq * 16); sacc[st] = MFMA16(aq[ks], bv, sacc[st]); } } }
    float mmr[4];
#pragma unroll
    for (int j = 0; j < 4; ++j) mmr[j] = mmv[wave * 16 + fq * 4 + j];
    __syncthreads();
#pragma unroll
    for (int st = 0; st < 8; ++st) {
        if (st <= (wave | 1)) {
            const int s = st * 16 + fr; const float gsl = gsv[s];
#pragma unroll
            for (int j = 0; j < 4; ++j) { const int l = wave * 16 + fq * 4 + j;
                const float wgt = (s <= l) ? __expf(gsl - mmr[j]) : 0.f;
                *(LAS unsigned short*)(SC + l * 272 + s * 2) = f2bf(sacc[st][j] * wgt); }
        }
    }
    asm volatile("" ::: "memory");
    f32x4 acc1[7];
#pragma unroll
    for (int n = 0; n < 7; ++n) acc1[n] = (f32x4){0.f, 0.f, 0.f, 0.f};
#pragma unroll
    for (int ks = 0; ks < 4; ++ks) {
        if (ks * 2 <= wave) {
            const bf16x8 av = *(const LAS bf16x8*)(SC + (wave * 16 + fr) * 272 + ks * 64 + fq * 16);
#pragma unroll
            for (int n = 0; n < 7; ++n) { const bf16x8 bv = *(const LAS bf16x8*)(VT + (n * 16 + fr) * 272 + ks * 64 + fq * 16); acc1[n] = MFMA16(av, bv, acc1[n]); }
        }
    }
#pragma unroll
    for (int i = 0; i < 3; ++i) { const int q = lane + 64 * i, r = q / 12, cc = q % 12; *(LAS v4u*)(Q + (wave * 16 + r) * 208 + cc * 16) = zc[i]; }
#pragma unroll
    for (int j = 0; j < 4; ++j) {
        const int l = wave * 16 + fq * 4 + j;
        const float sint = __expf(m_prev - mmr[j]);
        float den = acc1[6][j] + sint * acc2[6][j];
        den = __shfl(den, lane & 48);
        const float flo = __expf(-(bcum[l] + mmr[j]));
        const float inv = fast_rcp(fmaxf(fabsf(den), flo));
        float hv[6]; float ss = 0.f;
#pragma unroll
        for (int n = 0; n < 6; ++n) { hv[n] = (acc1[n][j] + sint * acc2[n][j]) * inv; ss += hv[n] * hv[n]; }
        ss += __shfl_xor(ss, 1); ss += __shfl_xor(ss, 2); ss += __shfl_xor(ss, 4); ss += __shfl_xor(ss, 8);
        const float rstd = rsqrtf(ss * (1.f / 96.f) + EPS);
#pragma unroll
        for (int n = 0; n < 6; n += 2) { const int e = n * 16 + fr;
            const float xc0 = bf2f(*(const LAS unsigned short*)(XC + l * 192 + e * 2)), xc1 = bf2f(*(const LAS unsigned short*)(XC + l * 192 + (e + 16) * 2));
            const f32x2 sz = silu2((f32x2){bf2f(*(const LAS unsigned short*)(Q + l * 208 + e * 2)), bf2f(*(const LAS unsigned short*)(Q + l * 208 + (e + 16) * 2))});
            *(LAS unsigned short*)(SC + l * 272 + e * 2) = f2bf((hv[n] * rstd * gcol[n] + scol[n] * xc0) * sz.x);
            *(LAS unsigned short*)(SC + l * 272 + (e + 16) * 2) = f2bf((hv[n + 1] * rstd * gcol[n + 1] + scol[n + 1] * xc1) * sz.y); }
    }
#pragma unroll
    for (int i = 0; i < 3; ++i) { const int q = lane + 64 * i, r = q / 12, cc = q % 12;
        *(v4u*)(cat + (size_t)(t0 + wave * 16 + r) * DM + h * 96 + cc * 8) = *(const LAS v4u*)(SC + (wave * 16 + r) * 272 + cc * 16); }
    __syncthreads();
}

__device__ __forceinline__ void phaseE_ret(ArgsP a, int L, int item, ldsp lds, int tid, int lane, int wave) {
    const int bh = item >> 5, c = item & 31, b = bh / 6, h = bh % 6;
    const int t0 = b * SEQ + c * 128, s0 = c * 128;
    ldsp Q = lds, K = lds + 18432, VT = lds + 36864, SC = lds + 54272, RT = lds + 89088;
    const bf16* proj = (const bf16*)(a->ws + WS_PROJ);
    const float* rope = (const float*)(a->ws + WS_ROPE);
    bf16* cat = (bf16*)(a->ws + WS_CAT);
    const float lg = ret_log_gamma(h);
    {
        const int l = tid >> 2, jc = tid & 3, j0 = jc * 8;
        const float* cs = rope + (size_t)(s0 + l) * 32; const float* sn = rope + 4096 * 32 + (size_t)(s0 + l) * 32;
        v4u o1, o2;
        rotary16(proj + (size_t)(t0 + l) * NP + PC_RQ + h * 64, cs, sn, j0, 1.f, o1, o2);
        *(LAS v4u*)(Q + l * 144 + j0 * 2) = o1; *(LAS v4u*)(Q + l * 144 + (32 + j0) * 2) = o2;
        rotary16(proj + (size_t)(t0 + l) * NP + PC_RK + h * 64, cs, sn, j0, 0.125f, o1, o2);
        *(LAS v4u*)(K + l * 144 + j0 * 2) = o1; *(LAS v4u*)(K + l * 144 + (32 + j0) * 2) = o2;
        const bf16* vp = proj + (size_t)(t0 + l) * NP + PC_RV + h * 64 + jc * 16;
        const v4u v0 = *(const v4u*)vp, v1 = *(const v4u*)(vp + 8);
        store_T8(VT, jc * 16, 272, l, v0); store_T8(VT, jc * 16 + 8, 272, l, v1);
        const float* st = (const float*)(a->ws + WS_RST) + (size_t)item * NE_R;
#pragma unroll
        for (int i = 0; i < 2; ++i) { const int idx4 = tid + 512 * i, e = idx4 >> 4, d4 = (idx4 & 15) * 4;
            const f32x4 w = *(const f32x4*)(st + e * 64 + d4);
            *(LAS v2u*)(RT + e * 144 + d4 * 2) = (v2u){pk2(w.x, w.y), pk2(w.z, w.w)}; }
    }
    __syncthreads();
    const int fr = lane & 15, fq = lane >> 4;
    const float* rng = a->in[I_RNG] + (size_t)L * 384 + h * 64;
    float gcol[4];
#pragma unroll
    for (int n = 0; n < 4; ++n) gcol[n] = rng[n * 16 + fr];
    v4u gc[2];
#pragma unroll
    for (int i = 0; i < 2; ++i) { const int q = lane + 64 * i, r = q >> 3, cc = q & 7; gc[i] = *(const v4u*)(proj + (size_t)(t0 + wave * 16 + r) * NP + PC_RG + h * 64 + cc * 8); }
    bf16x8 aq[2];
#pragma unroll
    for (int ks = 0; ks < 2; ++ks) aq[ks] = *(const LAS bf16x8*)(Q + (wave * 16 + fr) * 144 + ks * 64 + fq * 16);
    f32x4 acc2[4];
#pragma unroll
    for (int n = 0; n < 4; ++n) { acc2[n] = (f32x4){0.f, 0.f, 0.f, 0.f};
#pragma unroll
        for (int ks = 0; ks < 2; ++ks) { const bf16x8 bv = *(const LAS bf16x8*)(RT + (n * 16 + fr) * 144 + ks * 64 + fq * 16); acc2[n] = MFMA16(aq[ks], bv, acc2[n]); } }
    f32x4 sacc[8];
#pragma unroll
    for (int st = 0; st < 8; ++st) { sacc[st] = (f32x4){0.f, 0.f, 0.f, 0.f};
        if (st <= wave) {
#pragma unroll
            for (int ks = 0; ks < 2; ++ks) { const bf16x8 bv = *(const LAS bf16x8*)(K + (st * 16 + fr) * 144 + ks * 64 + fq * 16); sacc[st] = MFMA16(aq[ks], bv, sacc[st]); } } }
    float rowf[4];
#pragma unroll
    for (int j = 0; j < 4; ++j) rowf[j] = __expf((float)(fq * 4 + j - fr) * lg);
#pragma unroll
    for (int st = 0; st < 8; ++st) {
        if (st <= (wave | 1)) {
            const int s = st * 16 + fr; const float tf = __expf((float)((wave - st) * 16) * lg);
#pragma unroll
            for (int j = 0; j < 4; ++j) { const int l = wave * 16 + fq * 4 + j;
                const float wgt = (s <= l) ? rowf[j] * tf : 0.f;
                *(LAS unsigned short*)(SC + l * 272 + s * 2) = f2bf(sacc[st][j] * wgt); }
        }
    }
    asm volatile("" ::: "memory");
    f32x4 acc1[4];
#pragma unroll
    for (int n = 0; n < 4; ++n) acc1[n] = (f32x4){0.f, 0.f, 0.f, 0.f};
#pragma unroll
    for (int ks = 0; ks < 4; ++ks) {
        if (ks * 2 <= wave) {
            const bf16x8 av = *(const LAS bf16x8*)(SC + (wave * 16 + fr) * 272 + ks * 64 + fq * 16);
#pragma unroll
            for (int n = 0; n < 4; ++n) { const bf16x8 bv = *(const LAS bf16x8*)(VT + (n * 16 + fr) * 272 + ks * 64 + fq * 16); acc1[n] = MFMA16(av, bv, acc1[n]); }
        }
    }
#pragma unroll
    for (int i = 0; i < 2; ++i) { const int q = lane + 64 * i, r = q >> 3, cc = q & 7; *(LAS v4u*)(Q + (wave * 16 + r) * 144 + cc * 16) = gc[i]; }
#pragma unroll
    for (int j = 0; j < 4; ++j) {
        const int l = wave * 16 + fq * 4 + j;
        const float xi = __expf((float)(l + 1) * lg);
        float hv[4]; float ss = 0.f;
#pragma unroll
        for (int n = 0; n < 4; ++n) { hv[n] = acc1[n][j] + xi * acc2[n][j]; ss += hv[n] * hv[n]; }
        ss += __shfl_xor(ss, 1); ss += __shfl_xor(ss, 2); ss += __shfl_xor(ss, 4); ss += __shfl_xor(ss, 8);
        const float rstd = rsqrtf(ss * (1.f / 64.f) + EPS);
#pragma unroll
        for (int n = 0; n < 4; n += 2) { const int e = n * 16 + fr;
            const f32x2 sg = silu2((f32x2){bf2f(*(const LAS unsigned short*)(Q + l * 144 + e * 2)), bf2f(*(const LAS unsigned short*)(Q + l * 144 + (e + 16) * 2))});
            *(LAS unsigned short*)(SC + l * 272 + e * 2) = f2bf(hv[n] * rstd * gcol[n] * sg.x);
            *(LAS unsigned short*)(SC + l * 272 + (e + 16) * 2) = f2bf(hv[n + 1] * rstd * gcol[n + 1] * sg.y); }
    }
#pragma unroll
    for (int i = 0; i < 2; ++i) { const int q = lane + 64 * i, r = q >> 3, cc = q & 7;
        *(v4u*)(cat + (size_t)(t0 + wave * 16 + r) * DM + CAT_R + h * 64 + cc * 8) = *(const LAS v4u*)(SC + (wave * 16 + r) * 272 + cc * 16); }
    __syncthreads();
}


template <int MODE, int PER>
__device__ __forceinline__ void gemv4_item(const LAS float* A, const float* W, int ldw, int ncol0, int nvalid, int kb, float* out, int ldo, int ocol0, LAS float* red, int tid) {
    constexpr int klen = PER * 16, CH = PER < 32 ? PER : 32;
    const int kq = tid >> 5, c = tid & 31, k0 = kq * PER;
    float acc[4] = {0.f, 0.f, 0.f, 0.f};
    if (c < nvalid) {
        const float* wp = W + (size_t)(kb + k0) * ldw + ncol0 + c;
#pragma unroll
        for (int kk = 0; kk < PER; kk += CH) {
            float w[CH];
#pragma unroll
            for (int i = 0; i < CH; ++i) w[i] = wp[(size_t)(kk + i) * ldw];
#pragma unroll
            for (int i = 0; i < CH; ++i)
#pragma unroll
                for (int r = 0; r < 4; ++r) acc[r] += A[r * klen + k0 + kk + i] * w[i];
        }
    }
#pragma unroll
    for (int r = 0; r < 4; ++r) red[(kq * 4 + r) * 32 + c] = acc[r];
    __syncthreads();
    if (tid < 128) { const int r = tid >> 5; float s = 0.f;
#pragma unroll
        for (int q = 0; q < 16; ++q) s += red[(q * 4 + r) * 32 + c];
        if (c < nvalid) { float* o = out + (size_t)r * ldo + ocol0 + c;
            if (MODE == 0) *o = s; else if (MODE == 1) { const float t = fmaxf(s, 0.f); *o = t * t; } else atomicAdd(o, s); } }
    __syncthreads();
}
__device__ __forceinline__ void precise_norm_to_lds(const float* x0, size_t row_stride, const float* g, LAS float* A, int lane, int wave) {
    if (wave < 4) { const f32x4* xr = (const f32x4*)(x0 + (size_t)wave * row_stride) + lane; f32x4 v[4]; float ss = 0.f;
#pragma unroll
        for (int j = 0; j < 4; ++j) { v[j] = xr[64 * j]; ss += (v[j].x * v[j].x + v[j].y * v[j].y) + (v[j].z * v[j].z + v[j].w * v[j].w); }
        const float rstd = rsqrtf(wave_sum(ss) * (1.f / DM) + EPS);
#pragma unroll
        for (int j = 0; j < 4; ++j) { const f32x4 gv = ((const f32x4*)g)[lane + 64 * j]; *(LAS f32x4*)(A + wave * 1024 + 4 * lane + 256 * j) = v[j] * rstd * gv; } }
    __syncthreads();
}
__device__ __forceinline__ void lds_copy_rows(const float* src, int ld, int kb, int klen, LAS float* A, int tid) {
    for (int i = tid; i < 4 * klen; i += NTHR) { const int r = i / klen, k = i - r * klen; A[i] = src[(size_t)r * ld + kb + k]; }
    __syncthreads();
}
__device__ __forceinline__ void precise_mixer(ArgsP a, int L, int b, ldsp lds, int tid, int lane, int wave) {
    LAS float* XC = (LAS float*)lds, *XM = XC + 384, *Qs = XC + 768, *Ks = XC + 1152, *Vs = XC + 1536;
    const float* projP = (const float*)(a->ws + WS_PROJP); float* catP = (float*)(a->ws + WS_CATP);
    {
        const float* p = projP + (size_t)b * N_IN; float* o = catP + (size_t)b * DM;
        if (tid < 384) { const float x = p[tid]; XM[tid] = x; XC[tid] = silu_f(a->in[I_CONVW][(size_t)L * 4 * 384 + 3 * 384 + tid] * x + a->in[I_CONVB][(size_t)L * 384 + tid]); }
        __syncthreads();
        if (tid < 384) { const int nb = tid >> 2, j = tid & 3; float q = 0.f, k = 0.f, v = 0.f;
#pragma unroll
            for (int i = 0; i < 4; ++i) { const size_t wi = ((size_t)L * 96 + nb) * 16 + i * 4 + j; q += XC[nb * 4 + i] * a->in[I_WQ][wi]; k += XC[nb * 4 + i] * a->in[I_WK][wi]; v += XM[nb * 4 + i] * a->in[I_WV][wi]; }
            Qs[tid] = q; Ks[tid] = k * 0.10206207261596575f; Vs[tid] = v; }
        __syncthreads();
        if (wave < 4) {
            const int h = wave; const int d0 = h * 96 + lane, d1 = h * 96 + 64 + lane; const bool two = lane < 32;
            float s = Qs[d0] * Ks[d0] + (two ? Qs[d1] * Ks[d1] : 0.f); s = wave_sum(s);
            const float ig = p[768 + h] + a->in[I_IB][L * 4 + h], f = p[772 + h] + a->in[I_FB][L * 4 + h];
            const float logf = fminf(f, 0.f) - __logf(1.f + __expf(-fabsf(f)));
            const float mt = fmaxf(logf, ig), wts = __expf(ig - mt), den = s * wts, inv = 1.f / fmaxf(fabsf(den), __expf(-mt));
            const float h0 = den * Vs[d0] * inv, h1 = two ? den * Vs[d1] * inv : 0.f;
            const float rstd = rsqrtf(wave_sum(h0 * h0 + h1 * h1) * (1.f / 96.f) + EPS);
            const float* mg = a->in[I_MNG] + (size_t)L * 384; const float* sk = a->in[I_SKIP] + (size_t)L * 384;
            o[d0] = (h0 * rstd * mg[d0] + sk[d0] * XC[d0]) * silu_f(p[384 + d0]);
            if (two) o[d1] = (h1 * rstd * mg[d1] + sk[d1] * XC[d1]) * silu_f(p[384 + d1]);
        } else {
            for (int h = wave - 4; h < 6; h += 4) { const int d = h * 64 + lane;
                const float s = wave_sum(p[776 + d] * p[1160 + d]) * 0.125f; const float val = s * p[1544 + d];
                const float rstd = rsqrtf(wave_sum(val * val) * (1.f / 64.f) + EPS);
                o[CAT_R + d] = val * rstd * a->in[I_RNG][(size_t)L * 384 + d] * silu_f(p[1928 + d]); }
        }
        if (wave < 4) {
            const int g = wave; float gl[4]; float ss = 0.f;
#pragma unroll
            for (int i = 0; i < 4; ++i) { gl[i] = gelu_tanh(p[2568 + lane + 64 * i]); ss += gl[i] * gl[i]; }
            const float rstd = rsqrtf(wave_sum(ss) * (1.f / 256.f) + EPS);
            float gv = 0.f;
#pragma unroll
            for (int i = 0; i < 4; ++i) if (i == g) gv = gl[i];
            gv = gv * rstd * a->in[I_GNG][(size_t)L * 256 + g * 64 + lane];
            const float w00 = a->in[I_GWS][((size_t)L * 4 + g) * 128 * 128], b0 = a->in[I_GBS][((size_t)L * 4 + g) * 128];
            o[CAT_G + g * 64 + lane] = gelu_tanh(p[2312 + g * 64 + lane]) * (w00 * gv + b0);
        }
        __syncthreads();
    }
}

__global__ void __launch_bounds__(NTHR, 2) fwd_kernel(Args a_unused) {
    extern __shared__ __attribute__((aligned(16))) unsigned char lds_raw[];
    cg::grid_group grid = cg::this_grid();
    ldsp lds = (ldsp)lds_raw;
#define PHASE_BEGIN() int tid_o = threadIdx.x; asm volatile("" : "+v"(tid_o)); const int tid = tid_o, lane = tid & 63, wave = __builtin_amdgcn_readfirstlane(tid >> 6); (void)lane; (void)wave; \
    ArgsP a = (ArgsP)__builtin_amdgcn_kernarg_segment_ptr(); asm volatile("" : "+s"(a)); unsigned char* ws = a->ws; (void)ws; const int G = gridDim.x; (void)G;
    volatile LAS unsigned* MISC = (volatile LAS unsigned*)(lds + LDS_BYTES - 64);
    if (threadIdx.x < 16) MISC[threadIdx.x] = 0u;
    __syncthreads();
    XcdBarrier bar;
    { ArgsP a = (ArgsP)__builtin_amdgcn_kernarg_segment_ptr(); bar = xcd_barrier_post((unsigned*)(a->ws + WS_CTL), MISC); }
#define GRID_SYNC() xcd_barrier(bar)

    {
        PHASE_BEGIN();
        float* rope = (float*)(ws + WS_ROPE);
        for (int idx = blockIdx.x * NTHR + tid; idx < 4096 * 32; idx += G * NTHR) {
            const int pos = idx >> 5, j = idx & 31;
            const float freq = exp2f(-(float)j * (13.287712379549449f / 32.f));
            const double ang = (double)pos * (double)freq;
            double rev = ang * 0.15915494309189535; rev -= __builtin_rint(rev);
            const float fr = (float)rev;
            rope[idx] = __builtin_amdgcn_cosf(fr); rope[4096 * 32 + idx] = __builtin_amdgcn_sinf(fr);
        }
        {
            const int gw = blockIdx.x * NWAVES + wave, NGW = G * NWAVES;
            const float* x = a->in[I_X]; bf16* xb = (bf16*)(ws + WS_H); float* ssq = (float*)(ws + WS_SSQ);
            for (int m0 = gw; m0 < MTOK; m0 += 4 * NGW) {
                f32x4 v[4][4];
#pragma unroll
                for (int r = 0; r < 4; ++r) { const int m = m0 + r * NGW; if (m < MTOK) { const f32x4* xr = (const f32x4*)(x + (size_t)m * DM) + lane;
#pragma unroll
                    for (int j = 0; j < 4; ++j) v[r][j] = xr[64 * j]; } }
#pragma unroll
                for (int r = 0; r < 4; ++r) { const int m = m0 + r * NGW; if (m < MTOK) { float ss = 0.f;
#pragma unroll
                    for (int j = 0; j < 4; ++j) ss += (v[r][j].x * v[r][j].x + v[r][j].y * v[r][j].y) + (v[r][j].z * v[r][j].z + v[r][j].w * v[r][j].w);
                    ss = wave_sum(ss);
                    unsigned long long* o8 = (unsigned long long*)(xb + (size_t)m * DM) + lane;
#pragma unroll
                    for (int j = 0; j < 4; ++j) o8[64 * j] = (unsigned long long)pk2(v[r][j].x, v[r][j].y) | ((unsigned long long)pk2(v[r][j].z, v[r][j].w) << 32);
                    if (lane < 16) ssq[(size_t)m * 16 + lane] = lane == 0 ? ss : 0.f; } }
            }
        }
        convert_weights(a, 0, 0, lds, lane, wave);
        if (blockIdx.x == 0) { float* xP = (float*)(ws + WS_XP); for (int i = tid; i < 4 * DM; i += NTHR) xP[i] = a->in[I_X][(size_t)(i >> 10) * SEQ * DM + (i & 1023)]; }
    }
    { ArgsP a = (ArgsP)__builtin_amdgcn_kernarg_segment_ptr(); asm volatile("" : "+s"(a)); if (a->ws == nullptr) grid.sync(); }
    GRID_SYNC();

    for (int L = 0; L < DEPTH; ++L) {
        if ((int)blockIdx.x < 89) {
            PHASE_BEGIN();
            const float* xP = (const float*)(ws + WS_XP);
            LAS float* Ap = (LAS float*)(lds + 100352); LAS float* red = (LAS float*)(lds + 116736);
            precise_norm_to_lds(L == 0 ? a->in[I_X] : xP, L == 0 ? (size_t)SEQ * DM : (size_t)DM, a->in[I_NMG] + (size_t)L * DM, Ap, lane, wave);
            { const int cg_ = (int)blockIdx.x;
                gemv4_item<0, 64>(Ap, a->in[I_WIN] + (size_t)L * DM * N_IN, N_IN, cg_ * 32, cg_ == 88 ? 8 : 32, 0, (float*)(ws + WS_PROJP), N_IN, cg_ * 32, red, tid); }
        }
        {
            PHASE_BEGIN();
            const size_t wb = (L & 1) ? WS_WBUF1 : 0;
            pg8::Gemm g{(const bf16*)(ws + WS_H), (const bf16*)(ws + wb + WS_WIN), MTOK, NPAD, DM}; pg8::StaticOrder S; S.init(MTOK, NPAD, G, (int)blockIdx.x);
            pg8::EpiScaledBf16<0> E{(bf16*)(ws + WS_PROJ), NP, (const float*)(ws + WS_SSQ), 11, (float*)(ws + WS_GATES), a->in[I_IB] + L * 4, a->in[I_FB] + L * 4};
            for (int rep = 0; rep < 1 + XREP_B; ++rep) pg8::gemm_phase<pg8::EpiScaledBf16<0>, pg8::StaticOrder, GEMM_ALIGN, GEMM_SP2>(lds, g, S, E);
        }
        GRID_SYNC();
        if ((int)blockIdx.x >= (int)gridDim.x - 4) { PHASE_BEGIN(); precise_mixer(a, L, (int)blockIdx.x - (G - 4), lds, tid, lane, wave); }
        for (int rep = 0; rep < 1 + XREP_C; ++rep)
        for (int it = blockIdx.x; it < 1792; it += gridDim.x) {
            PHASE_BEGIN();
            if (it < 512) phaseC_mlstm(a, L, it, lds, tid, lane, wave);
            else if (it < 1280) phaseC_ret(a, L, it - 512, lds, tid, lane, wave);
            else phaseC_gmlp(a, L, it - 1280, lds, tid, lane, wave);
        }
        GRID_SYNC();
        {
            PHASE_BEGIN();
            phaseD(a, lds, tid);
            if ((int)blockIdx.x < 128) { const int pi = blockIdx.x, cg_ = pi & 31, ks = pi >> 5; LAS float* Ap = (LAS float*)lds; LAS float* red = (LAS float*)(lds + 16384);
                lds_copy_rows((const float*)(ws + WS_CATP), DM, ks * 256, 256, Ap, tid);
                gemv4_item<2, 16>(Ap, a->in[I_WOUT] + (size_t)L * DM * DM, DM, cg_ * 32, 32, ks * 256, (float*)(ws + WS_XP), DM, cg_ * 32, red, tid); }
            if (L + 1 < DEPTH) convert_weights(a, L + 1, ((L + 1) & 1) ? WS_WBUF1 : 0, lds, lane, wave);
        }
        GRID_SYNC();
        for (int rep = 0; rep < 1 + XREP_E; ++rep)
        for (int it = blockIdx.x; it < (rep == 0 ? 1280 + 128 : XREP_E_END); it += gridDim.x) {
            PHASE_BEGIN();
            if (it >= 1280) { const int cg_ = it - 1280; LAS float* Ap = (LAS float*)lds; LAS float* red = (LAS float*)(lds + 16384);
                precise_norm_to_lds((const float*)(ws + WS_XP), DM, a->in[I_NFG] + (size_t)L * DM, Ap, lane, wave);
                gemv4_item<1, 64>(Ap, a->in[I_WFF1] + (size_t)L * DM * DFF, DFF, cg_ * 32, 32, 0, (float*)(ws + WS_HIDP), DFF, cg_ * 32, red, tid); continue; }
            if (it < 512) phaseE_mlstm(a, L, it, lds, tid, lane, wave);
            else phaseE_ret(a, L, it - 512, lds, tid, lane, wave);
        }
        GRID_SYNC();
        {
            PHASE_BEGIN();
            const size_t wb = (L & 1) ? WS_WBUF1 : 0;
            pg8::Gemm g{(const bf16*)(ws + WS_CAT), (const bf16*)(ws + wb + WS_WOUT), MTOK, DM, DM}; pg8::StaticOrder S; S.init(MTOK, DM, G, (int)blockIdx.x);
            pg8::EpiResidNorm E{(L == 0) ? a->in[I_X] : a->out, a->out, (bf16*)(ws + WS_H), (float*)(ws + WS_SSQ), nullptr, DM};
            pg8::gemm_phase<pg8::EpiResidNorm, pg8::StaticOrder, true, GEMM_SP2>(lds, g, S, E);
        }
        GRID_SYNC();
        {
            PHASE_BEGIN();
            { const int pi = blockIdx.x, cg_ = pi & 31, ks = pi >> 5; LAS float* Ap = (LAS float*)lds; LAS float* red = (LAS float*)(lds + 16384);
              if (pi < 256) { lds_copy_rows((const float*)(ws + WS_HIDP), DFF, ks * 512, 512, Ap, tid);
                gemv4_item<2, 32>(Ap, a->in[I_WFF2] + (size_t)L * DFF * DM, DM, cg_ * 32, 32, ks * 512, (float*)(ws + WS_XP), DM, cg_ * 32, red, tid); } }
        }
        {
            PHASE_BEGIN();
            const size_t wb = (L & 1) ? WS_WBUF1 : 0;
            pg8::Gemm g{(const bf16*)(ws + WS_H), (const bf16*)(ws + wb + WS_W1), MTOK, DFF, DM}; pg8::StaticOrder S; S.init(MTOK, DFF, G, (int)blockIdx.x);
            pg8::EpiScaledBf16<2> E{(bf16*)(ws + WS_HID), DFF, (const float*)(ws + WS_SSQ), -1, nullptr, nullptr, nullptr};
            for (int rep = 0; rep < 1 + XREP_H; ++rep) pg8::gemm_phase<pg8::EpiScaledBf16<2>, pg8::StaticOrder, GEMM_ALIGN, GEMM_SP2>(lds, g, S, E);
        }
        GRID_SYNC();
        {
            PHASE_BEGIN();
            const size_t wb = (L & 1) ? WS_WBUF1 : 0;
            pg8::Gemm g{(const bf16*)(ws + WS_HID), (const bf16*)(ws + wb + WS_W2), MTOK, DM, DFF}; pg8::StaticOrder S; S.init(MTOK, DM, G, (int)blockIdx.x);
            pg8::EpiResidNorm E{a->out, a->out, (bf16*)(ws + WS_H), (float*)(ws + WS_SSQ), (const float*)(ws + WS_XP), DM};
            pg8::gemm_phase<pg8::EpiResidNorm, pg8::StaticOrder, true, GEMM_SP2>(lds, g, S, E);
        }
        GRID_SYNC();
    }
    {
        PHASE_BEGIN();
        const int gw = blockIdx.x * NWAVES + wave, NGW = G * NWAVES;
        const float* g = a->in[I_FNG]; const float* xP = (const float*)(ws + WS_XP);
        f32x4 gv[4];
#pragma unroll
        for (int j = 0; j < 4; ++j) gv[j] = ((const f32x4*)g)[lane + 64 * j];
        for (int m0 = gw; m0 < MTOK; m0 += 4 * NGW) {
            f32x4 v[4][4];
#pragma unroll
            for (int r = 0; r < 4; ++r) { const int m = m0 + r * NGW; if (m < MTOK) {
                const f32x4* xs = (m & (SEQ - 1)) == 0 ? (const f32x4*)(xP + (size_t)(m >> 12) * DM) + lane : (const f32x4*)(a->out + (size_t)m * DM) + lane;
#pragma unroll
                for (int j = 0; j < 4; ++j) v[r][j] = xs[64 * j]; } }
#pragma unroll
            for (int r = 0; r < 4; ++r) { const int m = m0 + r * NGW; if (m < MTOK) { float ss = 0.f;
#pragma unroll
                for (int j = 0; j < 4; ++j) ss += (v[r][j].x * v[r][j].x + v[r][j].y * v[r][j].y) + (v[r][j].z * v[r][j].z + v[r][j].w * v[r][j].w);
                const float rstd = rsqrtf(wave_sum(ss) * (1.f / DM) + EPS);
                f32x4* xr = (f32x4*)(a->out + (size_t)m * DM) + lane;
#pragma unroll
                for (int j = 0; j < 4; ++j) xr[64 * j] = v[r][j] * rstd * gv[j]; } }
        }
    }
}

extern "C" void kernel_launch(void* const* d_in, const int* in_sizes, int n_in, void* d_out, int out_size, void* d_ws, size_t ws_size, hipStream_t stream) {
    static int grid = 0;
    if (grid == 0) {
        if (n_in != 21 || out_size != MTOK * DM || ws_size < WS_END) { fprintf(stderr, "kernel_launch: unexpected shapes (n_in %d out %d ws %zu)\n", n_in, out_size, ws_size); grid = -1; return; }
        int dev = 0, cus = 0, per_cu = 0;
        hipGetDevice(&dev);
        hipDeviceGetAttribute(&cus, hipDeviceAttributeMultiprocessorCount, dev);
        if (hipFuncSetAttribute((const void*)fwd_kernel, hipFuncAttributeMaxDynamicSharedMemorySize, LDS_BYTES) != hipSuccess) { fprintf(stderr, "kernel_launch: hipFuncSetAttribute failed\n"); grid = -1; return; }
        if (hipOccupancyMaxActiveBlocksPerMultiprocessor(&per_cu, (const void*)fwd_kernel, NTHR, LDS_BYTES) != hipSuccess || per_cu < 1) { fprintf(stderr, "kernel_launch: occupancy query says %d\n", per_cu); per_cu = 1; }
        (void)hipGetLastError();
        grid = cus;
        fprintf(stderr, "kernel_launch: cus %d per_cu %d grid %d\n", cus, per_cu, grid);
    }
    if (grid < 0) return;
    if (hipMemsetAsync((char*)d_ws + WS_CTL, 0, 16384, stream) != hipSuccess) { fprintf(stderr, "kernel_launch: memset failed\n"); return; }
    Args a{};
    for (int i = 0; i < 21; ++i) a.in[i] = (const float*)d_in[i];
    a.out = (float*)d_out; a.ws = (unsigned char*)d_ws;
    void* args[] = {&a};
    hipError_t e = hipLaunchCooperativeKernel((const void*)fwd_kernel, dim3(grid), dim3(NTHR), args, LDS_BYTES, stream);
    if (e != hipSuccess) fprintf(stderr, "cooperative launch failed: %s (grid %d)\n", hipGetErrorString(e), grid);
}
```

```cpp
#define EPI_BATCH 1
#include <hip/hip_runtime.h>
#include <hip/hip_cooperative_groups.h>
#include <cstdio>
#include <cstdint>
namespace cg = cooperative_groups;
namespace pg8 {
#define PG8_LAS __attribute__((address_space(3)))
typedef unsigned short bf16_t;
typedef short bf16x8 __attribute__((ext_vector_type(8)));
typedef float f32x4 __attribute__((ext_vector_type(4)));
typedef unsigned u32x4 __attribute__((ext_vector_type(4)));
constexpr int BM = 256, BK = 64, HALF = 128, HTB = HALF * BK * 2  , STAGE_BYTES = 8 * HTB, NXCD = 8, WGM = 8;

__host__ __device__ __forceinline__ int lds_byte(int r, int c) { const int st = (r >> 4) * 2 + (c >> 5), rr = r & 15, cc = c & 31, ob = rr * 64 + cc * 2; return st * 1024 + (ob ^ (((ob >> 9) & 1) << 5)); }
__host__ __device__ __forceinline__ void stage_rc(int b, int& R, int& C) { const int st = b / 1024, sb = b % 1024, swz = sb ^ (((sb >> 9) & 1) << 5); R = (st >> 1) * 16 + swz / 64; C = (st & 1) * 32 + (swz % 64) / 2; }
__host__ __device__ __forceinline__ int perm32(int rho) { const int n = rho >> 4, i = rho & 15; return 8 * (i >> 2) + 4 * n + (i & 3); }

struct Unit { int pm, pn; };
struct Gemm { const bf16_t* A; const bf16_t* Bt; int M, N, K; };

struct StaticOrder {
    int nM, nN, nwg, G, c;
    __host__ __device__ void init(int M, int N, int G_, int c_) { nM = M / BM; nN = N / BM; nwg = nM * nN; G = G_; c = c_; }
    __host__ __device__ bool next(int i, Unit& u) const {
        const long L = (long)i * G + c; if (L >= nwg) return false;
        int wgid = (int)L; { const int q = nwg / NXCD, r = nwg % NXCD, xcd = wgid % NXCD, off = wgid / NXCD; wgid = (xcd < r ? xcd * (q + 1) : r * (q + 1) + (xcd - r) * q) + off; }
        const int nig = WGM * nN, gid = wgid / nig, fm = gid * WGM, gsz = (nM - fm) < WGM ? (nM - fm) : WGM;
        u.pm = fm + ((wgid % nig) % gsz); u.pn = (wgid % nig) / gsz; return true;
    }
    __device__ __forceinline__ void a_ready(const Unit&) const {}
    __device__ __forceinline__ void done(const Unit&) const {}
};

__device__ __forceinline__ unsigned cvt_pk_bf16(float lo, float hi) { unsigned r; asm volatile("v_cvt_pk_bf16_f32 %0, %1, %2" : "=v"(r) : "v"(lo), "v"(hi)); return r; }
typedef float f32x2 __attribute__((ext_vector_type(2)));
template <int ACT> struct EpiBf16 {
    static constexpr bool PERM = true, AFTER_DRAIN = false;
    bf16_t* O; int ldc;
    __device__ __forceinline__ void operator()(const f32x4 (&acc)[2][2][4][2], const Unit& u, int wr, int wc, int fr, int fq) const {
        const int row0 = u.pm * BM + wr * 64 + fr; const int col0 = u.pn * BM + wc * 32 + 8 * fq;
#pragma unroll
        for (int ai = 0; ai < 2; ++ai)
#pragma unroll
            for (int m = 0; m < 4; ++m) { bf16_t* rowp = O + (size_t)(row0 + ai * HALF + m * 16) * ldc + col0;
#pragma unroll
                for (int bj = 0; bj < 2; ++bj) { f32x4 v0 = acc[ai][bj][m][0], v1 = acc[ai][bj][m][1];
                    if (ACT == 2) {
#pragma unroll
                        for (int e = 0; e < 4; ++e) { float a = fmaxf(v0[e], 0.f), b = fmaxf(v1[e], 0.f); v0[e] = a * a; v1[e] = b * b; } }
                    u32x4 w; w.x = cvt_pk_bf16(v0[0], v0[1]); w.y = cvt_pk_bf16(v0[2], v0[3]); w.z = cvt_pk_bf16(v1[0], v1[1]); w.w = cvt_pk_bf16(v1[2], v1[3]);
                    *(u32x4*)(rowp + bj * HALF) = w; } }
    }
};
struct EpiResid {
    static constexpr bool PERM = false, AFTER_DRAIN = false;
    const float* base; float* out; int ldc;
    __device__ __forceinline__ void operator()(const f32x4 (&acc)[2][2][4][2], const Unit& u, int wr, int wc, int fr, int fq) const {
        const int col0 = u.pn * BM + wc * 32 + 4 * fq;
#pragma unroll
        for (int ai = 0; ai < 2; ++ai)
#pragma unroll
            for (int m = 0; m < 4; ++m) { const size_t off = (size_t)(u.pm * BM + ai * HALF + wr * 64 + m * 16 + fr) * ldc + col0;
#pragma unroll
                for (int bj = 0; bj < 2; ++bj)
#pragma unroll
                    for (int n = 0; n < 2; ++n) { const f32x4 bs = *(const f32x4*)(base + off + bj * HALF + n * 16); *(f32x4*)(out + off + bj * HALF + n * 16) = bs + acc[ai][bj][m][n]; } }
    }
};
__device__ __forceinline__ float row_rstd(const float* ssq, int row) {
    const f32x4* p = (const f32x4*)(ssq + (size_t)row * 16);
    const f32x4 a = p[0], b = p[1], c = p[2], d = p[3];
    const float s = (((a[0] + a[1]) + (a[2] + a[3])) + ((b[0] + b[1]) + (b[2] + b[3]))) + (((c[0] + c[1]) + (c[2] + c[3])) + ((d[0] + d[1]) + (d[2] + d[3])));
    return rsqrtf(s * (1.0f / 1024.0f) + 1e-6f);
}
#ifndef EPI_BATCH
#define EPI_BATCH 2
#endif
template <int ACT> struct EpiScaledBf16 {
    static constexpr bool PERM = true, AFTER_DRAIN = false;
    bf16_t* O; int ldc; const float* ssq; int gate_pn; float* gates; const float* ib; const float* fb;
    __device__ __forceinline__ void operator()(const f32x4 (&acc)[2][2][4][2], const Unit& u, int wr, int wc, int fr, int fq) const {
        const int row0 = u.pm * BM + wr * 64 + fr; const int col0 = u.pn * BM + wc * 32 + 8 * fq;
        const bool gate_tile = (u.pn == gate_pn);
        if (gate_tile && !(wc == 0 && fq == 0)) return;
#pragma unroll
        for (int ai = 0; ai < 2; ++ai)
#pragma unroll
        for (int mh = 0; mh < 4; mh += EPI_BATCH) {
            f32x4 p[EPI_BATCH][4]; float rs[EPI_BATCH];
#pragma unroll
            for (int m = 0; m < EPI_BATCH; ++m)
#pragma unroll
                for (int q = 0; q < 4; ++q) p[m][q] = *((const f32x4*)(ssq + (size_t)(row0 + ai * HALF + (mh + m) * 16) * 16) + q);
#pragma unroll
            for (int m = 0; m < EPI_BATCH; ++m) { const f32x4 t = (p[m][0] + p[m][1]) + (p[m][2] + p[m][3]); rs[m] = rsqrtf(((t[0] + t[1]) + (t[2] + t[3])) * (1.0f / 1024.0f) + 1e-6f); }
#pragma unroll
            for (int mm = 0; mm < EPI_BATCH; ++mm) { const int m = mh + mm; const int row = row0 + ai * HALF + m * 16; const float r = rs[mm];
                if (gate_tile) {
                    const f32x4 bi = *(const f32x4*)ib, bf = *(const f32x4*)fb;
                    *(f32x4*)(gates + (size_t)row * 8) = acc[ai][0][m][0] * r + bi; *(f32x4*)(gates + (size_t)row * 8 + 4) = acc[ai][0][m][1] * r + bf;
                } else {
                    bf16_t* rowp = O + (size_t)row * ldc + col0;
#pragma unroll
                    for (int bj = 0; bj < 2; ++bj) { f32x4 v0 = acc[ai][bj][m][0] * r, v1 = acc[ai][bj][m][1] * r;
                        if (ACT == 2) {
#pragma unroll
                            for (int e = 0; e < 4; ++e) { float a = fmaxf(v0[e], 0.f), b = fmaxf(v1[e], 0.f); v0[e] = a * a; v1[e] = b * b; } }
                        u32x4 w; w.x = cvt_pk_bf16(v0[0], v0[1]); w.y = cvt_pk_bf16(v0[2], v0[3]); w.z = cvt_pk_bf16(v1[0], v1[1]); w.w = cvt_pk_bf16(v1[2], v1[3]);
                        *(u32x4*)(rowp + bj * HALF) = w; }
                }
            }
            asm volatile("" ::: "memory");
        }
    }
};
struct EpiResidNorm {
    static constexpr bool PERM = false, AFTER_DRAIN = false;
    const float* base; float* out; bf16_t* xb; float* ssq; const float* xP; int ldc;
    __device__ __forceinline__ void operator()(const f32x4 (&acc)[2][2][4][2], const Unit& u, int wr, int wc, int fr, int fq) const {
        typedef unsigned u32x2v __attribute__((ext_vector_type(2)));
        const int col0 = u.pn * BM + wc * 32 + 4 * fq;
#pragma unroll
        for (int ai = 0; ai < 2; ++ai)
#pragma unroll
        for (int mh = 0; mh < 4; mh += EPI_BATCH) {
            f32x4 pre[EPI_BATCH][2][2];
#pragma unroll
            for (int mm = 0; mm < EPI_BATCH; ++mm) { const int m = mh + mm; const int row = u.pm * BM + ai * HALF + wr * 64 + m * 16 + fr; const bool p0 = xP != nullptr && (row & 4095) == 0;
                const float* src = p0 ? xP + (size_t)(row >> 12) * ldc + col0 : base + (size_t)row * ldc + col0;
#pragma unroll
                for (int bj = 0; bj < 2; ++bj)
#pragma unroll
                    for (int n = 0; n < 2; ++n) pre[mm][bj][n] = *(const f32x4*)(src + bj * HALF + n * 16); }
#pragma unroll
            for (int mm = 0; mm < EPI_BATCH; ++mm) { const int m = mh + mm; const int row = u.pm * BM + ai * HALF + wr * 64 + m * 16 + fr; const size_t off = (size_t)row * ldc + col0; float s = 0.f;
                const bool p0 = xP != nullptr && (row & 4095) == 0;
#pragma unroll
                for (int bj = 0; bj < 2; ++bj)
#pragma unroll
                    for (int n = 0; n < 2; ++n) { const int co = bj * HALF + n * 16;
                        f32x4 v = pre[mm][bj][n]; if (!p0) v = v + acc[ai][bj][m][n];
                        *(f32x4*)(out + off + co) = v; s += (v[0] * v[0] + v[1] * v[1]) + (v[2] * v[2] + v[3] * v[3]);
                        u32x2v w; w.x = cvt_pk_bf16(v[0], v[1]); w.y = cvt_pk_bf16(v[2], v[3]); *(u32x2v*)(xb + off + co) = w; }
                s += __shfl_xor(s, 16); s += __shfl_xor(s, 32);
                if (fq == 0) ssq[(size_t)row * 16 + u.pn * 4 + wc] = s; }
            asm volatile("" ::: "memory");
        }
    }
};
struct EpiNull {
    static constexpr bool PERM = false, AFTER_DRAIN = false;
    float* sink;
    __device__ __forceinline__ void operator()(const f32x4 (&acc)[2][2][4][2], const Unit& u, int wr, int wc, int fr, int fq) const {
        float s = 0.f;
#pragma unroll
        for (int ai = 0; ai < 2; ++ai)
#pragma unroll
            for (int bj = 0; bj < 2; ++bj)
#pragma unroll
                for (int m = 0; m < 4; ++m)
#pragma unroll
                    for (int n = 0; n < 2; ++n) s += (acc[ai][bj][m][n][0] + acc[ai][bj][m][n][1]) + (acc[ai][bj][m][n][2] + acc[ai][bj][m][n][3]);
        if (s == 1.2345678e33f) sink[0] = s;
    }
};
struct PreNone { __device__ __forceinline__ void operator()() const {} };
template <class Epi, class Sched, bool ALIGN_EPI = false, bool SP2 = false, class Pre = PreNone>
__device__ __forceinline__ void gemm_phase(PG8_LAS unsigned char* lds, const Gemm g, const Sched& S, const Epi& E, const Pre& P = Pre()) {
    int tid_o = threadIdx.x; asm volatile("" : "+v"(tid_o)); const int tid = tid_o, wid = __builtin_amdgcn_readfirstlane(tid >> 6), lane = tid & 63, wr = wid >> 2, wc = wid & 3, fr = lane & 15, fq = lane >> 4;
    const int K = g.K, nt = K / BK;
    unsigned voffA[2], voffB[2];
#pragma unroll
    for (int i = 0; i < 2; ++i) { int R, C; stage_rc(tid * 16 + i * 8192, R, C); const int Rb = Epi::PERM ? ((R & ~31) + perm32(R & 31)) : R;
        voffA[i] = (unsigned)(R * K + C) * 2u; voffB[i] = (unsigned)(Rb * K + C) * 2u; }
    const size_t kstep = (size_t)(BK * 2);
    const size_t hstep = (size_t)HALF * K * 2;
    const size_t tstep = 2 * hstep;
    const unsigned ldsw = (unsigned)wid * 1024u;
    const int aoff = lds_byte(wr * 64 + fr, fq * 8), boff = lds_byte(wc * 32 + fr, fq * 8);
#define PG8_SA(b, h) (((b) * 2 + (h)) * HTB)
#define PG8_SB(b, h) ((4 + (b) * 2 + (h)) * HTB)
#define PG8_STAGE(bufoff, gbase, voff) do { _Pragma("unroll") for (int _i = 0; _i < 2; ++_i) \
        __builtin_amdgcn_global_load_lds((const unsigned*)((const char*)(gbase) + (voff)[_i]), (PG8_LAS unsigned*)(lds + (bufoff) + ldsw + _i * 8192), 16, 0, 0); } while (0)
#define PG8_LDA(dst, b, h) do { _Pragma("unroll") for (int m = 0; m < 4; ++m) _Pragma("unroll") for (int k = 0; k < 2; ++k) dst[m][k] = *(const PG8_LAS bf16x8*)(lds + PG8_SA(b, h) + aoff + m * 2048 + k * 1024); } while (0)
#define PG8_LDB(dst, b, h) do { _Pragma("unroll") for (int n = 0; n < 2; ++n) _Pragma("unroll") for (int k = 0; k < 2; ++k) dst[n][k] = *(const PG8_LAS bf16x8*)(lds + PG8_SB(b, h) + boff + n * 2048 + k * 1024); } while (0)
#define PG8_MMA(ai, bj, At, Bt) do { __builtin_amdgcn_s_setprio(1); _Pragma("unroll") for (int m = 0; m < 4; ++m) _Pragma("unroll") for (int n = 0; n < 2; ++n) _Pragma("unroll") for (int k = 0; k < 2; ++k) \
        acc[ai][bj][m][n] = __builtin_amdgcn_mfma_f32_16x16x32_bf16(Bt[n][k], At[m][k], acc[ai][bj][m][n], 0, 0, 0); __builtin_amdgcn_s_setprio(0); } while (0)
#define PG8_WAIT_V(n) asm volatile("s_waitcnt vmcnt(" #n ")" ::: "memory")
#define PG8_WAIT_L(n) asm volatile("s_waitcnt lgkmcnt(" #n ")" ::: "memory")
#define PG8_BAR __builtin_amdgcn_s_barrier()
#define PG8_SCHED __builtin_amdgcn_sched_barrier(0)
    Unit cur, nxt; int ui = 0;
    if (!S.next(0, cur)) return;
    f32x4 acc[2][2][4][2];
#pragma unroll
    for (int a = 0; a < 2; ++a)
#pragma unroll
        for (int b = 0; b < 2; ++b)
#pragma unroll
            for (int m = 0; m < 4; ++m)
#pragma unroll
                for (int n = 0; n < 2; ++n) acc[a][b][m][n] = (f32x4){0.f, 0.f, 0.f, 0.f};
    bf16x8 At[4][2], B0[2][2], B1[2][2];
    const char* cA = (const char*)g.A + (size_t)cur.pm * tstep; const char* cB = (const char*)g.Bt + (size_t)cur.pn * tstep;
    S.a_ready(cur);
    if constexpr (SP2) {
        PG8_STAGE(PG8_SB(0, 0), cB, voffB); PG8_STAGE(PG8_SB(0, 1), cB + hstep, voffB); PG8_STAGE(PG8_SA(0, 0), cA, voffA); PG8_STAGE(PG8_SA(0, 1), cA + hstep, voffA);
        P();
        if (wr == 1) PG8_BAR;
        PG8_WAIT_V(2); PG8_BAR;
        PG8_STAGE(PG8_SB(1, 0), cB + kstep, voffB); PG8_STAGE(PG8_SA(1, 0), cA + kstep, voffA); PG8_STAGE(PG8_SB(1, 1), cB + hstep + kstep, voffB);
        PG8_WAIT_V(6); PG8_BAR;
    } else {
        PG8_STAGE(PG8_SB(0, 0), cB, voffB); PG8_STAGE(PG8_SA(0, 0), cA, voffA); PG8_STAGE(PG8_SB(0, 1), cB + hstep, voffB); PG8_STAGE(PG8_SA(0, 1), cA + hstep, voffA);
        if (wr == 1) PG8_BAR;
        PG8_WAIT_V(4); PG8_BAR;
        PG8_STAGE(PG8_SB(1, 0), cB + kstep, voffB); PG8_STAGE(PG8_SA(1, 0), cA + kstep, voffA); PG8_STAGE(PG8_SB(1, 1), cB + hstep + kstep, voffB);
        PG8_WAIT_V(6); PG8_BAR;
    }
    for (;;) {
        const bool has_next = S.next(ui + 1, nxt);
        const char* nA = has_next ? (const char*)g.A + (size_t)nxt.pm * tstep : cA; const char* nB = has_next ? (const char*)g.Bt + (size_t)nxt.pn * tstep : cB;
        for (int t = 0; t < nt; t += 2) {
            const bool last = (t == nt - 2);
            const char* a1 = cA + (size_t)(t + 1) * kstep;
            const char* a2 = last ? nA : cA + (size_t)(t + 2) * kstep; const char* b2 = last ? nB : cB + (size_t)(t + 2) * kstep;
            const char* a3 = a2 + kstep; const char* b3 = b2 + kstep;
            if (last && has_next) S.a_ready(nxt);
            if constexpr (SP2) {
            PG8_LDB(B0, 0, 0); PG8_LDB(B1, 0, 1); PG8_SCHED; PG8_LDA(At, 0, 0); PG8_STAGE(PG8_SA(1, 1), a1 + hstep, voffA);
            PG8_WAIT_V(8); PG8_WAIT_L(0); PG8_BAR; PG8_MMA(0, 0, At, B0); PG8_MMA(0, 1, At, B1); PG8_BAR; PG8_SCHED;
            PG8_LDA(At, 0, 1); PG8_STAGE(PG8_SB(0, 0), b2, voffB); PG8_STAGE(PG8_SB(0, 1), b2 + hstep, voffB); PG8_STAGE(PG8_SA(0, 0), a2, voffA);
            PG8_WAIT_V(8); PG8_WAIT_L(0); PG8_BAR; PG8_MMA(1, 0, At, B0); PG8_MMA(1, 1, At, B1); PG8_BAR; PG8_SCHED;
            PG8_LDB(B0, 1, 0); PG8_LDB(B1, 1, 1); PG8_SCHED; PG8_LDA(At, 1, 0); PG8_STAGE(PG8_SA(0, 1), a2 + hstep, voffA);
            PG8_WAIT_V(8); PG8_WAIT_L(0); PG8_BAR; PG8_MMA(0, 0, At, B0); PG8_MMA(0, 1, At, B1); PG8_BAR; PG8_SCHED;
            PG8_LDA(At, 1, 1); PG8_STAGE(PG8_SB(1, 0), b3, voffB); PG8_STAGE(PG8_SB(1, 1), b3 + hstep, voffB); PG8_STAGE(PG8_SA(1, 0), a3, voffA);
            PG8_WAIT_V(8); PG8_WAIT_L(0); PG8_BAR; PG8_MMA(1, 0, At, B0); PG8_MMA(1, 1, At, B1); PG8_BAR; PG8_SCHED;
            } else {
            PG8_LDB(B0, 0, 0); PG8_SCHED; PG8_LDA(At, 0, 0); PG8_STAGE(PG8_SA(1, 1), a1 + hstep, voffA);
            PG8_WAIT_L(8); PG8_BAR; PG8_WAIT_L(0); PG8_MMA(0, 0, At, B0); PG8_BAR; PG8_SCHED;
            PG8_LDB(B1, 0, 1); PG8_STAGE(PG8_SB(0, 0), b2, voffB);
            PG8_BAR; PG8_WAIT_L(0); PG8_MMA(0, 1, At, B1); PG8_BAR;
            PG8_LDA(At, 0, 1); PG8_STAGE(PG8_SA(0, 0), a2, voffA);
            PG8_BAR; PG8_WAIT_L(0); PG8_MMA(1, 0, At, B0); PG8_BAR; PG8_SCHED;
            PG8_STAGE(PG8_SB(0, 1), b2 + hstep, voffB);
            PG8_WAIT_V(6); PG8_BAR; PG8_MMA(1, 1, At, B1); PG8_BAR;
            PG8_LDB(B0, 1, 0); PG8_SCHED; PG8_LDA(At, 1, 0); PG8_STAGE(PG8_SA(0, 1), a2 + hstep, voffA);
            PG8_WAIT_L(8); PG8_BAR; PG8_WAIT_L(0); PG8_MMA(0, 0, At, B0); PG8_BAR; PG8_SCHED;
            PG8_LDB(B1, 1, 1); PG8_STAGE(PG8_SB(1, 0), b3, voffB);
            PG8_BAR; PG8_WAIT_L(0); PG8_MMA(0, 1, At, B1); PG8_BAR;
            PG8_LDA(At, 1, 1); PG8_STAGE(PG8_SA(1, 0), a3, voffA);
            PG8_BAR; PG8_WAIT_L(0); PG8_MMA(1, 0, At, B0); PG8_BAR; PG8_SCHED;
            PG8_STAGE(PG8_SB(1, 1), b3 + hstep, voffB);
            PG8_WAIT_V(6); PG8_BAR; PG8_MMA(1, 1, At, B1); PG8_BAR;
            }
        }
        if constexpr (ALIGN_EPI) { if (wr == 0) PG8_BAR; }
        if constexpr (!Epi::AFTER_DRAIN) { E(acc, cur, wr, wc, fr, fq); S.done(cur); }
        if (!has_next) break;
#pragma unroll
        for (int a = 0; a < 2; ++a)
#pragma unroll
            for (int b = 0; b < 2; ++b)
#pragma unroll
                for (int m = 0; m < 4; ++m)
#pragma unroll
                    for (int n = 0; n < 2; ++n) acc[a][b][m][n] = (f32x4){0.f, 0.f, 0.f, 0.f};
        cur = nxt; cA = nA; cB = nB; ++ui;
        if constexpr (ALIGN_EPI) { if (wr == 1) PG8_BAR; }
    }
    PG8_WAIT_V(0);
    if constexpr (!ALIGN_EPI) { if (wr == 0) PG8_BAR; }
    PG8_BAR;
    if constexpr (Epi::AFTER_DRAIN) { E.fused(acc, cur, wr, wc, fr, fq, lds, wid, lane); S.done(cur); }
#undef PG8_SA
#undef PG8_SB
#undef PG8_STAGE
#undef PG8_LDA
#undef PG8_LDB
#undef PG8_MMA
#undef PG8_WAIT_V
#undef PG8_WAIT_L
#undef PG8_BAR
#undef PG8_SCHED
}
}

constexpr int NWAVES = 8, NTHR = 512;
constexpr int BATCH = 4, SEQ = 4096, DM = 1024, DEPTH = 4, MTOK = BATCH * SEQ;
constexpr int N_IN = 2824, NP = 2816, NPAD = 3072, DFF = 4096;
constexpr int NCH = 32;
constexpr int PC_MX = 0, PC_MZ = 384, PC_RQ = 768, PC_RK = 1152, PC_RV = 1536, PC_RG = 1920, PC_GU = 2304, PC_GV = 2560;
constexpr int CAT_R = 384, CAT_G = 768;
constexpr float EPS = 1e-6f;
constexpr int NE_M = 97 * 96;
constexpr int NE_R = 64 * 64;

constexpr size_t MiB = 1u << 20;
constexpr size_t WS_CTL = 0;
constexpr size_t WS_WIN = 1 * MiB, WS_WOUT = 7 * MiB, WS_W1 = 9 * MiB, WS_W2 = 17 * MiB;
constexpr size_t WS_ROPE = 25 * MiB;
constexpr size_t WS_GATES = 26 * MiB;
constexpr size_t WS_SCAL = 27 * MiB;
constexpr size_t WS_XP = 27 * MiB + 65536;
constexpr size_t WS_PROJP = WS_XP + 16384;
constexpr size_t WS_CATP = WS_PROJP + 49152;
constexpr size_t WS_HIDP = WS_CATP + 16384;
constexpr size_t WS_H = 28 * MiB;
constexpr size_t WS_PROJ = 60 * MiB;
constexpr size_t WS_CAT = 148 * MiB;
constexpr size_t WS_MST = 180 * MiB;
constexpr size_t WS_RST = 199 * MiB;
constexpr size_t WS_HID = 60 * MiB;
constexpr size_t WS_WBUF1 = 210 * MiB;
constexpr size_t WS_SSQ = 236 * MiB;
constexpr size_t WS_END = 237 * MiB;
static_assert(WS_MST + (size_t)512 * NE_M * 4 <= WS_RST && WS_RST + (size_t)768 * NE_R * 4 <= 211 * MiB, "ws map");
static_assert(WS_HID + (size_t)MTOK * DFF * 2 <= WS_RST, "hid overlay");

#ifndef XREP_A
#define XREP_A 0
#endif
#ifndef XREP_C
#define XREP_C 0
#endif
#ifndef XREP_E_END
#define XREP_E_END 1280
#endif
#ifndef XREP_E
#define XREP_E 0
#endif
#ifndef XREP_D
#define XREP_D 0
#endif
#ifndef XREP_B
#define XREP_B 0
#endif
#ifndef XREP_H
#define XREP_H 0
#endif
#ifndef GEMM_SP2
#define GEMM_SP2 true
#endif
#ifndef GEMM_ALIGN
#define GEMM_ALIGN true
#endif
#ifndef XREP_G
#define XREP_G 0
#endif
constexpr int LDS_BYTES = 147456;

#define LAS __attribute__((address_space(3)))
typedef unsigned short bf16;
typedef unsigned v4u __attribute__((ext_vector_type(4)));
typedef unsigned v2u __attribute__((ext_vector_type(2)));
typedef float f32x4 __attribute__((ext_vector_type(4)));
typedef short bf16x8 __attribute__((ext_vector_type(8)));
typedef LAS unsigned char* ldsp;

__device__ __forceinline__ unsigned pk2(float lo, float hi) { return pg8::cvt_pk_bf16(lo, hi); }
__device__ __forceinline__ unsigned short f2bf(float f) { return (unsigned short)(pg8::cvt_pk_bf16(f, 0.f) & 0xffffu); }
__device__ __forceinline__ float bflo(unsigned u) { return __uint_as_float(u << 16); }
__device__ __forceinline__ float bfhi(unsigned u) { return __uint_as_float(u & 0xffff0000u); }
__device__ __forceinline__ float bf2f(unsigned short h) { return __uint_as_float((unsigned)h << 16); }
__device__ __forceinline__ float fast_rcp(float x) { return __builtin_amdgcn_rcpf(x); }
__device__ __forceinline__ float silu_f(float x) { return x * fast_rcp(1.f + __expf(-x)); }
__device__ __forceinline__ float gelu_tanh(float x) { const float u = 0.7978845608f * (x + 0.044715f * x * x * x); const float r = fast_rcp(__expf(2.f * u) + 1.f); return x - x * r; }
__device__ __forceinline__ float wave_sum(float v) {
#pragma unroll
    for (int o = 1; o < 64; o <<= 1) v += __shfl_xor(v, o);
    return v;
}
#define XB_TMO      128
#define XB_XCNT(j)  (256  + 64 * (j))
#define XB_XSUB(j)  (1280 + 64 * (j))
#define XB_XGEN(j)  (2304 + 64 * (j))
#define XB_TOP      3328
#define XB_TOPGEN   3392
#define XCD_BAR_WORDS 3456
#define XB_SPIN_CAP (1u << 18)

__device__ __forceinline__ unsigned xb_ld(unsigned* p)              { return __hip_atomic_load(p, __ATOMIC_RELAXED, __HIP_MEMORY_SCOPE_AGENT); }
__device__ __forceinline__ unsigned xb_add(unsigned* p, unsigned v) { return __hip_atomic_fetch_add(p, v, __ATOMIC_RELAXED, __HIP_MEMORY_SCOPE_AGENT); }
__device__ __forceinline__ unsigned xb_xcc_id() { return (unsigned)__builtin_amdgcn_s_getreg((3 << 11) | 20) & 0xFu; }
#define XB_SPIN(cond, bar) do { unsigned _sp = 0; while (cond) { __builtin_amdgcn_s_sleep(1); \
    if ((++_sp & 255u) == 0u) { if (xb_ld(&(bar)[XB_TMO])) break; if (_sp > XB_SPIN_CAP) { atomicAdd(&(bar)[XB_TMO], 1u); break; } } } } while (0)

struct XcdBarrier {
    unsigned* bar; unsigned x;
    volatile LAS unsigned* st;
};

__device__ __forceinline__ XcdBarrier xcd_barrier_post(unsigned* bar, volatile LAS unsigned* st) {
    XcdBarrier b; b.bar = bar; b.x = xb_xcc_id(); b.st = st;
    if (threadIdx.x == 0) (void)xb_add(&bar[XB_XCNT(b.x)], 1u);
    return b;
}
__device__ __forceinline__ void xcd_barrier_complete(unsigned* bar, unsigned x, unsigned& nloc, unsigned& nx) {
    const unsigned G = gridDim.x * gridDim.y * gridDim.z;
    unsigned sum, cnt, mine, sp = 0u;
    for (;;) {
        sum = 0u; cnt = 0u; mine = 0u;
#pragma unroll
        for (unsigned j = 0; j < 16; ++j) { const unsigned c = xb_ld(&bar[XB_XCNT(j)]); sum += c; cnt += (c > 0u) ? 1u : 0u; mine = (j == x) ? c : mine; }
        if (sum == G) break;
        __builtin_amdgcn_s_sleep(1);
        if ((++sp & 255u) == 0u) { if (xb_ld(&bar[XB_TMO])) break; if (sp > XB_SPIN_CAP) { atomicAdd(&bar[XB_TMO], 1u); break; } }
    }
    nloc = mine > 0u ? mine : 1u; nx = cnt > 0u ? cnt : 1u;
}

__device__ __forceinline__ void xcd_barrier(const XcdBarrier& b) {
    asm volatile("s_waitcnt vmcnt(0)" ::: "memory");
    __syncthreads();
    if (threadIdx.x == 0) {
        unsigned* bar = b.bar;
        __builtin_amdgcn_s_waitcnt(0);
        unsigned nloc = b.st[0], nx = b.st[1];
        if (nloc == 0u) { xcd_barrier_complete(bar, b.x, nloc, nx); b.st[0] = nloc; b.st[1] = nx; }
        const unsigned old = xb_add(&bar[XB_XSUB(b.x)], 1u);
        const unsigned gen = old / nloc;
        if (old + 1u == (gen + 1u) * nloc) {
            __builtin_amdgcn_fence(__ATOMIC_RELEASE, "agent");
            asm volatile("s_waitcnt vmcnt(0)" ::: "memory");
            const unsigned og = xb_add(&bar[XB_TOP], 1u);
            const unsigned tg = og / nx;
            if (og + 1u == (tg + 1u) * nx) xb_add(&bar[XB_TOPGEN], 1u);
            else XB_SPIN(xb_ld(&bar[XB_TOPGEN]) == tg, bar);
            __builtin_amdgcn_fence(__ATOMIC_ACQUIRE, "agent");
            xb_add(&bar[XB_XGEN(b.x)], 1u);
            asm volatile("s_waitcnt vmcnt(0)" ::: "memory");
        } else {
            XB_SPIN(xb_ld(&bar[XB_XGEN(b.x)]) == gen, bar);
            __builtin_amdgcn_fence(__ATOMIC_ACQUIRE, "agent");
            asm volatile("s_waitcnt vmcnt(0)" ::: "memory");
        }
    }
    __syncthreads();
}

typedef float f32x2 __attribute__((ext_vector_type(2)));
__device__ __forceinline__ f32x2 silu2(f32x2 x) { const f32x2 t = x * (-1.4426950408889634f); f32x2 e; e.x = __builtin_amdgcn_exp2f(t.x); e.y = __builtin_amdgcn_exp2f(t.y);
    const f32x2 d = e + 1.0f; f32x2 r; r.x = __builtin_amdgcn_rcpf(d.x); r.y = __builtin_amdgcn_rcpf(d.y); return x * r; }
__device__ __forceinline__ f32x2 gelu2(f32x2 x) { const f32x2 p = (x * x) * 0.10294324f + 2.3022082f; const f32x2 w = p * x; f32x2 e; e.x = __builtin_amdgcn_exp2f(w.x); e.y = __builtin_amdgcn_exp2f(w.y);
    const f32x2 d = e + 1.0f; f32x2 r; r.x = __builtin_amdgcn_rcpf(d.x); r.y = __builtin_amdgcn_rcpf(d.y); return x - x * r; }
#define LDS_WAIT() asm volatile("s_waitcnt lgkmcnt(0)" ::: "memory")
#define MFMA16(a, b, c) __builtin_amdgcn_mfma_f32_16x16x32_bf16((a), (b), (c), 0, 0, 0)

struct Args {
    const float* in[21];
    float* out; unsigned char* ws;
};
typedef const Args __attribute__((address_space(4)))* ArgsP;
enum { I_X = 0, I_NMG, I_WIN, I_CONVW, I_CONVB, I_WQ, I_WK, I_WV, I_IB, I_FB, I_MNG, I_SKIP, I_RNG, I_GNG, I_GWS, I_GBS, I_WOUT, I_NFG, I_WFF1, I_WFF2, I_FNG };

__device__ __forceinline__ void transpose_item(const float* W, int ldw, int col_src0, int nvalid, const float* gk, int K, bf16* WT, int n0, int k0, LAS float* scr, int lane) {
    float vv[32];
    const bool val = (lane & 31) < nvalid;
    const float* wp = W + (size_t)(k0 + (lane >> 5)) * ldw + col_src0 + (lane & 31);
#pragma unroll
    for (int i = 0; i < 32; ++i) vv[i] = val ? wp[(size_t)(2 * i) * ldw] : 0.f;
    if (gk) {
        const float* gp = gk + k0 + (lane >> 5);
#pragma unroll
        for (int i = 0; i < 32; ++i) vv[i] *= gp[2 * i];
    }
#pragma unroll
    for (int i = 0; i < 32; ++i) scr[(2 * i + (lane >> 5)) * 33 + (lane & 31)] = vv[i];
    LDS_WAIT(); asm volatile("" ::: "memory");
    const int c = lane & 7;
#pragma unroll
    for (int j = 0; j < 4; ++j) { const int n = (lane >> 3) + 8 * j; const LAS float* s = scr + (8 * c) * 33 + n;
        v4u o; o.x = pk2(s[0 * 33], s[1 * 33]); o.y = pk2(s[2 * 33], s[3 * 33]); o.z = pk2(s[4 * 33], s[5 * 33]); o.w = pk2(s[6 * 33], s[7 * 33]);
        *(v4u*)(WT + (size_t)(n0 + n) * K + k0 + 8 * c) = o; }
    LDS_WAIT(); asm volatile("" ::: "memory");
}

__device__ __forceinline__ void convert_weights(ArgsP a, int L, size_t wb, ldsp lds, int lane, int wave) {
    LAS float* scr = (LAS float*)(lds + 32768 + wave * 8448);
    const int gw = blockIdx.x * NWAVES + wave, NGW = gridDim.x * NWAVES;
    constexpr int I_IN = (DM / 64) * (NPAD / 32), I_O = (DM / 64) * (DM / 32), I_1 = (DM / 64) * (DFF / 32), I_2 = (DFF / 64) * (DM / 32);
    constexpr int NITEMS = I_IN + I_O + I_1 + I_2;
    unsigned char* ws = a->ws + wb;
    for (int it = gw; it < NITEMS; it += NGW) {
        int r = it;
        if (r < I_IN) { const int nblk = NPAD / 32, kb = r / nblk, nb = r % nblk, n0 = nb * 32;
            const int src = nb < 88 ? n0 + (n0 >= 768 ? 8 : 0) : 768, nv = nb < 88 ? 32 : (nb == 88 ? 8 : 0);
            transpose_item(a->in[I_WIN] + (size_t)L * DM * N_IN, N_IN, src, nv, a->in[I_NMG] + (size_t)L * DM, DM, (bf16*)(ws + WS_WIN), n0, kb * 64, scr, lane); continue; } r -= I_IN;
        if (r < I_O) { const int nblk = DM / 32, kb = r / nblk, nb = r % nblk; transpose_item(a->in[I_WOUT] + (size_t)L * DM * DM, DM, nb * 32, 32, nullptr, DM, (bf16*)(ws + WS_WOUT), nb * 32, kb * 64, scr, lane); continue; } r -= I_O;
        if (r < I_1) { const int nblk = DFF / 32, kb = r / nblk, nb = r % nblk; transpose_item(a->in[I_WFF1] + (size_t)L * DM * DFF, DFF, nb * 32, 32, a->in[I_NFG] + (size_t)L * DM, DM, (bf16*)(ws + WS_W1), nb * 32, kb * 64, scr, lane); continue; } r -= I_1;
        { const int nblk = DM / 32, kb = r / nblk, nb = r % nblk; transpose_item(a->in[I_WFF2] + (size_t)L * DFF * DM, DM, nb * 32, 32, nullptr, DFF, (bf16*)(ws + WS_W2), nb * 32, kb * 64, scr, lane); }
    }
}

template <bool GATES>
__device__ __forceinline__ void norm_rows(const float* x, const float* g, bf16* h, const LAS float* wgT, const float* ib, const float* fb, float* gates, int lane, int wave, const float* xP, float* wb) {
    const int gw = blockIdx.x * NWAVES + wave, NGW = gridDim.x * NWAVES;
    f32x4 gv[4];
#pragma unroll
    for (int j = 0; j < 4; ++j) gv[j] = ((const f32x4*)g)[lane + 64 * j];
    for (int m = gw; m < MTOK; m += NGW) {
        const bool p0 = xP != nullptr && (m & (SEQ - 1)) == 0;
        const f32x4* xr = (const f32x4*)(p0 ? xP + (size_t)(m >> 12) * DM : x + (size_t)m * DM) + lane;
        f32x4 v[4]; float ss = 0.f;
#pragma unroll
        for (int j = 0; j < 4; ++j) { v[j] = xr[64 * j]; ss += (v[j].x * v[j].x + v[j].y * v[j].y) + (v[j].z * v[j].z + v[j].w * v[j].w); }
        if (p0 && wb != nullptr) {
#pragma unroll
            for (int j = 0; j < 4; ++j) ((f32x4*)(wb + (size_t)m * DM) + lane)[64 * j] = v[j]; }
        const float rstd = rsqrtf(wave_sum(ss) * (1.f / DM) + EPS);
        unsigned long long* o8 = (unsigned long long*)(h + (size_t)m * DM) + lane;
#pragma unroll
        for (int j = 0; j < 4; ++j) { v[j] = v[j] * rstd * gv[j]; o8[64 * j] = (unsigned long long)pk2(v[j].x, v[j].y) | ((unsigned long long)pk2(v[j].z, v[j].w) << 32); }
        if (GATES) {
            float mine = 0.f;
#pragma unroll
            for (int c = 0; c < 8; ++c) {
                float p = 0.f;
#pragma unroll
                for (int j = 0; j < 4; ++j) { const f32x4 w = *(const LAS f32x4*)(wgT + c * 1024 + 4 * lane + 256 * j); p += (v[j].x * w.x + v[j].y * w.y) + (v[j].z * w.z + v[j].w * w.w); }
                p = wave_sum(p);
                if (lane == c) mine = p;
            }
            if (lane < 8) gates[(size_t)m * 8 + lane] = mine + (lane < 4 ? ib[lane] : fb[lane - 4]);
        }
    }
}

__device__ __forceinline__ float log_sigmoid_f(float f) { return fminf(f, 0.f) - __logf(1.f + __expf(-fabsf(f))); }
__device__ __forceinline__ void gates_cumsum(float f0, float f1, float& b0, float& b1, int lane) {
    const float l0 = log_sigmoid_f(f0), l1 = log_sigmoid_f(f1);
    float p = l0 + l1;
#pragma unroll
    for (int o = 1; o < 64; o <<= 1) { const float u = __shfl_up(p, o); if (lane >= o) p += u; }
    b1 = p; b0 = p - l1;
}
__device__ __forceinline__ void gates_prefmax(float g0, float g1, float& m0, float& m1, int lane) {
    float q = fmaxf(g0, g1);
#pragma unroll
    for (int o = 1; o < 64; o <<= 1) { const float u = __shfl_up(q, o); if (lane >= o) q = fmaxf(q, u); }
    const float ex = __shfl_up(q, 1);
    m1 = q; m0 = lane == 0 ? g0 : fmaxf(ex, g0);
}

struct MStage { f32x4 cw[4]; f32x4 cb; f32x4 wq[4], wk[4], wv[4]; v2u xr[11]; };
template <bool FULL>
__device__ __forceinline__ void mlstm_stage_load(ArgsP a, int L, int h, int t0, int s0, int tid, MStage& R) {
    if (tid < 384) {
        const bf16* proj = (const bf16*)(a->ws + WS_PROJ);
        const int blk = tid % 24, rg = tid / 24, l0 = rg * 8;
        const int ch0 = h * 96 + blk * 4, nb = h * 24 + blk;
#pragma unroll
        for (int r = 0; r < 11; ++r) { const int l = l0 - 3 + r;
            if (s0 + l >= 0) R.xr[r] = *(const v2u*)(proj + (size_t)(t0 + l) * NP + PC_MX + ch0); else R.xr[r] = (v2u){0u, 0u}; }
#pragma unroll
        for (int j = 0; j < 4; ++j) R.cw[j] = *(const f32x4*)(a->in[I_CONVW] + (size_t)L * 4 * 384 + j * 384 + ch0);
        R.cb = *(const f32x4*)(a->in[I_CONVB] + (size_t)L * 384 + ch0);
#pragma unroll
        for (int i = 0; i < 4; ++i) {
            R.wk[i] = *(const f32x4*)(a->in[I_WK] + ((size_t)L * 96 + nb) * 16 + i * 4);
            R.wv[i] = *(const f32x4*)(a->in[I_WV] + ((size_t)L * 96 + nb) * 16 + i * 4);
            if (FULL) R.wq[i] = *(const f32x4*)(a->in[I_WQ] + ((size_t)L * 96 + nb) * 16 + i * 4);
        }
    }
}
template <bool FULL>
__device__ __forceinline__ void mlstm_stage_compute(const MStage& R, ldsp XC, ldsp Q, ldsp K, ldsp VT, const LAS float* eend, int tid) {
    if (tid < 384) {
        const int blk = tid % 24, rg = tid / 24, l0 = rg * 8;
        f32x4 xm[11];
#pragma unroll
        for (int r = 0; r < 11; ++r) xm[r] = (f32x4){bflo(R.xr[r].x), bfhi(R.xr[r].x), bflo(R.xr[r].y), bfhi(R.xr[r].y)};
        const float kscale = 0.10206207261596575f;
        unsigned vpk[4][4], kpk[4][4];
        float vprev[4], kprev[4];
#pragma unroll
        for (int li = 0; li < 8; ++li) {
            f32x4 xc = R.cb;
#pragma unroll
            for (int j = 0; j < 4; ++j) xc = xc + R.cw[j] * xm[li + j];
            { const f32x2 s01 = silu2((f32x2){xc.x, xc.y}), s23 = silu2((f32x2){xc.z, xc.w}); xc = (f32x4){s01.x, s01.y, s23.x, s23.y}; }
            const f32x4 xr = xm[li + 3];
            f32x4 kk = (xc.x * R.wk[0] + xc.y * R.wk[1]) + (xc.z * R.wk[2] + xc.w * R.wk[3]);
            const f32x4 vv = (xr.x * R.wv[0] + xr.y * R.wv[1]) + (xr.z * R.wv[2] + xr.w * R.wv[3]);
            const int l = l0 + li;
            if (FULL) {
                const f32x4 qq = (xc.x * R.wq[0] + xc.y * R.wq[1]) + (xc.z * R.wq[2] + xc.w * R.wq[3]);
                kk = kk * kscale;
                *(LAS v2u*)(XC + l * 192 + blk * 8) = (v2u){pk2(xc.x, xc.y), pk2(xc.z, xc.w)};
                *(LAS v2u*)(Q + l * 208 + blk * 8) = (v2u){pk2(qq.x, qq.y), pk2(qq.z, qq.w)};
                *(LAS v2u*)(K + l * 208 + blk * 8) = (v2u){pk2(kk.x, kk.y), pk2(kk.z, kk.w)};
            } else {
                kk = kk * (kscale * eend[l]);
            }
            if (li & 1) {
#pragma unroll
                for (int jj = 0; jj < 4; ++jj) { vpk[jj][li >> 1] = pk2(vprev[jj], vv[jj]); if (!FULL) kpk[jj][li >> 1] = pk2(kprev[jj], kk[jj]); }
            } else {
#pragma unroll
                for (int jj = 0; jj < 4; ++jj) { vprev[jj] = vv[jj]; kprev[jj] = kk[jj]; }
            }
        }
#pragma unroll
        for (int jj = 0; jj < 4; ++jj) {
            *(LAS v4u*)(VT + (blk * 4 + jj) * 272 + l0 * 2) = (v4u){vpk[jj][0], vpk[jj][1], vpk[jj][2], vpk[jj][3]};
            if (!FULL) *(LAS v4u*)(K + (blk * 4 + jj) * 272 + l0 * 2) = (v4u){kpk[jj][0], kpk[jj][1], kpk[jj][2], kpk[jj][3]};
        }
    }
}

__device__ __forceinline__ void fill_vt_tail(ldsp VT, int tid) {
    if (tid < 384) return;
    const int i = tid - 384;
#pragma unroll
    for (int r = 0; r < 2; ++r) { const int idx = i + 128 * r;
        const int row = idx >> 4, c16 = idx & 15; const unsigned w = row == 0 ? 0x3f803f80u : 0u;
        *(LAS v4u*)(VT + (96 + row) * 272 + c16 * 16) = (v4u){w, w, w, w}; }
}

__device__ __forceinline__ void phaseC_mlstm(ArgsP a, int L, int item, ldsp lds, int tid, int lane, int wave) {
    const int bh = item >> 5, c = item & 31, b = bh >> 2, h = bh & 3;
    const int t0 = b * SEQ + c * 128, s0 = c * 128;
    ldsp EKT = lds, VT = lds + 26112;
    LAS float* eend = (LAS float*)(lds + 56576);
    const float* gates = (const float*)(a->ws + WS_GATES);
    float* scal = (float*)(a->ws + WS_SCAL);
    float i0 = 0.f, i1 = 0.f, f0 = 0.f, f1 = 0.f;
    if (wave == 7) { const float* gp = gates + (size_t)(t0 + 2 * lane) * 8; i0 = gp[h]; f0 = gp[4 + h]; i1 = gp[8 + h]; f1 = gp[12 + h]; }
    MStage R; mlstm_stage_load<false>(a, L, h, t0, s0, tid, R);
    if (wave == 7) {
        float b0, b1; gates_cumsum(f0, f1, b0, b1, lane);
        const float b_end = __shfl(b1, 63);
        const float w0 = b_end - b0 + i0, w1 = b_end - b1 + i1;
        float mx = fmaxf(w0, w1);
#pragma unroll
        for (int o = 1; o < 64; o <<= 1) mx = fmaxf(mx, __shfl_xor(mx, o));
        eend[2 * lane] = __expf(w0 - mx); eend[2 * lane + 1] = __expf(w1 - mx);
        if (lane == 0) { scal[item] = b_end; scal[512 + item] = mx; }
    }
    fill_vt_tail(VT, tid);
    __syncthreads();
    mlstm_stage_compute<false>(R, lds, lds, EKT, VT, eend, tid);
    __syncthreads();
    float* st = (float*)(a->ws + WS_MST) + (size_t)item * NE_M;
    const int fr = lane & 15, fq = lane >> 4;
    for (int tile = wave; tile < 42; tile += 8) {
        const int et = tile / 6, dt = tile % 6;
        f32x4 acc = {0.f, 0.f, 0.f, 0.f};
#pragma unroll
        for (int ks = 0; ks < 4; ++ks) {
            const bf16x8 av = *(const LAS bf16x8*)(VT + (et * 16 + fr) * 272 + ks * 64 + fq * 16);
            const bf16x8 bv = *(const LAS bf16x8*)(EKT + (dt * 16 + fr) * 272 + ks * 64 + fq * 16);
            acc = MFMA16(av, bv, acc);
        }
#pragma unroll
        for (int j = 0; j < 4; ++j) { const int e = et * 16 + fq * 4 + j; if (e < 97) st[e * 96 + dt * 16 + fr] = acc[j]; }
    }
    __syncthreads();
}

__device__ __forceinline__ float ret_log_gamma(int h) { return __logf(1.f - exp2f(-5.f - (float)h)); }

__device__ __forceinline__ void rotary16(const bf16* rowp, const float* cs, const float* sn, int j0, float scale, v4u& o1, v4u& o2) {
    const v4u u1 = *(const v4u*)(rowp + j0), u2 = *(const v4u*)(rowp + 32 + j0);
    const f32x4 c0 = *(const f32x4*)(cs + j0), c1 = *(const f32x4*)(cs + j0 + 4), s0 = *(const f32x4*)(sn + j0), s1 = *(const f32x4*)(sn + j0 + 4);
    float x1[8] = {bflo(u1.x), bfhi(u1.x), bflo(u1.y), bfhi(u1.y), bflo(u1.z), bfhi(u1.z), bflo(u1.w), bfhi(u1.w)};
    float x2[8] = {bflo(u2.x), bfhi(u2.x), bflo(u2.y), bfhi(u2.y), bflo(u2.z), bfhi(u2.z), bflo(u2.w), bfhi(u2.w)};
    float cc[8] = {c0.x, c0.y, c0.z, c0.w, c1.x, c1.y, c1.z, c1.w}, ss[8] = {s0.x, s0.y, s0.z, s0.w, s1.x, s1.y, s1.z, s1.w};
    float y1[8], y2[8];
#pragma unroll
    for (int i = 0; i < 8; ++i) { y1[i] = (x1[i] * cc[i] - x2[i] * ss[i]) * scale; y2[i] = (x2[i] * cc[i] + x1[i] * ss[i]) * scale; }
    o1 = (v4u){pk2(y1[0], y1[1]), pk2(y1[2], y1[3]), pk2(y1[4], y1[5]), pk2(y1[6], y1[7])};
    o2 = (v4u){pk2(y2[0], y2[1]), pk2(y2[2], y2[3]), pk2(y2[4], y2[5]), pk2(y2[6], y2[7])};
}

__device__ __forceinline__ void store_T8(ldsp dst, int e0, int stride, int l, v4u u) {
    const unsigned w[4] = {u.x, u.y, u.z, u.w};
#pragma unroll
    for (int i = 0; i < 4; ++i) {
        *(LAS unsigned short*)(dst + (e0 + 2 * i) * stride + l * 2) = (unsigned short)(w[i] & 0xffffu);
        *(LAS unsigned short*)(dst + (e0 + 2 * i + 1) * stride + l * 2) = (unsigned short)(w[i] >> 16);
    }
}

__device__ __forceinline__ void phaseC_ret(ArgsP a, int L, int item, ldsp lds, int tid, int lane, int wave) {
    const int bh = item >> 5, c = item & 31, b = bh / 6, h = bh % 6;
    const int t0 = b * SEQ + c * 128, s0 = c * 128;
    ldsp ZKT = lds, VT = lds + 17408;
    const bf16* proj = (const bf16*)(a->ws + WS_PROJ);
    const float* rope = (const float*)(a->ws + WS_ROPE);
    const float lg = ret_log_gamma(h);
    {
        const int l = tid >> 2, jc = tid & 3, j0 = jc * 8;
        const float zeta = __expf((127.f - (float)l) * lg);
        v4u o1, o2;
        rotary16(proj + (size_t)(t0 + l) * NP + PC_RK + h * 64, rope + (size_t)(s0 + l) * 32, rope + 4096 * 32 + (size_t)(s0 + l) * 32, j0, 0.125f * zeta, o1, o2);
        store_T8(ZKT, j0, 272, l, o1); store_T8(ZKT, 32 + j0, 272, l, o2);
        const bf16* vp = proj + (size_t)(t0 + l) * NP + PC_RV + h * 64 + jc * 16;
        const v4u v0 = *(const v4u*)vp, v1 = *(const v4u*)(vp + 8);
        store_T8(VT, jc * 16, 272, l, v0); store_T8(VT, jc * 16 + 8, 272, l, v1);
    }
    __syncthreads();
    float* st = (float*)(a->ws + WS_RST) + (size_t)item * NE_R;
    const int fr = lane & 15, fq = lane >> 4;
#pragma unroll
    for (int tt = 0; tt < 2; ++tt) {
        const int tile = wave * 2 + tt, et = tile >> 2, dt = tile & 3;
        f32x4 acc = {0.f, 0.f, 0.f, 0.f};
#pragma unroll
        for (int ks = 0; ks < 4; ++ks) {
            const bf16x8 av = *(const LAS bf16x8*)(VT + (et * 16 + fr) * 272 + ks * 64 + fq * 16);
            const bf16x8 bv = *(const LAS bf16x8*)(ZKT + (dt * 16 + fr) * 272 + ks * 64 + fq * 16);
            acc = MFMA16(av, bv, acc);
        }
#pragma unroll
        for (int j = 0; j < 4; ++j) st[(et * 16 + fq * 4 + j) * 64 + dt * 16 + fr] = acc[j];
    }
    __syncthreads();
}

__device__ __forceinline__ void phaseC_gmlp(ArgsP a, int L, int item, ldsp lds, int tid, int lane, int wave) {
    const int g = item & 3, bc = item >> 2, b = bc >> 5, c = bc & 31;
    const int t0 = b * SEQ + c * 128;
    ldsp W = lds, GVT = lds + 34816;
    const bf16* proj = (const bf16*)(a->ws + WS_PROJ);
    bf16* cat = (bf16*)(a->ws + WS_CAT);
    {
        const int l = tid >> 2, part = tid & 3;
        const bf16* vp = proj + (size_t)(t0 + l) * NP + PC_GV;
        float ss = 0.f;
#pragma unroll
        for (int i = 0; i < 8; ++i) { const v4u u = *(const v4u*)(vp + part * 64 + i * 8); const unsigned w[4] = {u.x, u.y, u.z, u.w};
#pragma unroll
            for (int q = 0; q < 4; ++q) { const f32x2 g = gelu2((f32x2){bflo(w[q]), bfhi(w[q])}); ss += g.x * g.x + g.y * g.y; } }
        ss += __shfl_xor(ss, 1); ss += __shfl_xor(ss, 2);
        const float rstd = rsqrtf(ss * (1.f / 256.f) + EPS);
        const float* gn = a->in[I_GNG] + (size_t)L * 256 + g * 64 + part * 16;
#pragma unroll
        for (int i = 0; i < 2; ++i) { const v4u u = *(const v4u*)(vp + g * 64 + part * 16 + i * 8); const unsigned w[4] = {u.x, u.y, u.z, u.w}; unsigned o[4];
#pragma unroll
            for (int q = 0; q < 4; ++q) { const f32x2 g = gelu2((f32x2){bflo(w[q]), bfhi(w[q])}) * rstd; o[q] = pk2(g.x * gn[i * 8 + 2 * q], g.y * gn[i * 8 + 2 * q + 1]); }
            store_T8(GVT, part * 16 + i * 8, 272, l, (v4u){o[0], o[1], o[2], o[3]}); }
    }
    {
        const float* wsrc = a->in[I_GWS] + ((size_t)L * 4 + g) * 128 * 128;
#pragma unroll
        for (int i = 0; i < 8; ++i) { const int idx4 = tid + 512 * i, t = idx4 >> 5, s4 = (idx4 & 31) * 4;
            f32x4 w = *(const f32x4*)(wsrc + (size_t)t * 128 + s4);
            if (s4 + 0 > t) w.x = 0.f; if (s4 + 1 > t) w.y = 0.f; if (s4 + 2 > t) w.z = 0.f; if (s4 + 3 > t) w.w = 0.f;
            *(LAS v2u*)(W + t * 272 + s4 * 2) = (v2u){pk2(w.x, w.y), pk2(w.z, w.w)}; }
    }
    __syncthreads();
    const int fr = lane & 15, fq = lane >> 4;
    const float* bs = a->in[I_GBS] + ((size_t)L * 4 + g) * 128;
    float bbv[4]; unsigned short uv[4][4];
#pragma unroll
    for (int j = 0; j < 4; ++j) { bbv[j] = bs[wave * 16 + fq * 4 + j];
#pragma unroll
        for (int n = 0; n < 4; ++n) uv[j][n] = proj[(size_t)(t0 + wave * 16 + fq * 4 + j) * NP + PC_GU + g * 64 + n * 16 + fr]; }
    f32x4 acc[4];
#pragma unroll
    for (int n = 0; n < 4; ++n) acc[n] = (f32x4){0.f, 0.f, 0.f, 0.f};
#pragma unroll
    for (int ks = 0; ks < 4; ++ks) {
        if (ks * 32 <= wave * 16 + 15) {
            const bf16x8 av = *(const LAS bf16x8*)(W + (wave * 16 + fr) * 272 + ks * 64 + fq * 16);
#pragma unroll
            for (int n = 0; n < 4; ++n) { const bf16x8 bv = *(const LAS bf16x8*)(GVT + (n * 16 + fr) * 272 + ks * 64 + fq * 16); acc[n] = MFMA16(av, bv, acc[n]); }
        }
    }
#pragma unroll
    for (int j = 0; j < 4; ++j) { const int t = wave * 16 + fq * 4 + j; const float bb = bbv[j];
#pragma unroll
        for (int n = 0; n < 4; n += 2) { const int e = n * 16 + fr;
            const f32x2 gu = gelu2((f32x2){bf2f(uv[j][n]), bf2f(uv[j][n + 1])});
            cat[(size_t)(t0 + t) * DM + CAT_G + g * 64 + e] = f2bf(gu.x * (acc[n][j] + bb));
            cat[(size_t)(t0 + t) * DM + CAT_G + g * 64 + e + 16] = f2bf(gu.y * (acc[n + 1][j] + bb)); } }
    __syncthreads();
}

__device__ __forceinline__ void phaseD(ArgsP a, ldsp lds, int tid) {
    LAS float* so = (LAS float*)lds; LAS float* sn = so + 512;
    float* scal = (float*)(a->ws + WS_SCAL);
    if (tid < 16) {
        float be[32], ac[32];
#pragma unroll
        for (int c = 0; c < 32; ++c) { be[c] = scal[tid * 32 + c]; ac[c] = scal[512 + tid * 32 + c]; }
        float m = 0.f;
#pragma unroll
        for (int c = 0; c < 32; ++c) { const float mn = fmaxf(be[c] + m, ac[c]); so[tid * 32 + c] = __expf(be[c] + m - mn); sn[tid * 32 + c] = __expf(ac[c] - mn);
            if (blockIdx.x == 0) scal[1024 + tid * 32 + c] = m; m = mn; }
    }
    __syncthreads();
    const int gt = blockIdx.x * NTHR + tid, NT = gridDim.x * NTHR;
    constexpr int TOT_M = 16 * NE_M, TOT_R = 24 * NE_R;
    for (int idx = gt; idx < TOT_M + TOT_R; idx += NT) {
        float v[32];
        if (idx < TOT_M) {
            const int bh = idx / NE_M, e = idx - bh * NE_M;
            float* p = (float*)(a->ws + WS_MST) + (size_t)bh * NCH * NE_M + e;
#pragma unroll
            for (int c = 0; c < 32; ++c) v[c] = p[(size_t)c * NE_M];
            float st = 0.f;
#pragma unroll
            for (int c = 0; c < 32; ++c) { p[(size_t)c * NE_M] = st; st = so[bh * 32 + c] * st + sn[bh * 32 + c] * v[c]; }
        } else {
            const int j = idx - TOT_M, bh = j >> 12, e = j & 4095, h = bh % 6;
            const float dec = __expf(128.f * ret_log_gamma(h));
            float* p = (float*)(a->ws + WS_RST) + (size_t)bh * NCH * NE_R + e;
#pragma unroll
            for (int c = 0; c < 32; ++c) v[c] = p[(size_t)c * NE_R];
            float st = 0.f;
#pragma unroll
            for (int c = 0; c < 32; ++c) { p[(size_t)c * NE_R] = st; st = dec * st + v[c]; }
        }
    }
    __syncthreads();
}

__device__ __forceinline__ void phaseE_mlstm(ArgsP a, int L, int item, ldsp lds, int tid, int lane, int wave) {
    const int bh = item >> 5, c = item & 31, b = bh >> 2, h = bh & 3;
    const int t0 = b * SEQ + c * 128, s0 = c * 128;
    ldsp XC = lds, Q = lds + 24576, K = lds + 51200, VT = lds + 77824, SC = lds + 108288, CT = SC;
    LAS float* fl = (LAS float*)(lds + 143104);
    LAS float* bcum = fl, *gsv = fl + 256, *mmv = fl + 384;
    const float* gates = (const float*)(a->ws + WS_GATES);
    const float* scal = (const float*)(a->ws + WS_SCAL);
    const bf16* proj = (const bf16*)(a->ws + WS_PROJ);
    bf16* cat = (bf16*)(a->ws + WS_CAT);
    const float m_prev = scal[1024 + item];
    float i0 = 0.f, i1 = 0.f, f0 = 0.f, f1 = 0.f;
    if (wave == 7) { const float* gp = gates + (size_t)(t0 + 2 * lane) * 8; i0 = gp[h]; f0 = gp[4 + h]; i1 = gp[8 + h]; f1 = gp[12 + h]; }
    MStage R; mlstm_stage_load<true>(a, L, h, t0, s0, tid, R);
    f32x4 ctv[6];
    {   const float* st = (const float*)(a->ws + WS_MST) + (size_t)item * NE_M;
#pragma unroll
        for (int i = 0; i < 6; ++i) { const int idx4 = tid + 512 * i, e = idx4 / 24, d4 = (idx4 % 24) * 4;
            ctv[i] = (f32x4){0.f, 0.f, 0.f, 0.f}; if (e < 97) ctv[i] = *(const f32x4*)(st + e * 96 + d4); } }
    if (wave == 7) {
        float b0, b1; gates_cumsum(f0, f1, b0, b1, lane);
        const float g0 = i0 - b0, g1 = i1 - b1; float p0, p1; gates_prefmax(g0, g1, p0, p1, lane);
        bcum[2 * lane] = b0; bcum[2 * lane + 1] = b1; gsv[2 * lane] = g0; gsv[2 * lane + 1] = g1;
        mmv[2 * lane] = fmaxf(m_prev, p0); mmv[2 * lane + 1] = fmaxf(m_prev, p1);
    }
    mlstm_stage_compute<true>(R, XC, Q, K, VT, nullptr, tid);
    fill_vt_tail(VT, tid);
#pragma unroll
    for (int i = 0; i < 6; ++i) { const int idx4 = tid + 512 * i, e = idx4 / 24, d4 = (idx4 % 24) * 4;
        if (idx4 < 112 * 24) *(LAS v2u*)(CT + e * 208 + d4 * 2) = (v2u){pk2(ctv[i].x, ctv[i].y), pk2(ctv[i].z, ctv[i].w)}; }
    __syncthreads();
    const int fr = lane & 15, fq = lane >> 4;
    const float* mng = a->in[I_MNG] + (size_t)L * 384 + h * 96;
    const float* skp = a->in[I_SKIP] + (size_t)L * 384 + h * 96;
    float gcol[6], scol[6];
#pragma unroll
    for (int n = 0; n < 6; ++n) { gcol[n] = mng[n * 16 + fr]; scol[n] = skp[n * 16 + fr]; }
    v4u zc[3];
#pragma unroll
    for (int i = 0; i < 3; ++i) { const int q = lane + 64 * i, r = q / 12, cc = q % 12; zc[i] = *(const v4u*)(proj + (size_t)(t0 + wave * 16 + r) * NP + PC_MZ + h * 96 + cc * 8); }
    bf16x8 aq[3];
#pragma unroll
    for (int ks = 0; ks < 3; ++ks) aq[ks] = *(const LAS bf16x8*)(Q + (wave * 16 + fr) * 208 + ks * 64 + fq * 16);
    f32x4 acc2[7];
#pragma unroll
    for (int n = 0; n < 7; ++n) { acc2[n] = (f32x4){0.f, 0.f, 0.f, 0.f};
#pragma unroll
        for (int ks = 0; ks < 3; ++ks) { const bf16x8 bv = *(const LAS bf16x8*)(CT + (n * 16 + fr) * 208 + ks * 64 + fq * 16); acc2[n] = MFMA16(aq[ks], bv, acc2[n]); } }
    f32x4 sacc[8];
#pragma unroll
    for (int st = 0; st < 8; ++st) { sacc[st] = (f32x4){0.f, 0.f, 0.f, 0.f};
        if (st <= wave) {
#pragma unroll
            for (int ks = 0; ks < 3; ++ks) { const bf16x8 bv = *(const LAS bf16x8*)(K + (st * 16 + fr) * 208 + ks * 64 + fq * 16); sacc[st] = MFMA16(aq[ks], bv, sacc[st]); } } }
    float mmr[4];
#pragma unroll
    for (int j = 0; j < 4; ++j) mmr[j] = mmv[wave * 16 + fq * 4 + j];
    __syncthreads();
#pragma unroll
    for (int st = 0; st < 8; ++st) {
        if (st <= (wave | 1)) {
            const int s = st * 16 + fr; const float gsl = gsv[s];
#pragma unroll
            for (int j = 0; j < 4; ++j) { const int l = wave * 16 + fq * 4 + j;
                const float wgt = (s <= l) ? __expf(gsl - mmr[j]) : 0.f;
                *(LAS unsigned short*)(SC + l * 272 + s * 2) = f2bf(sacc[st][j] * wgt); }
        }
    }
    asm volatile("" ::: "memory");
    f32x4 acc1[7];
#pragma unroll
    for (int n = 0; n < 7; ++n) acc1[n] = (f32x4){0.f, 0.f, 0.f, 0.f};
#pragma unroll
    for (int ks = 0; ks < 4; ++ks) {
        if (ks * 2 <= wave) {
            const bf16x8 av = *(const LAS bf16x8*)(SC + (wave * 16 + fr) * 272 + ks * 64 + fq * 16);
#pragma unroll
            for (int n = 0; n < 7; ++n) { const bf16x8 bv = *(const LAS bf16x8*)(VT + (n * 16 + fr) * 272 + ks * 64 + fq * 16); acc1[n] = MFMA16(av, bv, acc1[n]); }
        }
    }
#pragma unroll
    for (int i = 0; i < 3; ++i) { const int q = lane + 64 * i, r = q / 12, cc = q % 12; *(LAS v4u*)(Q + (wave * 16 + r) * 208 + cc * 16) = zc[i]; }
#pragma unroll
    for (int j = 0; j < 4; ++j) {
        const int l = wave * 16 + fq * 4 + j;
        const float sint = __expf(m_prev - mmr[j]);
        float den = acc1[6][j] + sint * acc2[6][j];
        den = __shfl(den, lane & 48);
        const float flo = __expf(-(bcum[l] + mmr[j]));
        const float inv = fast_rcp(fmaxf(fabsf(den), flo));
        float hv[6]; float ss = 0.f;
#pragma unroll
        for (int n = 0; n < 6; ++n) { hv[n] = (acc1[n][j] + sint * acc2[n][j]) * inv; ss += hv[n] * hv[n]; }
        ss += __shfl_xor(ss, 1); ss += __shfl_xor(ss, 2); ss += __shfl_xor(ss, 4); ss += __shfl_xor(ss, 8);
        const float rstd = rsqrtf(ss * (1.f / 96.f) + EPS);
#pragma unroll
        for (int n = 0; n < 6; n += 2) { const int e = n * 16 + fr;
            const float xc0 = bf2f(*(const LAS unsigned short*)(XC + l * 192 + e * 2)), xc1 = bf2f(*(const LAS unsigned short*)(XC + l * 192 + (e + 16) * 2));
            const f32x2 sz = silu2((f32x2){bf2f(*(const LAS unsigned short*)(Q + l * 208 + e * 2)), bf2f(*(const LAS unsigned short*)(Q + l * 208 + (e + 16) * 2))});
            *(LAS unsigned short*)(SC + l * 272 + e * 2) = f2bf((hv[n] * rstd * gcol[n] + scol[n] * xc0) * sz.x);
            *(LAS unsigned short*)(SC + l * 272 + (e + 16) * 2) = f2bf((hv[n + 1] * rstd * gcol[n + 1] + scol[n + 1] * xc1) * sz.y); }
    }
#pragma unroll
    for (int i = 0; i < 3; ++i) { const int q = lane + 64 * i, r = q / 12, cc = q % 12;
        *(v4u*)(cat + (size_t)(t0 + wave * 16 + r) * DM + h * 96 + cc * 8) = *(const LAS v4u*)(SC + (wave * 16 + r) * 272 + cc * 16); }
    __syncthreads();
}

__device__ __forceinline__ void phaseE_ret(ArgsP a, int L, int item, ldsp lds, int tid, int lane, int wave) {
    const int bh = item >> 5, c = item & 31, b = bh / 6, h = bh % 6;
    const int t0 = b * SEQ + c * 128, s0 = c * 128;
    ldsp Q = lds, K = lds + 18432, VT = lds + 36864, SC = lds + 54272, RT = SC;
    const bf16* proj = (const bf16*)(a->ws + WS_PROJ);
    const float* rope = (const float*)(a->ws + WS_ROPE);
    bf16* cat = (bf16*)(a->ws + WS_CAT);
    const float lg = ret_log_gamma(h);
    {
        const int l = tid >> 2, jc = tid & 3, j0 = jc * 8;
        const float* cs = rope + (size_t)(s0 + l) * 32; const float* sn = rope + 4096 * 32 + (size_t)(s0 + l) * 32;
        v4u o1, o2;
        rotary16(proj + (size_t)(t0 + l) * NP + PC_RQ + h * 64, cs, sn, j0, 1.f, o1, o2);
        *(LAS v4u*)(Q + l * 144 + j0 * 2) = o1; *(LAS v4u*)(Q + l * 144 + (32 + j0) * 2) = o2;
        rotary16(proj + (size_t)(t0 + l) * NP + PC_RK + h * 64, cs, sn, j0, 0.125f, o1, o2);
        *(LAS v4u*)(K + l * 144 + j0 * 2) = o1; *(LAS v4u*)(K + l * 144 + (32 + j0) * 2) = o2;
        const bf16* vp = proj + (size_t)(t0 + l) * NP + PC_RV + h * 64 + jc * 16;
        const v4u v0 = *(const v4u*)vp, v1 = *(const v4u*)(vp + 8);
        store_T8(VT, jc * 16, 272, l, v0); store_T8(VT, jc * 16 + 8, 272, l, v1);
        const float* st = (const float*)(a->ws + WS_RST) + (size_t)item * NE_R;
#pragma unroll
        for (int i = 0; i < 2; ++i) { const int idx4 = tid + 512 * i, e = idx4 >> 4, d4 = (idx4 & 15) * 4;
            const f32x4 w = *(const f32x4*)(st + e * 64 + d4);
            *(LAS v2u*)(RT + e * 144 + d4 * 2) = (v2u){pk2(w.x, w.y), pk2(w.z, w.w)}; }
    }
    __syncthreads();
    const int fr = lane & 15, fq = lane >> 4;
    const float* rng = a->in[I_RNG] + (size_t)L * 384 + h * 64;
    float gcol[4];
#pragma unroll
    for (int n = 0; n < 4; ++n) gcol[n] = rng[n * 16 + fr];
    v4u gc[2];
#pragma unroll
    for (int i = 0; i < 2; ++i) { const int q = lane + 64 * i, r = q >> 3, cc = q & 7; gc[i] = *(const v4u*)(proj + (size_t)(t0 + wave * 16 + r) * NP + PC_RG + h * 64 + cc * 8); }
    bf16x8 aq[2];
#pragma unroll
    for (int ks = 0; ks < 2; ++ks) aq[ks] = *(const LAS bf16x8*)(Q + (wave * 16 + fr) * 144 + ks * 64 + fq * 16);
    f32x4 acc2[4];
#pragma unroll
    for (int n = 0; n < 4; ++n) { acc2[n] = (f32x4){0.f, 0.f, 0.f, 0.f};
#pragma unroll
        for (int ks = 0; ks < 2; ++ks) { const bf16x8 bv = *(const LAS bf16x8*)(RT + (n * 16 + fr) * 144 + ks * 64 + fq * 16); acc2[n] = MFMA16(aq[ks], bv, acc2[n]); } }
    f32x4 sacc[8];
#pragma unroll
    for (int st = 0; st < 8; ++st) { sacc[st] = (f32x4){0.f, 0.f, 0.f, 0.f};
        if (st <= wave) {
#pragma unroll
            for (int ks = 0; ks < 2; ++ks) { const bf16x8 bv = *(const LAS bf16x8*)(K + (st * 16 + fr) * 144 + ks * 64 + fq * 16); sacc[st] = MFMA16(aq[ks], bv, sacc[st]); } } }
    __syncthreads();
    float rowf[4];
#pragma unroll
    for (int j = 0; j < 4; ++j) rowf[j] = __expf((float)(fq * 4 + j - fr) * lg);
#pragma unroll
    for (int st = 0; st < 8; ++st) {
        if (st <= (wave | 1)) {
            const int s = st * 16 + fr; const float tf = __expf((float)((wave - st) * 16) * lg);
#pragma unroll
            for (int j = 0; j < 4; ++j) { const int l = wave * 16 + fq * 4 + j;
                const float wgt = (s <= l) ? rowf[j] * tf : 0.f;
                *(LAS unsigned short*)(SC + l * 272 + s * 2) = f2bf(sacc[st][j] * wgt); }
        }
    }
    asm volatile("" ::: "memory");
    f32x4 acc1[4];
#pragma unroll
    for (int n = 0; n < 4; ++n) acc1[n] = (f32x4){0.f, 0.f, 0.f, 0.f};
#pragma unroll
    for (int ks = 0; ks < 4; ++ks) {
        if (ks * 2 <= wave) {
            const bf16x8 av = *(const LAS bf16x8*)(SC + (wave * 16 + fr) * 272 + ks * 64 + fq * 16);
#pragma unroll
            for (int n = 0; n < 4; ++n) { const bf16x8 bv = *(const LAS bf16x8*)(VT + (n * 16 + fr) * 272 + ks * 64 + fq * 16); acc1[n] = MFMA16(av, bv, acc1[n]); }
        }
    }
#pragma unroll
    for (int i = 0; i < 2; ++i) { const int q = lane + 64 * i, r = q >> 3, cc = q & 7; *(LAS v4u*)(Q + (wave * 16 + r) * 144 + cc * 16) = gc[i]; }
#pragma unroll
    for (int j = 0; j < 4; ++j) {
        const int l = wave * 16 + fq * 4 + j;
        const float xi = __expf((float)(l + 1) * lg);
        float hv[4]; float ss = 0.f;
#pragma unroll
        for (int n = 0; n < 4; ++n) { hv[n] = acc1[n][j] + xi * acc2[n][j]; ss += hv[n] * hv[n]; }
        ss += __shfl_xor(ss, 1); ss += __shfl_xor(ss, 2); ss += __shfl_xor(ss, 4); ss += __shfl_xor(ss, 8);
        const float rstd = rsqrtf(ss * (1.f / 64.f) + EPS);
#pragma unroll
        for (int n = 0; n < 4; n += 2) { const int e = n * 16 + fr;
            const f32x2 sg = silu2((f32x2){bf2f(*(const LAS unsigned short*)(Q + l * 144 + e * 2)), bf2f(*(const LAS unsigned short*)(Q + l * 144 + (e + 16) * 2))});
            *(LAS unsigned short*)(SC + l * 272 + e * 2) = f2bf(hv[n] * rstd * gcol[n] * sg.x);
            *(LAS unsigned short*)(SC + l * 272 + (e + 16) * 2) = f2bf(hv[n + 1] * rstd * gcol[n + 1] * sg.y); }
    }
#pragma unroll
    for (int i = 0; i < 2; ++i) { const int q = lane + 64 * i, r = q >> 3, cc = q & 7;
        *(v4u*)(cat + (size_t)(t0 + wave * 16 + r) * DM + CAT_R + h * 64 + cc * 8) = *(const LAS v4u*)(SC + (wave * 16 + r) * 272 + cc * 16); }
    __syncthreads();
}


template <int MODE, int PER>
__device__ __forceinline__ void gemv4_item(const LAS float* A, const float* W, int ldw, int ncol0, int nvalid, int kb, float* out, int ldo, int ocol0, LAS float* red, int tid) {
    constexpr int klen = PER * 16, CH = PER < 32 ? PER : 32;
    const int kq = tid >> 5, c = tid & 31, k0 = kq * PER;
    float acc[4] = {0.f, 0.f, 0.f, 0.f};
    if (c < nvalid) {
        const float* wp = W + (size_t)(kb + k0) * ldw + ncol0 + c;
#pragma unroll
        for (int kk = 0; kk < PER; kk += CH) {
            float w[CH];
#pragma unroll
            for (int i = 0; i < CH; ++i) w[i] = wp[(size_t)(kk + i) * ldw];
#pragma unroll
            for (int i = 0; i < CH; ++i)
#pragma unroll
                for (int r = 0; r < 4; ++r) acc[r] += A[r * klen + k0 + kk + i] * w[i];
        }
    }
#pragma unroll
    for (int r = 0; r < 4; ++r) red[(kq * 4 + r) * 32 + c] = acc[r];
    __syncthreads();
    if (tid < 128) { const int r = tid >> 5; float s = 0.f;
#pragma unroll
        for (int q = 0; q < 16; ++q) s += red[(q * 4 + r) * 32 + c];
        if (c < nvalid) { float* o = out + (size_t)r * ldo + ocol0 + c;
            if (MODE == 0) *o = s; else if (MODE == 1) { const float t = fmaxf(s, 0.f); *o = t * t; } else atomicAdd(o, s); } }
    __syncthreads();
}
__device__ __forceinline__ void precise_norm_to_lds(const float* x0, size_t row_stride, const float* g, LAS float* A, int lane, int wave) {
    if (wave < 4) { const f32x4* xr = (const f32x4*)(x0 + (size_t)wave * row_stride) + lane; f32x4 v[4]; float ss = 0.f;
#pragma unroll
        for (int j = 0; j < 4; ++j) { v[j] = xr[64 * j]; ss += (v[j].x * v[j].x + v[j].y * v[j].y) + (v[j].z * v[j].z + v[j].w * v[j].w); }
        const float rstd = rsqrtf(wave_sum(ss) * (1.f / DM) + EPS);
#pragma unroll
        for (int j = 0; j < 4; ++j) { const f32x4 gv = ((const f32x4*)g)[lane + 64 * j]; *(LAS f32x4*)(A + wave * 1024 + 4 * lane + 256 * j) = v[j] * rstd * gv; } }
    __syncthreads();
}
__device__ __forceinline__ void lds_copy_rows(const float* src, int ld, int kb, int klen, LAS float* A, int tid) {
    for (int i = tid; i < 4 * klen; i += NTHR) { const int r = i / klen, k = i - r * klen; A[i] = src[(size_t)r * ld + kb + k]; }
    __syncthreads();
}
__device__ __forceinline__ void precise_mixer(ArgsP a, int L, int b, ldsp lds, int tid, int lane, int wave) {
    LAS float* XC = (LAS float*)lds, *XM = XC + 384, *Qs = XC + 768, *Ks = XC + 1152, *Vs = XC + 1536;
    const float* projP = (const float*)(a->ws + WS_PROJP); float* catP = (float*)(a->ws + WS_CATP);
    {
        const float* p = projP + (size_t)b * N_IN; float* o = catP + (size_t)b * DM;
        if (tid < 384) { const float x = p[tid]; XM[tid] = x; XC[tid] = silu_f(a->in[I_CONVW][(size_t)L * 4 * 384 + 3 * 384 + tid] * x + a->in[I_CONVB][(size_t)L * 384 + tid]); }
        __syncthreads();
        if (tid < 384) { const int nb = tid >> 2, j = tid & 3; float q = 0.f, k = 0.f, v = 0.f;
#pragma unroll
            for (int i = 0; i < 4; ++i) { const size_t wi = ((size_t)L * 96 + nb) * 16 + i * 4 + j; q += XC[nb * 4 + i] * a->in[I_WQ][wi]; k += XC[nb * 4 + i] * a->in[I_WK][wi]; v += XM[nb * 4 + i] * a->in[I_WV][wi]; }
            Qs[tid] = q; Ks[tid] = k * 0.10206207261596575f; Vs[tid] = v; }
        __syncthreads();
        if (wave < 4) {
            const int h = wave; const int d0 = h * 96 + lane, d1 = h * 96 + 64 + lane; const bool two = lane < 32;
            float s = Qs[d0] * Ks[d0] + (two ? Qs[d1] * Ks[d1] : 0.f); s = wave_sum(s);
            const float ig = p[768 + h] + a->in[I_IB][L * 4 + h], f = p[772 + h] + a->in[I_FB][L * 4 + h];
            const float logf = fminf(f, 0.f) - __logf(1.f + __expf(-fabsf(f)));
            const float mt = fmaxf(logf, ig), wts = __expf(ig - mt), den = s * wts, inv = 1.f / fmaxf(fabsf(den), __expf(-mt));
            const float h0 = den * Vs[d0] * inv, h1 = two ? den * Vs[d1] * inv : 0.f;
            const float rstd = rsqrtf(wave_sum(h0 * h0 + h1 * h1) * (1.f / 96.f) + EPS);
            const float* mg = a->in[I_MNG] + (size_t)L * 384; const float* sk = a->in[I_SKIP] + (size_t)L * 384;
            o[d0] = (h0 * rstd * mg[d0] + sk[d0] * XC[d0]) * silu_f(p[384 + d0]);
            if (two) o[d1] = (h1 * rstd * mg[d1] + sk[d1] * XC[d1]) * silu_f(p[384 + d1]);
        } else {
            for (int h = wave - 4; h < 6; h += 4) { const int d = h * 64 + lane;
                const float s = wave_sum(p[776 + d] * p[1160 + d]) * 0.125f; const float val = s * p[1544 + d];
                const float rstd = rsqrtf(wave_sum(val * val) * (1.f / 64.f) + EPS);
                o[CAT_R + d] = val * rstd * a->in[I_RNG][(size_t)L * 384 + d] * silu_f(p[1928 + d]); }
        }
        if (wave < 4) {
            const int g = wave; float gl[4]; float ss = 0.f;
#pragma unroll
            for (int i = 0; i < 4; ++i) { gl[i] = gelu_tanh(p[2568 + lane + 64 * i]); ss += gl[i] * gl[i]; }
            const float rstd = rsqrtf(wave_sum(ss) * (1.f / 256.f) + EPS);
            float gv = 0.f;
#pragma unroll
            for (int i = 0; i < 4; ++i) if (i == g) gv = gl[i];
            gv = gv * rstd * a->in[I_GNG][(size_t)L * 256 + g * 64 + lane];
            const float w00 = a->in[I_GWS][((size_t)L * 4 + g) * 128 * 128], b0 = a->in[I_GBS][((size_t)L * 4 + g) * 128];
            o[CAT_G + g * 64 + lane] = gelu_tanh(p[2312 + g * 64 + lane]) * (w00 * gv + b0);
        }
        __syncthreads();
    }
}

struct PreP1 { ArgsP a; int L; ldsp lds;
    __device__ __forceinline__ void operator()() const {
        if ((int)blockIdx.x >= 89) return;
        int t_ = threadIdx.x; asm volatile("" : "+v"(t_)); const int tid = t_, lane = tid & 63, wave = __builtin_amdgcn_readfirstlane(tid >> 6);
        unsigned char* ws = a->ws; const float* xP = (const float*)(ws + WS_XP);
        LAS float* Ap = (LAS float*)(lds + 32768); LAS float* red = (LAS float*)(lds + 32768 + 16384);
        precise_norm_to_lds(L == 0 ? a->in[I_X] : xP, L == 0 ? (size_t)SEQ * DM : (size_t)DM, a->in[I_NMG] + (size_t)L * DM, Ap, lane, wave);
        const int cg_ = (int)blockIdx.x;
        gemv4_item<0, 64>(Ap, a->in[I_WIN] + (size_t)L * DM * N_IN, N_IN, cg_ * 32, cg_ == 88 ? 8 : 32, 0, (float*)(ws + WS_PROJP), N_IN, cg_ * 32, red, tid);
    } };
struct PreP5 { ArgsP a; int L; ldsp lds;
    __device__ __forceinline__ void operator()() const {
        const int pi = blockIdx.x; if (pi >= 256) return;
        int t_ = threadIdx.x; asm volatile("" : "+v"(t_)); const int tid = t_;
        unsigned char* ws = a->ws; const int cg_ = pi & 31, ks = pi >> 5;
        LAS float* Ap = (LAS float*)(lds + 32768); LAS float* red = (LAS float*)(lds + 32768 + 8192);
        lds_copy_rows((const float*)(ws + WS_HIDP), DFF, ks * 512, 512, Ap, tid);
        gemv4_item<2, 32>(Ap, a->in[I_WFF2] + (size_t)L * DFF * DM, DM, cg_ * 32, 32, ks * 512, (float*)(ws + WS_XP), DM, cg_ * 32, red, tid);
    } };

__global__ void __launch_bounds__(NTHR, 2) fwd_kernel(Args a_unused) {
    extern __shared__ __attribute__((aligned(16))) unsigned char lds_raw[];
    cg::grid_group grid = cg::this_grid();
    ldsp lds = (ldsp)lds_raw;
#define PHASE_BEGIN() int tid_o = threadIdx.x; asm volatile("" : "+v"(tid_o)); const int tid = tid_o, lane = tid & 63, wave = __builtin_amdgcn_readfirstlane(tid >> 6); (void)lane; (void)wave; \
    ArgsP a = (ArgsP)__builtin_amdgcn_kernarg_segment_ptr(); asm volatile("" : "+s"(a)); unsigned char* ws = a->ws; (void)ws; const int G = gridDim.x; (void)G;
    volatile LAS unsigned* MISC = (volatile LAS unsigned*)(lds + LDS_BYTES - 64);
    if (threadIdx.x < 16) MISC[threadIdx.x] = 0u;
    __syncthreads();
    XcdBarrier bar;
    { ArgsP a = (ArgsP)__builtin_amdgcn_kernarg_segment_ptr(); bar = xcd_barrier_post((unsigned*)(a->ws + WS_CTL), MISC); }
#define GRID_SYNC() xcd_barrier(bar)

    {
        PHASE_BEGIN();
        float* rope = (float*)(ws + WS_ROPE);
        for (int idx = blockIdx.x * NTHR + tid; idx < 4096 * 32; idx += G * NTHR) {
            const int pos = idx >> 5, j = idx & 31;
            const float freq = exp2f(-(float)j * (13.287712379549449f / 32.f));
            const double ang = (double)pos * (double)freq;
            double rev = ang * 0.15915494309189535; rev -= __builtin_rint(rev);
            const float fr = (float)rev;
            rope[idx] = __builtin_amdgcn_cosf(fr); rope[4096 * 32 + idx] = __builtin_amdgcn_sinf(fr);
        }
        {
            const int gw = blockIdx.x * NWAVES + wave, NGW = G * NWAVES;
            const float* x = a->in[I_X]; bf16* xb = (bf16*)(ws + WS_H); float* ssq = (float*)(ws + WS_SSQ);
            for (int m0 = gw; m0 < MTOK; m0 += 4 * NGW) {
                f32x4 v[4][4];
#pragma unroll
                for (int r = 0; r < 4; ++r) { const int m = m0 + r * NGW; if (m < MTOK) { const f32x4* xr = (const f32x4*)(x + (size_t)m * DM) + lane;
#pragma unroll
                    for (int j = 0; j < 4; ++j) v[r][j] = xr[64 * j]; } }
#pragma unroll
                for (int r = 0; r < 4; ++r) { const int m = m0 + r * NGW; if (m < MTOK) { float ss = 0.f;
#pragma unroll
                    for (int j = 0; j < 4; ++j) ss += (v[r][j].x * v[r][j].x + v[r][j].y * v[r][j].y) + (v[r][j].z * v[r][j].z + v[r][j].w * v[r][j].w);
                    ss = wave_sum(ss);
                    unsigned long long* o8 = (unsigned long long*)(xb + (size_t)m * DM) + lane;
#pragma unroll
                    for (int j = 0; j < 4; ++j) o8[64 * j] = (unsigned long long)pk2(v[r][j].x, v[r][j].y) | ((unsigned long long)pk2(v[r][j].z, v[r][j].w) << 32);
                    if (lane < 16) ssq[(size_t)m * 16 + lane] = lane == 0 ? ss : 0.f; } }
            }
        }
        convert_weights(a, 0, 0, lds, lane, wave);
        if (blockIdx.x == 0) { float* xP = (float*)(ws + WS_XP); for (int i = tid; i < 4 * DM; i += NTHR) xP[i] = a->in[I_X][(size_t)(i >> 10) * SEQ * DM + (i & 1023)]; }
    }
    { ArgsP a = (ArgsP)__builtin_amdgcn_kernarg_segment_ptr(); asm volatile("" : "+s"(a)); if (a->ws == nullptr) grid.sync(); }
    GRID_SYNC();

    for (int L = 0; L < DEPTH; ++L) {
        {
            PHASE_BEGIN();
            const size_t wb = (L & 1) ? WS_WBUF1 : 0;
            pg8::Gemm g{(const bf16*)(ws + WS_H), (const bf16*)(ws + wb + WS_WIN), MTOK, NPAD, DM}; pg8::StaticOrder S; S.init(MTOK, NPAD, G, (int)blockIdx.x);
            pg8::EpiScaledBf16<0> E{(bf16*)(ws + WS_PROJ), NP, (const float*)(ws + WS_SSQ), 11, (float*)(ws + WS_GATES), a->in[I_IB] + L * 4, a->in[I_FB] + L * 4};
            pg8::gemm_phase<pg8::EpiScaledBf16<0>, pg8::StaticOrder, GEMM_ALIGN, GEMM_SP2, PreP1>(lds, g, S, E, PreP1{a, L, lds});
        }
        GRID_SYNC();
        if ((int)blockIdx.x >= (int)gridDim.x - 4) { PHASE_BEGIN(); precise_mixer(a, L, (int)blockIdx.x - (G - 4), lds, tid, lane, wave); }
        for (int rep = 0; rep < 1 + XREP_C; ++rep)
        for (int it = blockIdx.x; it < 1792; it += gridDim.x) {
            PHASE_BEGIN();
            if (it < 512) phaseC_mlstm(a, L, it, lds, tid, lane, wave);
            else if (it < 1280) phaseC_ret(a, L, it - 512, lds, tid, lane, wave);
            else phaseC_gmlp(a, L, it - 1280, lds, tid, lane, wave);
        }
        GRID_SYNC();
        {
            PHASE_BEGIN();
            phaseD(a, lds, tid);
            if ((int)blockIdx.x < 128) { const int pi = blockIdx.x, cg_ = pi & 31, ks = pi >> 5; LAS float* Ap = (LAS float*)lds; LAS float* red = (LAS float*)(lds + 16384);
                lds_copy_rows((const float*)(ws + WS_CATP), DM, ks * 256, 256, Ap, tid);
                gemv4_item<2, 16>(Ap, a->in[I_WOUT] + (size_t)L * DM * DM, DM, cg_ * 32, 32, ks * 256, (float*)(ws + WS_XP), DM, cg_ * 32, red, tid); }
            if (L + 1 < DEPTH) convert_weights(a, L + 1, ((L + 1) & 1) ? WS_WBUF1 : 0, lds, lane, wave);
        }
        GRID_SYNC();
        for (int rep = 0; rep < 1 + XREP_E; ++rep)
        for (int it = blockIdx.x; it < (rep == 0 ? 1280 + 128 : XREP_E_END); it += gridDim.x) {
            PHASE_BEGIN();
            if (it >= 1280) { const int cg_ = it - 1280; LAS float* Ap = (LAS float*)lds; LAS float* red = (LAS float*)(lds + 16384);
                precise_norm_to_lds((const float*)(ws + WS_XP), DM, a->in[I_NFG] + (size_t)L * DM, Ap, lane, wave);
                gemv4_item<1, 64>(Ap, a->in[I_WFF1] + (size_t)L * DM * DFF, DFF, cg_ * 32, 32, 0, (float*)(ws + WS_HIDP), DFF, cg_ * 32, red, tid); continue; }
            if (it < 512) phaseE_mlstm(a, L, it, lds, tid, lane, wave);
            else phaseE_ret(a, L, it - 512, lds, tid, lane, wave);
        }
        GRID_SYNC();
        {
            PHASE_BEGIN();
            const size_t wb = (L & 1) ? WS_WBUF1 : 0;
            pg8::Gemm g{(const bf16*)(ws + WS_CAT), (const bf16*)(ws + wb + WS_WOUT), MTOK, DM, DM}; pg8::StaticOrder S; S.init(MTOK, DM, G, (int)blockIdx.x);
            pg8::EpiResidNorm E{(L == 0) ? a->in[I_X] : a->out, a->out, (bf16*)(ws + WS_H), (float*)(ws + WS_SSQ), nullptr, DM};
            pg8::gemm_phase<pg8::EpiResidNorm, pg8::StaticOrder, true, GEMM_SP2>(lds, g, S, E);
        }
        GRID_SYNC();
        {
            PHASE_BEGIN();
            const size_t wb = (L & 1) ? WS_WBUF1 : 0;
            pg8::Gemm g{(const bf16*)(ws + WS_H), (const bf16*)(ws + wb + WS_W1), MTOK, DFF, DM}; pg8::StaticOrder S; S.init(MTOK, DFF, G, (int)blockIdx.x);
            pg8::EpiScaledBf16<2> E{(bf16*)(ws + WS_HID), DFF, (const float*)(ws + WS_SSQ), -1, nullptr, nullptr, nullptr};
            pg8::gemm_phase<pg8::EpiScaledBf16<2>, pg8::StaticOrder, GEMM_ALIGN, GEMM_SP2, PreP5>(lds, g, S, E, PreP5{a, L, lds});
        }
        GRID_SYNC();
        {
            PHASE_BEGIN();
            const size_t wb = (L & 1) ? WS_WBUF1 : 0;
            pg8::Gemm g{(const bf16*)(ws + WS_HID), (const bf16*)(ws + wb + WS_W2), MTOK, DM, DFF}; pg8::StaticOrder S; S.init(MTOK, DM, G, (int)blockIdx.x);
            pg8::EpiResidNorm E{a->out, a->out, (bf16*)(ws + WS_H), (float*)(ws + WS_SSQ), (const float*)(ws + WS_XP), DM};
            pg8::gemm_phase<pg8::EpiResidNorm, pg8::StaticOrder, true, GEMM_SP2>(lds, g, S, E);
        }
        GRID_SYNC();
    }
    {
        PHASE_BEGIN();
        const int gw = blockIdx.x * NWAVES + wave, NGW = G * NWAVES;
        const float* g = a->in[I_FNG]; const float* xP = (const float*)(ws + WS_XP);
        f32x4 gv[4];
#pragma unroll
        for (int j = 0; j < 4; ++j) gv[j] = ((const f32x4*)g)[lane + 64 * j];
        for (int m0 = gw; m0 < MTOK; m0 += 4 * NGW) {
            f32x4 v[4][4];
#pragma unroll
            for (int r = 0; r < 4; ++r) { const int m = m0 + r * NGW; if (m < MTOK) {
                const f32x4* xs = (m & (SEQ - 1)) == 0 ? (const f32x4*)(xP + (size_t)(m >> 12) * DM) + lane : (const f32x4*)(a->out + (size_t)m * DM) + lane;
#pragma unroll
                for (int j = 0; j < 4; ++j) v[r][j] = xs[64 * j]; } }
#pragma unroll
            for (int r = 0; r < 4; ++r) { const int m = m0 + r * NGW; if (m < MTOK) { float ss = 0.f;
#pragma unroll
                for (int j = 0; j < 4; ++j) ss += (v[r][j].x * v[r][j].x + v[r][j].y * v[r][j].y) + (v[r][j].z * v[r][j].z + v[r][j].w * v[r][j].w);
                const float rstd = rsqrtf(wave_sum(ss) * (1.f / DM) + EPS);
                f32x4* xr = (f32x4*)(a->out + (size_t)m * DM) + lane;
#pragma unroll
                for (int j = 0; j < 4; ++j) xr[64 * j] = v[r][j] * rstd * gv[j]; } }
        }
    }
}

extern "C" void kernel_launch(void* const* d_in, const int* in_sizes, int n_in, void* d_out, int out_size, void* d_ws, size_t ws_size, hipStream_t stream) {
    static int grid = 0;
    if (grid == 0) {
        if (n_in != 21 || out_size != MTOK * DM || ws_size < WS_END) { fprintf(stderr, "kernel_launch: unexpected shapes (n_in %d out %d ws %zu)\n", n_in, out_size, ws_size); grid = -1; return; }
        int dev = 0, cus = 0, per_cu = 0;
        hipGetDevice(&dev);
        hipDeviceGetAttribute(&cus, hipDeviceAttributeMultiprocessorCount, dev);
        if (hipFuncSetAttribute((const void*)fwd_kernel, hipFuncAttributeMaxDynamicSharedMemorySize, LDS_BYTES) != hipSuccess) { fprintf(stderr, "kernel_launch: hipFuncSetAttribute failed\n"); grid = -1; return; }
        if (hipOccupancyMaxActiveBlocksPerMultiprocessor(&per_cu, (const void*)fwd_kernel, NTHR, LDS_BYTES) != hipSuccess || per_cu < 1) { fprintf(stderr, "kernel_launch: occupancy query says %d\n", per_cu); per_cu = 1; }
        (void)hipGetLastError();
        grid = cus;
        fprintf(stderr, "kernel_launch: cus %d per_cu %d grid %d\n", cus, per_cu, grid);
    }
    if (grid < 0) return;
    if (hipMemsetAsync((char*)d_ws + WS_CTL, 0, 16384, stream) != hipSuccess) { fprintf(stderr, "kernel_launch: memset failed\n"); return; }
    Args a{};
    for (int i = 0; i < 21; ++i) a.in[i] = (const float*)d_in[i];
    a.out = (float*)d_out; a.ws = (unsigned char*)d_ws;
    void* args[] = {&a};
    hipError_t e = hipLaunchCooperativeKernel((const void*)fwd_kernel, dim3(grid), dim3(NTHR), args, LDS_BYTES, stream);
    if (e != hipSuccess) fprintf(stderr, "cooperative launch failed: %s (grid %d)\n", hipGetErrorString(e), grid);
}
```

```cpp
#define EPI_BATCH 4
#include <hip/hip_runtime.h>
#include <hip/hip_cooperative_groups.h>
#include <cstdio>
#include <cstdint>
namespace cg = cooperative_groups;
namespace pg8 {
#define PG8_LAS __attribute__((address_space(3)))
typedef unsigned short bf16_t;
typedef short bf16x8 __attribute__((ext_vector_type(8)));
typedef float f32x4 __attribute__((ext_vector_type(4)));
typedef unsigned u32x4 __attribute__((ext_vector_type(4)));
constexpr int BM = 256, BK = 64, HALF = 128, HTB = HALF * BK * 2  , STAGE_BYTES = 8 * HTB, NXCD = 8, WGM = 8;

__host__ __device__ __forceinline__ int lds_byte(int r, int c) { const int st = (r >> 4) * 2 + (c >> 5), rr = r & 15, cc = c & 31, ob = rr * 64 + cc * 2; return st * 1024 + (ob ^ (((ob >> 9) & 1) << 5)); }
__host__ __device__ __forceinline__ void stage_rc(int b, int& R, int& C) { const int st = b / 1024, sb = b % 1024, swz = sb ^ (((sb >> 9) & 1) << 5); R = (st >> 1) * 16 + swz / 64; C = (st & 1) * 32 + (swz % 64) / 2; }
__host__ __device__ __forceinline__ int perm32(int rho) { const int n = rho >> 4, i = rho & 15; return 8 * (i >> 2) + 4 * n + (i & 3); }

struct Unit { int pm, pn; };
struct Gemm { const bf16_t* A; const bf16_t* Bt; int M, N, K; };

struct StaticOrder {
    int nM, nN, nwg, G, c;
    __host__ __device__ void init(int M, int N, int G_, int c_) { nM = M / BM; nN = N / BM; nwg = nM * nN; G = G_; c = c_; }
    __host__ __device__ bool next(int i, Unit& u) const {
        const long L = (long)i * G + c; if (L >= nwg) return false;
        int wgid = (int)L; { const int q = nwg / NXCD, r = nwg % NXCD, xcd = wgid % NXCD, off = wgid / NXCD; wgid = (xcd < r ? xcd * (q + 1) : r * (q + 1) + (xcd - r) * q) + off; }
        const int nig = WGM * nN, gid = wgid / nig, fm = gid * WGM, gsz = (nM - fm) < WGM ? (nM - fm) : WGM;
        u.pm = fm + ((wgid % nig) % gsz); u.pn = (wgid % nig) / gsz; return true;
    }
    __device__ __forceinline__ void a_ready(const Unit&) const {}
    __device__ __forceinline__ void done(const Unit&) const {}
};

__device__ __forceinline__ unsigned cvt_pk_bf16(float lo, float hi) { unsigned r; asm volatile("v_cvt_pk_bf16_f32 %0, %1, %2" : "=v"(r) : "v"(lo), "v"(hi)); return r; }
typedef float f32x2 __attribute__((ext_vector_type(2)));
template <int ACT> struct EpiBf16 {
    static constexpr bool PERM = true, AFTER_DRAIN = false;
    bf16_t* O; int ldc;
    __device__ __forceinline__ void operator()(const f32x4 (&acc)[2][2][4][2], const Unit& u, int wr, int wc, int fr, int fq) const {
        const int row0 = u.pm * BM + wr * 64 + fr; const int col0 = u.pn * BM + wc * 32 + 8 * fq;
#pragma unroll
        for (int ai = 0; ai < 2; ++ai)
#pragma unroll
            for (int m = 0; m < 4; ++m) { bf16_t* rowp = O + (size_t)(row0 + ai * HALF + m * 16) * ldc + col0;
#pragma unroll
                for (int bj = 0; bj < 2; ++bj) { f32x4 v0 = acc[ai][bj][m][0], v1 = acc[ai][bj][m][1];
                    if (ACT == 2) {
#pragma unroll
                        for (int e = 0; e < 4; ++e) { float a = fmaxf(v0[e], 0.f), b = fmaxf(v1[e], 0.f); v0[e] = a * a; v1[e] = b * b; } }
                    u32x4 w; w.x = cvt_pk_bf16(v0[0], v0[1]); w.y = cvt_pk_bf16(v0[2], v0[3]); w.z = cvt_pk_bf16(v1[0], v1[1]); w.w = cvt_pk_bf16(v1[2], v1[3]);
                    *(u32x4*)(rowp + bj * HALF) = w; } }
    }
};
struct EpiResid {
    static constexpr bool PERM = false, AFTER_DRAIN = false;
    const float* base; float* out; int ldc;
    __device__ __forceinline__ void operator()(const f32x4 (&acc)[2][2][4][2], const Unit& u, int wr, int wc, int fr, int fq) const {
        const int col0 = u.pn * BM + wc * 32 + 4 * fq;
#pragma unroll
        for (int ai = 0; ai < 2; ++ai)
#pragma unroll
            for (int m = 0; m < 4; ++m) { const size_t off = (size_t)(u.pm * BM + ai * HALF + wr * 64 + m * 16 + fr) * ldc + col0;
#pragma unroll
                for (int bj = 0; bj < 2; ++bj)
#pragma unroll
                    for (int n = 0; n < 2; ++n) { const f32x4 bs = *(const f32x4*)(base + off + bj * HALF + n * 16); *(f32x4*)(out + off + bj * HALF + n * 16) = bs + acc[ai][bj][m][n]; } }
    }
};
__device__ __forceinline__ float row_rstd(const float* ssq, int row) {
    const f32x4* p = (const f32x4*)(ssq + (size_t)row * 16);
    const f32x4 a = p[0], b = p[1], c = p[2], d = p[3];
    const float s = (((a[0] + a[1]) + (a[2] + a[3])) + ((b[0] + b[1]) + (b[2] + b[3]))) + (((c[0] + c[1]) + (c[2] + c[3])) + ((d[0] + d[1]) + (d[2] + d[3])));
    return rsqrtf(s * (1.0f / 1024.0f) + 1e-6f);
}
#ifndef EPI_BATCH
#define EPI_BATCH 2
#endif
template <int ACT> struct EpiScaledBf16 {
    static constexpr bool PERM = true, AFTER_DRAIN = false;
    bf16_t* O; int ldc; const float* ssq; int gate_pn; float* gates; const float* ib; const float* fb;
    __device__ __forceinline__ void operator()(const f32x4 (&acc)[2][2][4][2], const Unit& u, int wr, int wc, int fr, int fq) const {
        const int row0 = u.pm * BM + wr * 64 + fr; const int col0 = u.pn * BM + wc * 32 + 8 * fq;
        const bool gate_tile = (u.pn == gate_pn);
        if (gate_tile && !(wc == 0 && fq == 0)) return;
#pragma unroll
        for (int ai = 0; ai < 2; ++ai)
#pragma unroll
        for (int mh = 0; mh < 4; mh += EPI_BATCH) {
            f32x4 p[EPI_BATCH][4]; float rs[EPI_BATCH];
#pragma unroll
            for (int m = 0; m < EPI_BATCH; ++m)
#pragma unroll
                for (int q = 0; q < 4; ++q) p[m][q] = *((const f32x4*)(ssq + (size_t)(row0 + ai * HALF + (mh + m) * 16) * 16) + q);
#pragma unroll
            for (int m = 0; m < EPI_BATCH; ++m) { const f32x4 t = (p[m][0] + p[m][1]) + (p[m][2] + p[m][3]); rs[m] = rsqrtf(((t[0] + t[1]) + (t[2] + t[3])) * (1.0f / 1024.0f) + 1e-6f); }
#pragma unroll
            for (int mm = 0; mm < EPI_BATCH; ++mm) { const int m = mh + mm; const int row = row0 + ai * HALF + m * 16; const float r = rs[mm];
                if (gate_tile) {
                    const f32x4 bi = *(const f32x4*)ib, bf = *(const f32x4*)fb;
                    *(f32x4*)(gates + (size_t)row * 8) = acc[ai][0][m][0] * r + bi; *(f32x4*)(gates + (size_t)row * 8 + 4) = acc[ai][0][m][1] * r + bf;
                } else {
                    bf16_t* rowp = O + (size_t)row * ldc + col0;
#pragma unroll
                    for (int bj = 0; bj < 2; ++bj) { f32x4 v0 = acc[ai][bj][m][0] * r, v1 = acc[ai][bj][m][1] * r;
                        if (ACT == 2) {
#pragma unroll
                            for (int e = 0; e < 4; ++e) { float a = fmaxf(v0[e], 0.f), b = fmaxf(v1[e], 0.f); v0[e] = a * a; v1[e] = b * b; } }
                        u32x4 w; w.x = cvt_pk_bf16(v0[0], v0[1]); w.y = cvt_pk_bf16(v0[2], v0[3]); w.z = cvt_pk_bf16(v1[0], v1[1]); w.w = cvt_pk_bf16(v1[2], v1[3]);
                        *(u32x4*)(rowp + bj * HALF) = w; }
                }
            }
            asm volatile("" ::: "memory");
        }
    }
};
struct EpiResidNorm {
    static constexpr bool PERM = false, AFTER_DRAIN = false;
    const float* base; float* out; bf16_t* xb; float* ssq; const float* xP; int ldc;
    __device__ __forceinline__ void operator()(const f32x4 (&acc)[2][2][4][2], const Unit& u, int wr, int wc, int fr, int fq) const {
        typedef unsigned u32x2v __attribute__((ext_vector_type(2)));
        const int col0 = u.pn * BM + wc * 32 + 4 * fq;
#pragma unroll
        for (int ai = 0; ai < 2; ++ai)
#pragma unroll
        for (int mh = 0; mh < 4; mh += EPI_BATCH) {
            f32x4 pre[EPI_BATCH][2][2];
#pragma unroll
            for (int mm = 0; mm < EPI_BATCH; ++mm) { const int m = mh + mm; const int row = u.pm * BM + ai * HALF + wr * 64 + m * 16 + fr; const bool p0 = xP != nullptr && (row & 4095) == 0;
                const float* src = p0 ? xP + (size_t)(row >> 12) * ldc + col0 : base + (size_t)row * ldc + col0;
#pragma unroll
                for (int bj = 0; bj < 2; ++bj)
#pragma unroll
                    for (int n = 0; n < 2; ++n) pre[mm][bj][n] = *(const f32x4*)(src + bj * HALF + n * 16); }
#pragma unroll
            for (int mm = 0; mm < EPI_BATCH; ++mm) { const int m = mh + mm; const int row = u.pm * BM + ai * HALF + wr * 64 + m * 16 + fr; const size_t off = (size_t)row * ldc + col0; float s = 0.f;
                const bool p0 = xP != nullptr && (row & 4095) == 0;
#pragma unroll
                for (int bj = 0; bj < 2; ++bj)
#pragma unroll
                    for (int n = 0; n < 2; ++n) { const int co = bj * HALF + n * 16;
                        f32x4 v = pre[mm][bj][n]; if (!p0) v = v + acc[ai][bj][m][n];
                        *(f32x4*)(out + off + co) = v; s += (v[0] * v[0] + v[1] * v[1]) + (v[2] * v[2] + v[3] * v[3]);
                        u32x2v w; w.x = cvt_pk_bf16(v[0], v[1]); w.y = cvt_pk_bf16(v[2], v[3]); *(u32x2v*)(xb + off + co) = w; }
                s += __shfl_xor(s, 16); s += __shfl_xor(s, 32);
                if (fq == 0) ssq[(size_t)row * 16 + u.pn * 4 + wc] = s; }
            asm volatile("" ::: "memory");
        }
    }
};
struct EpiNull {
    static constexpr bool PERM = false, AFTER_DRAIN = false;
    float* sink;
    __device__ __forceinline__ void operator()(const f32x4 (&acc)[2][2][4][2], const Unit& u, int wr, int wc, int fr, int fq) const {
        float s = 0.f;
#pragma unroll
        for (int ai = 0; ai < 2; ++ai)
#pragma unroll
            for (int bj = 0; bj < 2; ++bj)
#pragma unroll
                for (int m = 0; m < 4; ++m)
#pragma unroll
                    for (int n = 0; n < 2; ++n) s += (acc[ai][bj][m][n][0] + acc[ai][bj][m][n][1]) + (acc[ai][bj][m][n][2] + acc[ai][bj][m][n][3]);
        if (s == 1.2345678e33f) sink[0] = s;
    }
};
template <class Epi, class Sched, bool ALIGN_EPI = false, bool SP2 = false>
__device__ __forceinline__ void gemm_phase(PG8_LAS unsigned char* lds, const Gemm g, const Sched& S, const Epi& E) {
    int tid_o = threadIdx.x; asm volatile("" : "+v"(tid_o)); const int tid = tid_o, wid = __builtin_amdgcn_readfirstlane(tid >> 6), lane = tid & 63, wr = wid >> 2, wc = wid & 3, fr = lane & 15, fq = lane >> 4;
    const int K = g.K, nt = K / BK;
    unsigned voffA[2], voffB[2];
#pragma unroll
    for (int i = 0; i < 2; ++i) { int R, C; stage_rc(tid * 16 + i * 8192, R, C); const int Rb = Epi::PERM ? ((R & ~31) + perm32(R & 31)) : R;
        voffA[i] = (unsigned)(R * K + C) * 2u; voffB[i] = (unsigned)(Rb * K + C) * 2u; }
    const size_t kstep = (size_t)(BK * 2);
    const size_t hstep = (size_t)HALF * K * 2;
    const size_t tstep = 2 * hstep;
    const unsigned ldsw = (unsigned)wid * 1024u;
    const int aoff = lds_byte(wr * 64 + fr, fq * 8), boff = lds_byte(wc * 32 + fr, fq * 8);
#define PG8_SA(b, h) (((b) * 2 + (h)) * HTB)
#define PG8_SB(b, h) ((4 + (b) * 2 + (h)) * HTB)
#define PG8_STAGE(bufoff, gbase, voff) do { _Pragma("unroll") for (int _i = 0; _i < 2; ++_i) \
        __builtin_amdgcn_global_load_lds((const unsigned*)((const char*)(gbase) + (voff)[_i]), (PG8_LAS unsigned*)(lds + (bufoff) + ldsw + _i * 8192), 16, 0, 0); } while (0)
#define PG8_LDA(dst, b, h) do { _Pragma("unroll") for (int m = 0; m < 4; ++m) _Pragma("unroll") for (int k = 0; k < 2; ++k) dst[m][k] = *(const PG8_LAS bf16x8*)(lds + PG8_SA(b, h) + aoff + m * 2048 + k * 1024); } while (0)
#define PG8_LDB(dst, b, h) do { _Pragma("unroll") for (int n = 0; n < 2; ++n) _Pragma("unroll") for (int k = 0; k < 2; ++k) dst[n][k] = *(const PG8_LAS bf16x8*)(lds + PG8_SB(b, h) + boff + n * 2048 + k * 1024); } while (0)
#define PG8_MMA(ai, bj, At, Bt) do { __builtin_amdgcn_s_setprio(1); _Pragma("unroll") for (int m = 0; m < 4; ++m) _Pragma("unroll") for (int n = 0; n < 2; ++n) _Pragma("unroll") for (int k = 0; k < 2; ++k) \
        acc[ai][bj][m][n] = __builtin_amdgcn_mfma_f32_16x16x32_bf16(Bt[n][k], At[m][k], acc[ai][bj][m][n], 0, 0, 0); __builtin_amdgcn_s_setprio(0); } while (0)
#define PG8_WAIT_V(n) asm volatile("s_waitcnt vmcnt(" #n ")" ::: "memory")
#define PG8_WAIT_L(n) asm volatile("s_waitcnt lgkmcnt(" #n ")" ::: "memory")
#define PG8_BAR __builtin_amdgcn_s_barrier()
#define PG8_SCHED __builtin_amdgcn_sched_barrier(0)
    Unit cur, nxt; int ui = 0;
    if (!S.next(0, cur)) return;
    f32x4 acc[2][2][4][2];
#pragma unroll
    for (int a = 0; a < 2; ++a)
#pragma unroll
        for (int b = 0; b < 2; ++b)
#pragma unroll
            for (int m = 0; m < 4; ++m)
#pragma unroll
                for (int n = 0; n < 2; ++n) acc[a][b][m][n] = (f32x4){0.f, 0.f, 0.f, 0.f};
    bf16x8 At[4][2], B0[2][2], B1[2][2];
    const char* cA = (const char*)g.A + (size_t)cur.pm * tstep; const char* cB = (const char*)g.Bt + (size_t)cur.pn * tstep;
    S.a_ready(cur);
    if constexpr (SP2) {
        PG8_STAGE(PG8_SB(0, 0), cB, voffB); PG8_STAGE(PG8_SB(0, 1), cB + hstep, voffB); PG8_STAGE(PG8_SA(0, 0), cA, voffA); PG8_STAGE(PG8_SA(0, 1), cA + hstep, voffA);
        if (wr == 1) PG8_BAR;
        PG8_WAIT_V(2); PG8_BAR;
        PG8_STAGE(PG8_SB(1, 0), cB + kstep, voffB); PG8_STAGE(PG8_SA(1, 0), cA + kstep, voffA); PG8_STAGE(PG8_SB(1, 1), cB + hstep + kstep, voffB);
        PG8_WAIT_V(6); PG8_BAR;
    } else {
        PG8_STAGE(PG8_SB(0, 0), cB, voffB); PG8_STAGE(PG8_SA(0, 0), cA, voffA); PG8_STAGE(PG8_SB(0, 1), cB + hstep, voffB); PG8_STAGE(PG8_SA(0, 1), cA + hstep, voffA);
        if (wr == 1) PG8_BAR;
        PG8_WAIT_V(4); PG8_BAR;
        PG8_STAGE(PG8_SB(1, 0), cB + kstep, voffB); PG8_STAGE(PG8_SA(1, 0), cA + kstep, voffA); PG8_STAGE(PG8_SB(1, 1), cB + hstep + kstep, voffB);
        PG8_WAIT_V(6); PG8_BAR;
    }
    for (;;) {
        const bool has_next = S.next(ui + 1, nxt);
        const char* nA = has_next ? (const char*)g.A + (size_t)nxt.pm * tstep : cA; const char* nB = has_next ? (const char*)g.Bt + (size_t)nxt.pn * tstep : cB;
        for (int t = 0; t < nt; t += 2) {
            const bool last = (t == nt - 2);
            const char* a1 = cA + (size_t)(t + 1) * kstep;
            const char* a2 = last ? nA : cA + (size_t)(t + 2) * kstep; const char* b2 = last ? nB : cB + (size_t)(t + 2) * kstep;
            const char* a3 = a2 + kstep; const char* b3 = b2 + kstep;
            if (last && has_next) S.a_ready(nxt);
            if constexpr (SP2) {
            PG8_LDB(B0, 0, 0); PG8_LDB(B1, 0, 1); PG8_SCHED; PG8_LDA(At, 0, 0); PG8_STAGE(PG8_SA(1, 1), a1 + hstep, voffA);
            PG8_WAIT_V(8); PG8_WAIT_L(0); PG8_BAR; PG8_MMA(0, 0, At, B0); PG8_MMA(0, 1, At, B1); PG8_BAR; PG8_SCHED;
            PG8_LDA(At, 0, 1); PG8_STAGE(PG8_SB(0, 0), b2, voffB); PG8_STAGE(PG8_SB(0, 1), b2 + hstep, voffB); PG8_STAGE(PG8_SA(0, 0), a2, voffA);
            PG8_WAIT_V(8); PG8_WAIT_L(0); PG8_BAR; PG8_MMA(1, 0, At, B0); PG8_MMA(1, 1, At, B1); PG8_BAR; PG8_SCHED;
            PG8_LDB(B0, 1, 0); PG8_LDB(B1, 1, 1); PG8_SCHED; PG8_LDA(At, 1, 0); PG8_STAGE(PG8_SA(0, 1), a2 + hstep, voffA);
            PG8_WAIT_V(8); PG8_WAIT_L(0); PG8_BAR; PG8_MMA(0, 0, At, B0); PG8_MMA(0, 1, At, B1); PG8_BAR; PG8_SCHED;
            PG8_LDA(At, 1, 1); PG8_STAGE(PG8_SB(1, 0), b3, voffB); PG8_STAGE(PG8_SB(1, 1), b3 + hstep, voffB); PG8_STAGE(PG8_SA(1, 0), a3, voffA);
            PG8_WAIT_V(8); PG8_WAIT_L(0); PG8_BAR; PG8_MMA(1, 0, At, B0); PG8_MMA(1, 1, At, B1); PG8_BAR; PG8_SCHED;
            } else {
            PG8_LDB(B0, 0, 0); PG8_SCHED; PG8_LDA(At, 0, 0); PG8_STAGE(PG8_SA(1, 1), a1 + hstep, voffA);
            PG8_WAIT_L(8); PG8_BAR; PG8_WAIT_L(0); PG8_MMA(0, 0, At, B0); PG8_BAR; PG8_SCHED;
            PG8_LDB(B1, 0, 1); PG8_STAGE(PG8_SB(0, 0), b2, voffB);
            PG8_BAR; PG8_WAIT_L(0); PG8_MMA(0, 1, At, B1); PG8_BAR;
            PG8_LDA(At, 0, 1); PG8_STAGE(PG8_SA(0, 0), a2, voffA);
            PG8_BAR; PG8_WAIT_L(0); PG8_MMA(1, 0, At, B0); PG8_BAR; PG8_SCHED;
            PG8_STAGE(PG8_SB(0, 1), b2 + hstep, voffB);
            PG8_WAIT_V(6); PG8_BAR; PG8_MMA(1, 1, At, B1); PG8_BAR;
            PG8_LDB(B0, 1, 0); PG8_SCHED; PG8_LDA(At, 1, 0); PG8_STAGE(PG8_SA(0, 1), a2 + hstep, voffA);
            PG8_WAIT_L(8); PG8_BAR; PG8_WAIT_L(0); PG8_MMA(0, 0, At, B0); PG8_BAR; PG8_SCHED;
            PG8_LDB(B1, 1, 1); PG8_STAGE(PG8_SB(1, 0), b3, voffB);
            PG8_BAR; PG8_WAIT_L(0); PG8_MMA(0, 1, At, B1); PG8_BAR;
            PG8_LDA(At, 1, 1); PG8_STAGE(PG8_SA(1, 0), a3, voffA);
            PG8_BAR; PG8_WAIT_L(0); PG8_MMA(1, 0, At, B0); PG8_BAR; PG8_SCHED;
            PG8_STAGE(PG8_SB(1, 1), b3 + hstep, voffB);
            PG8_WAIT_V(6); PG8_BAR; PG8_MMA(1, 1, At, B1); PG8_BAR;
            }
        }
        if constexpr (ALIGN_EPI) { if (wr == 0) PG8_BAR; }
        if constexpr (!Epi::AFTER_DRAIN) { E(acc, cur, wr, wc, fr, fq); S.done(cur); }
        if (!has_next) break;
#pragma unroll
        for (int a = 0; a < 2; ++a)
#pragma unroll
            for (int b = 0; b < 2; ++b)
#pragma unroll
                for (int m = 0; m < 4; ++m)
#pragma unroll
                    for (int n = 0; n < 2; ++n) acc[a][b][m][n] = (f32x4){0.f, 0.f, 0.f, 0.f};
        cur = nxt; cA = nA; cB = nB; ++ui;
        if constexpr (ALIGN_EPI) { if (wr == 1) PG8_BAR; }
    }
    PG8_WAIT_V(0);
    if constexpr (!ALIGN_EPI) { if (wr == 0) PG8_BAR; }
    PG8_BAR;
    if constexpr (Epi::AFTER_DRAIN) { E.fused(acc, cur, wr, wc, fr, fq, lds, wid, lane); S.done(cur); }
#undef PG8_SA
#undef PG8_SB
#undef PG8_STAGE
#undef PG8_LDA
#undef PG8_LDB
#undef PG8_MMA
#undef PG8_WAIT_V
#undef PG8_WAIT_L
#undef PG8_BAR
#undef PG8_SCHED
}
}

constexpr int NWAVES = 8, NTHR = 512;
constexpr int BATCH = 4, SEQ = 4096, DM = 1024, DEPTH = 4, MTOK = BATCH * SEQ;
constexpr int N_IN = 2824, NP = 2816, NPAD = 3072, DFF = 4096;
constexpr int NCH = 32;
constexpr int PC_MX = 0, PC_MZ = 384, PC_RQ = 768, PC_RK = 1152, PC_RV = 1536, PC_RG = 1920, PC_GU = 2304, PC_GV = 2560;
constexpr int CAT_R = 384, CAT_G = 768;
constexpr float EPS = 1e-6f;
constexpr int NE_M = 97 * 96;
constexpr int NE_R = 64 * 64;

constexpr size_t MiB = 1u << 20;
constexpr size_t WS_CTL = 0;
constexpr size_t WS_WIN = 1 * MiB, WS_WOUT = 7 * MiB, WS_W1 = 9 * MiB, WS_W2 = 17 * MiB;
constexpr size_t WS_ROPE = 25 * MiB;
constexpr size_t WS_GATES = 26 * MiB;
constexpr size_t WS_SCAL = 27 * MiB;
constexpr size_t WS_XP = 27 * MiB + 65536;
constexpr size_t WS_PROJP = WS_XP + 16384;
constexpr size_t WS_CATP = WS_PROJP + 49152;
constexpr size_t WS_HIDP = WS_CATP + 16384;
constexpr size_t WS_H = 28 * MiB;
constexpr size_t WS_PROJ = 60 * MiB;
constexpr size_t WS_CAT = 148 * MiB;
constexpr size_t WS_MST = 180 * MiB;
constexpr size_t WS_RST = 199 * MiB;
constexpr size_t WS_HID = 60 * MiB;
constexpr size_t WS_WBUF1 = 210 * MiB;
constexpr size_t WS_SSQ = 236 * MiB;
constexpr size_t WS_END = 237 * MiB;
static_assert(WS_MST + (size_t)512 * NE_M * 4 <= WS_RST && WS_RST + (size_t)768 * NE_R * 4 <= 211 * MiB, "ws map");
static_assert(WS_HID + (size_t)MTOK * DFF * 2 <= WS_RST, "hid overlay");

#ifndef XREP_A
#define XREP_A 0
#endif
#ifndef XREP_C
#define XREP_C 0
#endif
#ifndef XREP_E_END
#define XREP_E_END 1280
#endif
#ifndef XREP_E
#define XREP_E 0
#endif
#ifndef XREP_D
#define XREP_D 0
#endif
#ifndef XREP_B
#define XREP_B 0
#endif
#ifndef XREP_H
#define XREP_H 0
#endif
#ifndef GEMM_SP2
#define GEMM_SP2 true
#endif
#ifndef GEMM_ALIGN
#define GEMM_ALIGN true
#endif
#ifndef XREP_G
#define XREP_G 0
#endif
constexpr int LDS_BYTES = 147456;

#define LAS __attribute__((address_space(3)))
typedef unsigned short bf16;
typedef unsigned v4u __attribute__((ext_vector_type(4)));
typedef unsigned v2u __attribute__((ext_vector_type(2)));
typedef float f32x4 __attribute__((ext_vector_type(4)));
typedef short bf16x8 __attribute__((ext_vector_type(8)));
typedef LAS unsigned char* ldsp;

__device__ __forceinline__ unsigned pk2(float lo, float hi) { return pg8::cvt_pk_bf16(lo, hi); }
__device__ __forceinline__ unsigned short f2bf(float f) { return (unsigned short)(pg8::cvt_pk_bf16(f, 0.f) & 0xffffu); }
__device__ __forceinline__ float bflo(unsigned u) { return __uint_as_float(u << 16); }
__device__ __forceinline__ float bfhi(unsigned u) { return __uint_as_float(u & 0xffff0000u); }
__device__ __forceinline__ float bf2f(unsigned short h) { return __uint_as_float((unsigned)h << 16); }
__device__ __forceinline__ float fast_rcp(float x) { return __builtin_amdgcn_rcpf(x); }
__device__ __forceinline__ float silu_f(float x) { return x * fast_rcp(1.f + __expf(-x)); }
__device__ __forceinline__ float gelu_tanh(float x) { const float u = 0.7978845608f * (x + 0.044715f * x * x * x); const float r = fast_rcp(__expf(2.f * u) + 1.f); return x - x * r; }
__device__ __forceinline__ float wave_sum(float v) {
#pragma unroll
    for (int o = 1; o < 64; o <<= 1) v += __shfl_xor(v, o);
    return v;
}
#define XB_TMO      128
#define XB_XCNT(j)  (256  + 64 * (j))
#define XB_XSUB(j)  (1280 + 64 * (j))
#define XB_XGEN(j)  (2304 + 64 * (j))
#define XB_TOP      3328
#define XB_TOPGEN   3392
#define XCD_BAR_WORDS 3456
#define XB_SPIN_CAP (1u << 18)

__device__ __forceinline__ unsigned xb_ld(unsigned* p)              { return __hip_atomic_load(p, __ATOMIC_RELAXED, __HIP_MEMORY_SCOPE_AGENT); }
__device__ __forceinline__ unsigned xb_add(unsigned* p, unsigned v) { return __hip_atomic_fetch_add(p, v, __ATOMIC_RELAXED, __HIP_MEMORY_SCOPE_AGENT); }
__device__ __forceinline__ unsigned xb_xcc_id() { return (unsigned)__builtin_amdgcn_s_getreg((3 << 11) | 20) & 0xFu; }
#define XB_SPIN(cond, bar) do { unsigned _sp = 0; while (cond) { __builtin_amdgcn_s_sleep(1); \
    if ((++_sp & 255u) == 0u) { if (xb_ld(&(bar)[XB_TMO])) break; if (_sp > XB_SPIN_CAP) { atomicAdd(&(bar)[XB_TMO], 1u); break; } } } } while (0)

struct XcdBarrier {
    unsigned* bar; unsigned x;
    volatile LAS unsigned* st;
};

__device__ __forceinline__ XcdBarrier xcd_barrier_post(unsigned* bar, volatile LAS unsigned* st) {
    XcdBarrier b; b.bar = bar; b.x = xb_xcc_id(); b.st = st;
    if (threadIdx.x == 0) (void)xb_add(&bar[XB_XCNT(b.x)], 1u);
    return b;
}
__device__ __forceinline__ void xcd_barrier_complete(unsigned* bar, unsigned x, unsigned& nloc, unsigned& nx) {
    const unsigned G = gridDim.x * gridDim.y * gridDim.z;
    unsigned sum, cnt, mine, sp = 0u;
    for (;;) {
        sum = 0u; cnt = 0u; mine = 0u;
#pragma unroll
        for (unsigned j = 0; j < 16; ++j) { const unsigned c = xb_ld(&bar[XB_XCNT(j)]); sum += c; cnt += (c > 0u) ? 1u : 0u; mine = (j == x) ? c : mine; }
        if (sum == G) break;
        __builtin_amdgcn_s_sleep(1);
        if ((++sp & 255u) == 0u) { if (xb_ld(&bar[XB_TMO])) break; if (sp > XB_SPIN_CAP) { atomicAdd(&bar[XB_TMO], 1u); break; } }
    }
    nloc = mine > 0u ? mine : 1u; nx = cnt > 0u ? cnt : 1u;
}

__device__ __forceinline__ void xcd_barrier(const XcdBarrier& b) {
    asm volatile("s_waitcnt vmcnt(0)" ::: "memory");
    __syncthreads();
    if (threadIdx.x == 0) {
        unsigned* bar = b.bar;
        __builtin_amdgcn_s_waitcnt(0);
        unsigned nloc = b.st[0], nx = b.st[1];
        if (nloc == 0u) { xcd_barrier_complete(bar, b.x, nloc, nx); b.st[0] = nloc; b.st[1] = nx; }
        const unsigned old = xb_add(&bar[XB_XSUB(b.x)], 1u);
        const unsigned gen = old / nloc;
        if (old + 1u == (gen + 1u) * nloc) {
            __builtin_amdgcn_fence(__ATOMIC_RELEASE, "agent");
            asm volatile("s_waitcnt vmcnt(0)" ::: "memory");
            const unsigned og = xb_add(&bar[XB_TOP], 1u);
            const unsigned tg = og / nx;
            if (og + 1u == (tg + 1u) * nx) xb_add(&bar[XB_TOPGEN], 1u);
            else XB_SPIN(xb_ld(&bar[XB_TOPGEN]) == tg, bar);
            __builtin_amdgcn_fence(__ATOMIC_ACQUIRE, "agent");
            xb_add(&bar[XB_XGEN(b.x)], 1u);
            asm volatile("s_waitcnt vmcnt(0)" ::: "memory");
        } else {
            XB_SPIN(xb_ld(&bar[XB_XGEN(b.x)]) == gen, bar);
            __builtin_amdgcn_fence(__ATOMIC_ACQUIRE, "agent");
            asm volatile("s_waitcnt vmcnt(0)" ::: "memory");
        }
    }
    __syncthreads();
}

typedef float f32x2 __attribute__((ext_vector_type(2)));
__device__ __forceinline__ f32x2 silu2(f32x2 x) { const f32x2 t = x * (-1.4426950408889634f); f32x2 e; e.x = __builtin_amdgcn_exp2f(t.x); e.y = __builtin_amdgcn_exp2f(t.y);
    const f32x2 d = e + 1.0f; f32x2 r; r.x = __builtin_amdgcn_rcpf(d.x); r.y = __builtin_amdgcn_rcpf(d.y); return x * r; }
__device__ __forceinline__ f32x2 gelu2(f32x2 x) { const f32x2 p = (x * x) * 0.10294324f + 2.3022082f; const f32x2 w = p * x; f32x2 e; e.x = __builtin_amdgcn_exp2f(w.x); e.y = __builtin_amdgcn_exp2f(w.y);
    const f32x2 d = e + 1.0f; f32x2 r; r.x = __builtin_amdgcn_rcpf(d.x); r.y = __builtin_amdgcn_rcpf(d.y); return x - x * r; }
#define LDS_WAIT() asm volatile("s_waitcnt lgkmcnt(0)" ::: "memory")
#define MFMA16(a, b, c) __builtin_amdgcn_mfma_f32_16x16x32_bf16((a), (b), (c), 0, 0, 0)

struct Args {
    const float* in[21];
    float* out; unsigned char* ws;
};
typedef const Args __attribute__((address_space(4)))* ArgsP;
enum { I_X = 0, I_NMG, I_WIN, I_CONVW, I_CONVB, I_WQ, I_WK, I_WV, I_IB, I_FB, I_MNG, I_SKIP, I_RNG, I_GNG, I_GWS, I_GBS, I_WOUT, I_NFG, I_WFF1, I_WFF2, I_FNG };

__device__ __forceinline__ void transpose_item(const float* W, int ldw, int col_src0, int nvalid, const float* gk, int K, bf16* WT, int n0, int k0, LAS float* scr, int lane) {
    float vv[32];
    const bool val = (lane & 31) < nvalid;
    const float* wp = W + (size_t)(k0 + (lane >> 5)) * ldw + col_src0 + (lane & 31);
#pragma unroll
    for (int i = 0; i < 32; ++i) vv[i] = val ? wp[(size_t)(2 * i) * ldw] : 0.f;
    if (gk) {
        const float* gp = gk + k0 + (lane >> 5);
#pragma unroll
        for (int i = 0; i < 32; ++i) vv[i] *= gp[2 * i];
    }
#pragma unroll
    for (int i = 0; i < 32; ++i) scr[(2 * i + (lane >> 5)) * 33 + (lane & 31)] = vv[i];
    LDS_WAIT(); asm volatile("" ::: "memory");
    const int c = lane & 7;
#pragma unroll
    for (int j = 0; j < 4; ++j) { const int n = (lane >> 3) + 8 * j; const LAS float* s = scr + (8 * c) * 33 + n;
        v4u o; o.x = pk2(s[0 * 33], s[1 * 33]); o.y = pk2(s[2 * 33], s[3 * 33]); o.z = pk2(s[4 * 33], s[5 * 33]); o.w = pk2(s[6 * 33], s[7 * 33]);
        *(v4u*)(WT + (size_t)(n0 + n) * K + k0 + 8 * c) = o; }
    LDS_WAIT(); asm volatile("" ::: "memory");
}

__device__ __forceinline__ void convert_weights(ArgsP a, int L, size_t wb, ldsp lds, int lane, int wave) {
    LAS float* scr = (LAS float*)(lds + 32768 + wave * 8448);
    const int gw = blockIdx.x * NWAVES + wave, NGW = gridDim.x * NWAVES;
    constexpr int I_IN = (DM / 64) * (NPAD / 32), I_O = (DM / 64) * (DM / 32), I_1 = (DM / 64) * (DFF / 32), I_2 = (DFF / 64) * (DM / 32);
    constexpr int NITEMS = I_IN + I_O + I_1 + I_2;
    unsigned char* ws = a->ws + wb;
    for (int it = gw; it < NITEMS; it += NGW) {
        int r = it;
        if (r < I_IN) { const int nblk = NPAD / 32, kb = r / nblk, nb = r % nblk, n0 = nb * 32;
            const int src = nb < 88 ? n0 + (n0 >= 768 ? 8 : 0) : 768, nv = nb < 88 ? 32 : (nb == 88 ? 8 : 0);
            transpose_item(a->in[I_WIN] + (size_t)L * DM * N_IN, N_IN, src, nv, a->in[I_NMG] + (size_t)L * DM, DM, (bf16*)(ws + WS_WIN), n0, kb * 64, scr, lane); continue; } r -= I_IN;
        if (r < I_O) { const int nblk = DM / 32, kb = r / nblk, nb = r % nblk; transpose_item(a->in[I_WOUT] + (size_t)L * DM * DM, DM, nb * 32, 32, nullptr, DM, (bf16*)(ws + WS_WOUT), nb * 32, kb * 64, scr, lane); continue; } r -= I_O;
        if (r < I_1) { const int nblk = DFF / 32, kb = r / nblk, nb = r % nblk; transpose_item(a->in[I_WFF1] + (size_t)L * DM * DFF, DFF, nb * 32, 32, a->in[I_NFG] + (size_t)L * DM, DM, (bf16*)(ws + WS_W1), nb * 32, kb * 64, scr, lane); continue; } r -= I_1;
        { const int nblk = DM / 32, kb = r / nblk, nb = r % nblk; transpose_item(a->in[I_WFF2] + (size_t)L * DFF * DM, DM, nb * 32, 32, nullptr, DFF, (bf16*)(ws + WS_W2), nb * 32, kb * 64, scr, lane); }
    }
}

template <bool GATES>
__device__ __forceinline__ void norm_rows(const float* x, const float* g, bf16* h, const LAS float* wgT, const float* ib, const float* fb, float* gates, int lane, int wave, const float* xP, float* wb) {
    const int gw = blockIdx.x * NWAVES + wave, NGW = gridDim.x * NWAVES;
    f32x4 gv[4];
#pragma unroll
    for (int j = 0; j < 4; ++j) gv[j] = ((const f32x4*)g)[lane + 64 * j];
    for (int m = gw; m < MTOK; m += NGW) {
        const bool p0 = xP != nullptr && (m & (SEQ - 1)) == 0;
        const f32x4* xr = (const f32x4*)(p0 ? xP + (size_t)(m >> 12) * DM : x + (size_t)m * DM) + lane;
        f32x4 v[4]; float ss = 0.f;
#pragma unroll
        for (int j = 0; j < 4; ++j) { v[j] = xr[64 * j]; ss += (v[j].x * v[j].x + v[j].y * v[j].y) + (v[j].z * v[j].z + v[j].w * v[j].w); }
        if (p0 && wb != nullptr) {
#pragma unroll
            for (int j = 0; j < 4; ++j) ((f32x4*)(wb + (size_t)m * DM) + lane)[64 * j] = v[j]; }
        const float rstd = rsqrtf(wave_sum(ss) * (1.f / DM) + EPS);
        unsigned long long* o8 = (unsigned long long*)(h + (size_t)m * DM) + lane;
#pragma unroll
        for (int j = 0; j < 4; ++j) { v[j] = v[j] * rstd * gv[j]; o8[64 * j] = (unsigned long long)pk2(v[j].x, v[j].y) | ((unsigned long long)pk2(v[j].z, v[j].w) << 32); }
        if (GATES) {
            float mine = 0.f;
#pragma unroll
            for (int c = 0; c < 8; ++c) {
                float p = 0.f;
#pragma unroll
                for (int j = 0; j < 4; ++j) { const f32x4 w = *(const LAS f32x4*)(wgT + c * 1024 + 4 * lane + 256 * j); p += (v[j].x * w.x + v[j].y * w.y) + (v[j].z * w.z + v[j].w * w.w); }
                p = wave_sum(p);
                if (lane == c) mine = p;
            }
            if (lane < 8) gates[(size_t)m * 8 + lane] = mine + (lane < 4 ? ib[lane] : fb[lane - 4]);
        }
    }
}

__device__ __forceinline__ float log_sigmoid_f(float f) { return fminf(f, 0.f) - __logf(1.f + __expf(-fabsf(f))); }
__device__ __forceinline__ void gates_cumsum(float f0, float f1, float& b0, float& b1, int lane) {
    const float l0 = log_sigmoid_f(f0), l1 = log_sigmoid_f(f1);
    float p = l0 + l1;
#pragma unroll
    for (int o = 1; o < 64; o <<= 1) { const float u = __shfl_up(p, o); if (lane >= o) p += u; }
    b1 = p; b0 = p - l1;
}
__device__ __forceinline__ void gates_prefmax(float g0, float g1, float& m0, float& m1, int lane) {
    float q = fmaxf(g0, g1);
#pragma unroll
    for (int o = 1; o < 64; o <<= 1) { const float u = __shfl_up(q, o); if (lane >= o) q = fmaxf(q, u); }
    const float ex = __shfl_up(q, 1);
    m1 = q; m0 = lane == 0 ? g0 : fmaxf(ex, g0);
}

struct MStage { f32x4 cw[4]; f32x4 cb; f32x4 wq[4], wk[4], wv[4]; v2u xr[11]; };
template <bool FULL>
__device__ __forceinline__ void mlstm_stage_load(ArgsP a, int L, int h, int t0, int s0, int tid, MStage& R) {
    if (tid < 384) {
        const bf16* proj = (const bf16*)(a->ws + WS_PROJ);
        const int blk = tid % 24, rg = tid / 24, l0 = rg * 8;
        const int ch0 = h * 96 + blk * 4, nb = h * 24 + blk;
#pragma unroll
        for (int r = 0; r < 11; ++r) { const int l = l0 - 3 + r;
            if (s0 + l >= 0) R.xr[r] = *(const v2u*)(proj + (size_t)(t0 + l) * NP + PC_MX + ch0); else R.xr[r] = (v2u){0u, 0u}; }
#pragma unroll
        for (int j = 0; j < 4; ++j) R.cw[j] = *(const f32x4*)(a->in[I_CONVW] + (size_t)L * 4 * 384 + j * 384 + ch0);
        R.cb = *(const f32x4*)(a->in[I_CONVB] + (size_t)L * 384 + ch0);
#pragma unroll
        for (int i = 0; i < 4; ++i) {
            R.wk[i] = *(const f32x4*)(a->in[I_WK] + ((size_t)L * 96 + nb) * 16 + i * 4);
            R.wv[i] = *(const f32x4*)(a->in[I_WV] + ((size_t)L * 96 + nb) * 16 + i * 4);
            if (FULL) R.wq[i] = *(const f32x4*)(a->in[I_WQ] + ((size_t)L * 96 + nb) * 16 + i * 4);
        }
    }
}
template <bool FULL>
__device__ __forceinline__ void mlstm_stage_compute(const MStage& R, ldsp XC, ldsp Q, ldsp K, ldsp VT, const LAS float* eend, int tid) {
    if (tid < 384) {
        const int blk = tid % 24, rg = tid / 24, l0 = rg * 8;
        f32x4 xm[11];
#pragma unroll
        for (int r = 0; r < 11; ++r) xm[r] = (f32x4){bflo(R.xr[r].x), bfhi(R.xr[r].x), bflo(R.xr[r].y), bfhi(R.xr[r].y)};
        const float kscale = 0.10206207261596575f;
        unsigned vpk[4][4], kpk[4][4];
        float vprev[4], kprev[4];
#pragma unroll
        for (int li = 0; li < 8; ++li) {
            f32x4 xc = R.cb;
#pragma unroll
            for (int j = 0; j < 4; ++j) xc = xc + R.cw[j] * xm[li + j];
            { const f32x2 s01 = silu2((f32x2){xc.x, xc.y}), s23 = silu2((f32x2){xc.z, xc.w}); xc = (f32x4){s01.x, s01.y, s23.x, s23.y}; }
            const f32x4 xr = xm[li + 3];
            f32x4 kk = (xc.x * R.wk[0] + xc.y * R.wk[1]) + (xc.z * R.wk[2] + xc.w * R.wk[3]);
            const f32x4 vv = (xr.x * R.wv[0] + xr.y * R.wv[1]) + (xr.z * R.wv[2] + xr.w * R.wv[3]);
            const int l = l0 + li;
            if (FULL) {
                const f32x4 qq = (xc.x * R.wq[0] + xc.y * R.wq[1]) + (xc.z * R.wq[2] + xc.w * R.wq[3]);
                kk = kk * kscale;
                *(LAS v2u*)(XC + l * 192 + blk * 8) = (v2u){pk2(xc.x, xc.y), pk2(xc.z, xc.w)};
                *(LAS v2u*)(Q + l * 208 + blk * 8) = (v2u){pk2(qq.x, qq.y), pk2(qq.z, qq.w)};
                *(LAS v2u*)(K + l * 208 + blk * 8) = (v2u){pk2(kk.x, kk.y), pk2(kk.z, kk.w)};
            } else {
                kk = kk * (kscale * eend[l]);
            }
            if (li & 1) {
#pragma unroll
                for (int jj = 0; jj < 4; ++jj) { vpk[jj][li >> 1] = pk2(vprev[jj], vv[jj]); if (!FULL) kpk[jj][li >> 1] = pk2(kprev[jj], kk[jj]); }
            } else {
#pragma unroll
                for (int jj = 0; jj < 4; ++jj) { vprev[jj] = vv[jj]; kprev[jj] = kk[jj]; }
            }
        }
#pragma unroll
        for (int jj = 0; jj < 4; ++jj) {
            *(LAS v4u*)(VT + (blk * 4 + jj) * 272 + l0 * 2) = (v4u){vpk[jj][0], vpk[jj][1], vpk[jj][2], vpk[jj][3]};
            if (!FULL) *(LAS v4u*)(K + (blk * 4 + jj) * 272 + l0 * 2) = (v4u){kpk[jj][0], kpk[jj][1], kpk[jj][2], kpk[jj][3]};
        }
    }
}

__device__ __forceinline__ void fill_vt_tail(ldsp VT, int tid) {
    if (tid < 384) return;
    const int i = tid - 384;
#pragma unroll
    for (int r = 0; r < 2; ++r) { const int idx = i + 128 * r;
        const int row = idx >> 4, c16 = idx & 15; unsigned w = row == 0 ? 0x3f803f80u : 0u; asm volatile("" : "+v"(w));
        *(LAS v4u*)(VT + (96 + row) * 272 + c16 * 16) = (v4u){w, w, w, w}; }
}

__device__ __forceinline__ void phaseC_mlstm(ArgsP a, int L, int item, ldsp lds, int tid, int lane, int wave) {
    const int bh = item >> 5, c = item & 31, b = bh >> 2, h = bh & 3;
    const int t0 = b * SEQ + c * 128, s0 = c * 128;
    ldsp EKT = lds, VT = lds + 26112;
    LAS float* eend = (LAS float*)(lds + 56576);
    const float* gates = (const float*)(a->ws + WS_GATES);
    float* scal = (float*)(a->ws + WS_SCAL);
    float i0 = 0.f, i1 = 0.f, f0 = 0.f, f1 = 0.f;
    if (wave == 7) { const float* gp = gates + (size_t)(t0 + 2 * lane) * 8; i0 = gp[h]; f0 = gp[4 + h]; i1 = gp[8 + h]; f1 = gp[12 + h]; }
    MStage R; mlstm_stage_load<false>(a, L, h, t0, s0, tid, R);
    if (wave == 7) {
        float b0, b1; gates_cumsum(f0, f1, b0, b1, lane);
        const float b_end = __shfl(b1, 63);
        const float w0 = b_end - b0 + i0, w1 = b_end - b1 + i1;
        float mx = fmaxf(w0, w1);
#pragma unroll
        for (int o = 1; o < 64; o <<= 1) mx = fmaxf(mx, __shfl_xor(mx, o));
        eend[2 * lane] = __expf(w0 - mx); eend[2 * lane + 1] = __expf(w1 - mx);
        if (lane == 0) { scal[item] = b_end; scal[512 + item] = mx; }
    }
    fill_vt_tail(VT, tid);
    __syncthreads();
    mlstm_stage_compute<false>(R, lds, lds, EKT, VT, eend, tid);
    __syncthreads();
    float* st = (float*)(a->ws + WS_MST) + (size_t)item * NE_M;
    const int fr = lane & 15, fq = lane >> 4;
    for (int tile = wave; tile < 42; tile += 8) {
        const int et = tile / 6, dt = tile % 6;
        f32x4 acc = {0.f, 0.f, 0.f, 0.f};
#pragma unroll
        for (int ks = 0; ks < 4; ++ks) {
            const bf16x8 av = *(const LAS bf16x8*)(VT + (et * 16 + fr) * 272 + ks * 64 + fq * 16);
            const bf16x8 bv = *(const LAS bf16x8*)(EKT + (dt * 16 + fr) * 272 + ks * 64 + fq * 16);
            acc = MFMA16(av, bv, acc);
        }
#pragma unroll
        for (int j = 0; j < 4; ++j) { const int e = et * 16 + fq * 4 + j; if (e < 97) st[e * 96 + dt * 16 + fr] = acc[j]; }
    }
    __syncthreads();
}

__device__ __forceinline__ float ret_log_gamma(int h) { return __logf(1.f - exp2f(-5.f - (float)h)); }

__device__ __forceinline__ void rotary16(const bf16* rowp, const float* cs, const float* sn, int j0, float scale, v4u& o1, v4u& o2) {
    const v4u u1 = *(const v4u*)(rowp + j0), u2 = *(const v4u*)(rowp + 32 + j0);
    const f32x4 c0 = *(const f32x4*)(cs + j0), c1 = *(const f32x4*)(cs + j0 + 4), s0 = *(const f32x4*)(sn + j0), s1 = *(const f32x4*)(sn + j0 + 4);
    float x1[8] = {bflo(u1.x), bfhi(u1.x), bflo(u1.y), bfhi(u1.y), bflo(u1.z), bfhi(u1.z), bflo(u1.w), bfhi(u1.w)};
    float x2[8] = {bflo(u2.x), bfhi(u2.x), bflo(u2.y), bfhi(u2.y), bflo(u2.z), bfhi(u2.z), bflo(u2.w), bfhi(u2.w)};
    float cc[8] = {c0.x, c0.y, c0.z, c0.w, c1.x, c1.y, c1.z, c1.w}, ss[8] = {s0.x, s0.y, s0.z, s0.w, s1.x, s1.y, s1.z, s1.w};
    float y1[8], y2[8];
#pragma unroll
    for (int i = 0; i < 8; ++i) { y1[i] = (x1[i] * cc[i] - x2[i] * ss[i]) * scale; y2[i] = (x2[i] * cc[i] + x1[i] * ss[i]) * scale; }
    o1 = (v4u){pk2(y1[0], y1[1]), pk2(y1[2], y1[3]), pk2(y1[4], y1[5]), pk2(y1[6], y1[7])};
    o2 = (v4u){pk2(y2[0], y2[1]), pk2(y2[2], y2[3]), pk2(y2[4], y2[5]), pk2(y2[6], y2[7])};
}

__device__ __forceinline__ void store_T8(ldsp dst, int e0, int stride, int l, v4u u) {
    const unsigned w[4] = {u.x, u.y, u.z, u.w};
#pragma unroll
    for (int i = 0; i < 4; ++i) {
        *(LAS unsigned short*)(dst + (e0 + 2 * i) * stride + l * 2) = (unsigned short)(w[i] & 0xffffu);
        *(LAS unsigned short*)(dst + (e0 + 2 * i + 1) * stride + l * 2) = (unsigned short)(w[i] >> 16);
    }
}

__device__ __forceinline__ void phaseC_ret(ArgsP a, int L, int item, ldsp lds, int tid, int lane, int wave) {
    const int bh = item >> 5, c = item & 31, b = bh / 6, h = bh % 6;
    const int t0 = b * SEQ + c * 128, s0 = c * 128;
    ldsp ZKT = lds, VT = lds + 17408;
    const bf16* proj = (const bf16*)(a->ws + WS_PROJ);
    const float* rope = (const float*)(a->ws + WS_ROPE);
    const float lg = ret_log_gamma(h);
    {
        const int l = tid >> 2, jc = tid & 3, j0 = jc * 8;
        const float zeta = __expf((127.f - (float)l) * lg);
        v4u o1, o2;
        rotary16(proj + (size_t)(t0 + l) * NP + PC_RK + h * 64, rope + (size_t)(s0 + l) * 32, rope + 4096 * 32 + (size_t)(s0 + l) * 32, j0, 0.125f * zeta, o1, o2);
        store_T8(ZKT, j0, 272, l, o1); store_T8(ZKT, 32 + j0, 272, l, o2);
        const bf16* vp = proj + (size_t)(t0 + l) * NP + PC_RV + h * 64 + jc * 16;
        const v4u v0 = *(const v4u*)vp, v1 = *(const v4u*)(vp + 8);
        store_T8(VT, jc * 16, 272, l, v0); store_T8(VT, jc * 16 + 8, 272, l, v1);
    }
    __syncthreads();
    float* st = (float*)(a->ws + WS_RST) + (size_t)item * NE_R;
    const int fr = lane & 15, fq = lane >> 4;
#pragma unroll
    for (int tt = 0; tt < 2; ++tt) {
        const int tile = wave * 2 + tt, et = tile >> 2, dt = tile & 3;
        f32x4 acc = {0.f, 0.f, 0.f, 0.f};
#pragma unroll
        for (int ks = 0; ks < 4; ++ks) {
            const bf16x8 av = *(const LAS bf16x8*)(VT + (et * 16 + fr) * 272 + ks * 64 + fq * 16);
            const bf16x8 bv = *(const LAS bf16x8*)(ZKT + (dt * 16 + fr) * 272 + ks * 64 + fq * 16);
            acc = MFMA16(av, bv, acc);
        }
#pragma unroll
        for (int j = 0; j < 4; ++j) st[(et * 16 + fq * 4 + j) * 64 + dt * 16 + fr] = acc[j];
    }
    __syncthreads();
}

__device__ __forceinline__ void phaseC_gmlp(ArgsP a, int L, int item, ldsp lds, int tid, int lane, int wave) {
    const int g = item & 3, bc = item >> 2, b = bc >> 5, c = bc & 31;
    const int t0 = b * SEQ + c * 128;
    ldsp W = lds, GVT = lds + 34816;
    const bf16* proj = (const bf16*)(a->ws + WS_PROJ);
    bf16* cat = (bf16*)(a->ws + WS_CAT);
    {
        const int l = tid >> 2, part = tid & 3;
        const bf16* vp = proj + (size_t)(t0 + l) * NP + PC_GV;
        float ss = 0.f;
#pragma unroll
        for (int i = 0; i < 8; ++i) { const v4u u = *(const v4u*)(vp + part * 64 + i * 8); const unsigned w[4] = {u.x, u.y, u.z, u.w};
#pragma unroll
            for (int q = 0; q < 4; ++q) { const f32x2 g = gelu2((f32x2){bflo(w[q]), bfhi(w[q])}); ss += g.x * g.x + g.y * g.y; } }
        ss += __shfl_xor(ss, 1); ss += __shfl_xor(ss, 2);
        const float rstd = rsqrtf(ss * (1.f / 256.f) + EPS);
        const float* gn = a->in[I_GNG] + (size_t)L * 256 + g * 64 + part * 16;
#pragma unroll
        for (int i = 0; i < 2; ++i) { const v4u u = *(const v4u*)(vp + g * 64 + part * 16 + i * 8); const unsigned w[4] = {u.x, u.y, u.z, u.w}; unsigned o[4];
#pragma unroll
            for (int q = 0; q < 4; ++q) { const f32x2 g = gelu2((f32x2){bflo(w[q]), bfhi(w[q])}) * rstd; o[q] = pk2(g.x * gn[i * 8 + 2 * q], g.y * gn[i * 8 + 2 * q + 1]); }
            store_T8(GVT, part * 16 + i * 8, 272, l, (v4u){o[0], o[1], o[2], o[3]}); }
    }
    {
        const float* wsrc = a->in[I_GWS] + ((size_t)L * 4 + g) * 128 * 128;
#pragma unroll
        for (int i = 0; i < 8; ++i) { const int idx4 = tid + 512 * i, t = idx4 >> 5, s4 = (idx4 & 31) * 4;
            f32x4 w = *(const f32x4*)(wsrc + (size_t)t * 128 + s4);
            if (s4 + 0 > t) w.x = 0.f; if (s4 + 1 > t) w.y = 0.f; if (s4 + 2 > t) w.z = 0.f; if (s4 + 3 > t) w.w = 0.f;
            *(LAS v2u*)(W + t * 272 + s4 * 2) = (v2u){pk2(w.x, w.y), pk2(w.z, w.w)}; }
    }
    __syncthreads();
    const int fr = lane & 15, fq = lane >> 4;
    const float* bs = a->in[I_GBS] + ((size_t)L * 4 + g) * 128;
    float bbv[4]; unsigned short uv[4][4];
#pragma unroll
    for (int j = 0; j < 4; ++j) { bbv[j] = bs[wave * 16 + fq * 4 + j];
#pragma unroll
        for (int n = 0; n < 4; ++n) uv[j][n] = proj[(size_t)(t0 + wave * 16 + fq * 4 + j) * NP + PC_GU + g * 64 + n * 16 + fr]; }
    f32x4 acc[4];
#pragma unroll
    for (int n = 0; n < 4; ++n) acc[n] = (f32x4){0.f, 0.f, 0.f, 0.f};
#pragma unroll
    for (int ks = 0; ks < 4; ++ks) {
        if (ks * 32 <= wave * 16 + 15) {
            const bf16x8 av = *(const LAS bf16x8*)(W + (wave * 16 + fr) * 272 + ks * 64 + fq * 16);
#pragma unroll
            for (int n = 0; n < 4; ++n) { const bf16x8 bv = *(const LAS bf16x8*)(GVT + (n * 16 + fr) * 272 + ks * 64 + fq * 16); acc[n] = MFMA16(av, bv, acc[n]); }
        }
    }
#pragma unroll
    for (int j = 0; j < 4; ++j) { const int t = wave * 16 + fq * 4 + j; const float bb = bbv[j];
#pragma unroll
        for (int n = 0; n < 4; n += 2) { const int e = n * 16 + fr;
            const f32x2 gu = gelu2((f32x2){bf2f(uv[j][n]), bf2f(uv[j][n + 1])});
            cat[(size_t)(t0 + t) * DM + CAT_G + g * 64 + e] = f2bf(gu.x * (acc[n][j] + bb));
            cat[(size_t)(t0 + t) * DM + CAT_G + g * 64 + e + 16] = f2bf(gu.y * (acc[n + 1][j] + bb)); } }
    __syncthreads();
}

__device__ __forceinline__ void phaseD(ArgsP a, ldsp lds, int tid) {
    LAS float* so = (LAS float*)lds; LAS float* sn = so + 512;
    float* scal = (float*)(a->ws + WS_SCAL);
    if (tid < 16) {
        float be[32], ac[32];
#pragma unroll
        for (int c = 0; c < 32; ++c) { be[c] = scal[tid * 32 + c]; ac[c] = scal[512 + tid * 32 + c]; }
        float m = 0.f;
#pragma unroll
        for (int c = 0; c < 32; ++c) { const float mn = fmaxf(be[c] + m, ac[c]); so[tid * 32 + c] = __expf(be[c] + m - mn); sn[tid * 32 + c] = __expf(ac[c] - mn);
            if (blockIdx.x == 0) scal[1024 + tid * 32 + c] = m; m = mn; }
    }
    __syncthreads();
    const int gt = blockIdx.x * NTHR + tid, NT = gridDim.x * NTHR;
    constexpr int TOT_M = 16 * NE_M, TOT_R = 24 * NE_R;
    for (int idx = gt; idx < TOT_M + TOT_R; idx += NT) {
        float v[32];
        if (idx < TOT_M) {
            const int bh = idx / NE_M, e = idx - bh * NE_M;
            float* p = (float*)(a->ws + WS_MST) + (size_t)bh * NCH * NE_M + e;
#pragma unroll
            for (int c = 0; c < 32; ++c) v[c] = p[(size_t)c * NE_M];
            float st = 0.f;
#pragma unroll
            for (int c = 0; c < 32; ++c) { p[(size_t)c * NE_M] = st; st = so[bh * 32 + c] * st + sn[bh * 32 + c] * v[c]; }
        } else {
            const int j = idx - TOT_M, bh = j >> 12, e = j & 4095, h = bh % 6;
            const float dec = __expf(128.f * ret_log_gamma(h));
            float* p = (float*)(a->ws + WS_RST) + (size_t)bh * NCH * NE_R + e;
#pragma unroll
            for (int c = 0; c < 32; ++c) v[c] = p[(size_t)c * NE_R];
            float st = 0.f;
#pragma unroll
            for (int c = 0; c < 32; ++c) { p[(size_t)c * NE_R] = st; st = dec * st + v[c]; }
        }
    }
    __syncthreads();
}

__device__ __forceinline__ void phaseE_mlstm(ArgsP a, int L, int item, ldsp lds, int tid, int lane, int wave) {
    const int bh = item >> 5, c = item & 31, b = bh >> 2, h = bh & 3;
    const int t0 = b * SEQ + c * 128, s0 = c * 128;
    ldsp XC = lds, Q = lds + 24576, K = lds + 51200, VT = lds + 77824, SC = lds + 108288, CT = SC;
    LAS float* fl = (LAS float*)(lds + 143104);
    LAS float* bcum = fl, *gsv = fl + 256, *mmv = fl + 384;
    const float* gates = (const float*)(a->ws + WS_GATES);
    const float* scal = (const float*)(a->ws + WS_SCAL);
    const bf16* proj = (const bf16*)(a->ws + WS_PROJ);
    bf16* cat = (bf16*)(a->ws + WS_CAT);
    const float m_prev = scal[1024 + item];
    float i0 = 0.f, i1 = 0.f, f0 = 0.f, f1 = 0.f;
    if (wave == 7) { const float* gp = gates + (size_t)(t0 + 2 * lane) * 8; i0 = gp[h]; f0 = gp[4 + h]; i1 = gp[8 + h]; f1 = gp[12 + h]; }
    MStage R; mlstm_stage_load<true>(a, L, h, t0, s0, tid, R);
    f32x4 ctv[6];
    {   const float* st = (const float*)(a->ws + WS_MST) + (size_t)item * NE_M;
#pragma unroll
        for (int i = 0; i < 6; ++i) { const int idx4 = tid + 512 * i, e = idx4 / 24, d4 = (idx4 % 24) * 4;
            ctv[i] = (f32x4){0.f, 0.f, 0.f, 0.f}; if (e < 97) ctv[i] = *(const f32x4*)(st + e * 96 + d4); } }
    if (wave == 7) {
        float b0, b1; gates_cumsum(f0, f1, b0, b1, lane);
        const float g0 = i0 - b0, g1 = i1 - b1; float p0, p1; gates_prefmax(g0, g1, p0, p1, lane);
        bcum[2 * lane] = b0; bcum[2 * lane + 1] = b1; gsv[2 * lane] = g0; gsv[2 * lane + 1] = g1;
        mmv[2 * lane] = fmaxf(m_prev, p0); mmv[2 * lane + 1] = fmaxf(m_prev, p1);
    }
    mlstm_stage_compute<true>(R, XC, Q, K, VT, nullptr, tid);
    fill_vt_tail(VT, tid);
#pragma unroll
    for (int i = 0; i < 6; ++i) { const int idx4 = tid + 512 * i, e = idx4 / 24, d4 = (idx4 % 24) * 4;
        if (idx4 < 112 * 24) *(LAS v2u*)(CT + e * 208 + d4 * 2) = (v2u){pk2(ctv[i].x, ctv[i].y), pk2(ctv[i].z, ctv[i].w)}; }
    __syncthreads();
    const int fr = lane & 15, fq = lane >> 4;
    const float* mng = a->in[I_MNG] + (size_t)L * 384 + h * 96;
    const float* skp = a->in[I_SKIP] + (size_t)L * 384 + h * 96;
    float gcol[6], scol[6];
#pragma unroll
    for (int n = 0; n < 6; ++n) { gcol[n] = mng[n * 16 + fr]; scol[n] = skp[n * 16 + fr]; }
    v4u zc[3];
#pragma unroll
    for (int i = 0; i < 3; ++i) { const int q = lane + 64 * i, r = q / 12, cc = q % 12; zc[i] = *(const v4u*)(proj + (size_t)(t0 + wave * 16 + r) * NP + PC_MZ + h * 96 + cc * 8); }
    bf16x8 aq[3];
#pragma unroll
    for (int ks = 0; ks < 3; ++ks) aq[ks] = *(const LAS bf16x8*)(Q + (wave * 16 + fr) * 208 + ks * 64 + fq * 16);
    f32x4 acc2[7];
#pragma unroll
    for (int n = 0; n < 7; ++n) { acc2[n] = (f32x4){0.f, 0.f, 0.f, 0.f};
#pragma unroll
        for (int ks = 0; ks < 3; ++ks) { const bf16x8 bv = *(const LAS bf16x8*)(CT + (n * 16 + fr) * 208 + ks * 64 + fq * 16); acc2[n] = MFMA16(aq[ks], bv, acc2[n]); } }
    f32x4 sacc[8];
#pragma unroll
    for (int st = 0; st < 8; ++st) { sacc[st] = (f32x4){0.f, 0.f, 0.f, 0.f};
        if (st <= wave) {
#pragma unroll
            for (int ks = 0; ks < 3; ++ks) { const bf16x8 bv = *(const LAS bf16x8*)(K + (st * 16 + fr) * 208 + ks * 64 + fq * 16); sacc[st] = MFMA16(aq[ks], bv, sacc[st]); } } }
    float mmr[4];
#pragma unroll
    for (int j = 0; j < 4; ++j) mmr[j] = mmv[wave * 16 + fq * 4 + j];
    __syncthreads();
#pragma unroll
    for (int st = 0; st < 8; ++st) {
        if (st <= (wave | 1)) {
            const int s = st * 16 + fr; const float gsl = gsv[s];
#pragma unroll
            for (int j = 0; j < 4; ++j) { const int l = wave * 16 + fq * 4 + j;
                const float wgt = (s <= l) ? __expf(gsl - mmr[j]) : 0.f;
                *(LAS unsigned short*)(SC + l * 272 + s * 2) = f2bf(sacc[st][j] * wgt); }
        }
    }
    asm volatile("" ::: "memory");
    f32x4 acc1[7];
#pragma unroll
    for (int n = 0; n < 7; ++n) acc1[n] = (f32x4){0.f, 0.f, 0.f, 0.f};
#pragma unroll
    for (int ks = 0; ks < 4; ++ks) {
        if (ks * 2 <= wave) {
            const bf16x8 av = *(const LAS bf16x8*)(SC + (wave * 16 + fr) * 272 + ks * 64 + fq * 16);
#pragma unroll
            for (int n = 0; n < 7; ++n) { const bf16x8 bv = *(const LAS bf16x8*)(VT + (n * 16 + fr) * 272 + ks * 64 + fq * 16); acc1[n] = MFMA16(av, bv, acc1[n]); }
        }
    }
#pragma unroll
    for (int i = 0; i < 3; ++i) { const int q = lane + 64 * i, r = q / 12, cc = q % 12; *(LAS v4u*)(Q + (wave * 16 + r) * 208 + cc * 16) = zc[i]; }
#pragma unroll
    for (int j = 0; j < 4; ++j) {
        const int l = wave * 16 + fq * 4 + j;
        const float sint = __expf(m_prev - mmr[j]);
        float den = acc1[6][j] + sint * acc2[6][j];
        den = __shfl(den, lane & 48);
        const float flo = __expf(-(bcum[l] + mmr[j]));
        const float inv = fast_rcp(fmaxf(fabsf(den), flo));
        float hv[6]; float ss = 0.f;
#pragma unroll
        for (int n = 0; n < 6; ++n) { hv[n] = (acc1[n][j] + sint * acc2[n][j]) * inv; ss += hv[n] * hv[n]; }
        ss += __shfl_xor(ss, 1); ss += __shfl_xor(ss, 2); ss += __shfl_xor(ss, 4); ss += __shfl_xor(ss, 8);
        const float rstd = rsqrtf(ss * (1.f / 96.f) + EPS);
#pragma unroll
        for (int n = 0; n < 6; n += 2) { const int e = n * 16 + fr;
            const float xc0 = bf2f(*(const LAS unsigned short*)(XC + l * 192 + e * 2)), xc1 = bf2f(*(const LAS unsigned short*)(XC + l * 192 + (e + 16) * 2));
            const f32x2 sz = silu2((f32x2){bf2f(*(const LAS unsigned short*)(Q + l * 208 + e * 2)), bf2f(*(const LAS unsigned short*)(Q + l * 208 + (e + 16) * 2))});
            *(LAS unsigned short*)(SC + l * 272 + e * 2) = f2bf((hv[n] * rstd * gcol[n] + scol[n] * xc0) * sz.x);
            *(LAS unsigned short*)(SC + l * 272 + (e + 16) * 2) = f2bf((hv[n + 1] * rstd * gcol[n + 1] + scol[n + 1] * xc1) * sz.y); }
    }
#pragma unroll
    for (int i = 0; i < 3; ++i) { const int q = lane + 64 * i, r = q / 12, cc = q % 12;
        *(v4u*)(cat + (size_t)(t0 + wave * 16 + r) * DM + h * 96 + cc * 8) = *(const LAS v4u*)(SC + (wave * 16 + r) * 272 + cc * 16); }
    __syncthreads();
}

__device__ __forceinline__ void phaseE_ret(ArgsP a, int L, int item, ldsp lds, int tid, int lane, int wave) {
    const int bh = item >> 5, c = item & 31, b = bh / 6, h = bh % 6;
    const int t0 = b * SEQ + c * 128, s0 = c * 128;
    ldsp Q = lds, K = lds + 18432, VT = lds + 36864, SC = lds + 54272, RT = SC;
    const bf16* proj = (const bf16*)(a->ws + WS_PROJ);
    const float* rope = (const float*)(a->ws + WS_ROPE);
    bf16* cat = (bf16*)(a->ws + WS_CAT);
    const float lg = ret_log_gamma(h);
    {
        const int l = tid >> 2, jc = tid & 3, j0 = jc * 8;
        const float* cs = rope + (size_t)(s0 + l) * 32; const float* sn = rope + 4096 * 32 + (size_t)(s0 + l) * 32;
        v4u o1, o2;
        rotary16(proj + (size_t)(t0 + l) * NP + PC_RQ + h * 64, cs, sn, j0, 1.f, o1, o2);
        *(LAS v4u*)(Q + l * 144 + j0 * 2) = o1; *(LAS v4u*)(Q + l * 144 + (32 + j0) * 2) = o2;
        rotary16(proj + (size_t)(t0 + l) * NP + PC_RK + h * 64, cs, sn, j0, 0.125f, o1, o2);
        *(LAS v4u*)(K + l * 144 + j0 * 2) = o1; *(LAS v4u*)(K + l * 144 + (32 + j0) * 2) = o2;
        const bf16* vp = proj + (size_t)(t0 + l) * NP + PC_RV + h * 64 + jc * 16;
        const v4u v0 = *(const v4u*)vp, v1 = *(const v4u*)(vp + 8);
        store_T8(VT, jc * 16, 272, l, v0); store_T8(VT, jc * 16 + 8, 272, l, v1);
        const float* st = (const float*)(a->ws + WS_RST) + (size_t)item * NE_R;
#pragma unroll
        for (int i = 0; i < 2; ++i) { const int idx4 = tid + 512 * i, e = idx4 >> 4, d4 = (idx4 & 15) * 4;
            const f32x4 w = *(const f32x4*)(st + e * 64 + d4);
            *(LAS v2u*)(RT + e * 144 + d4 * 2) = (v2u){pk2(w.x, w.y), pk2(w.z, w.w)}; }
    }
    __syncthreads();
    const int fr = lane & 15, fq = lane >> 4;
    const float* rng = a->in[I_RNG] + (size_t)L * 384 + h * 64;
    float gcol[4];
#pragma unroll
    for (int n = 0; n < 4; ++n) gcol[n] = rng[n * 16 + fr];
    v4u gc[2];
#pragma unroll
    for (int i = 0; i < 2; ++i) { const int q = lane + 64 * i, r = q >> 3, cc = q & 7; gc[i] = *(const v4u*)(proj + (size_t)(t0 + wave * 16 + r) * NP + PC_RG + h * 64 + cc * 8); }
    bf16x8 aq[2];
#pragma unroll
    for (int ks = 0; ks < 2; ++ks) aq[ks] = *(const LAS bf16x8*)(Q + (wave * 16 + fr) * 144 + ks * 64 + fq * 16);
    f32x4 acc2[4];
#pragma unroll
    for (int n = 0; n < 4; ++n) { acc2[n] = (f32x4){0.f, 0.f, 0.f, 0.f};
#pragma unroll
        for (int ks = 0; ks < 2; ++ks) { const bf16x8 bv = *(const LAS bf16x8*)(RT + (n * 16 + fr) * 144 + ks * 64 + fq * 16); acc2[n] = MFMA16(aq[ks], bv, acc2[n]); } }
    f32x4 sacc[8];
#pragma unroll
    for (int st = 0; st < 8; ++st) { sacc[st] = (f32x4){0.f, 0.f, 0.f, 0.f};
        if (st <= wave) {
#pragma unroll
            for (int ks = 0; ks < 2; ++ks) { const bf16x8 bv = *(const LAS bf16x8*)(K + (st * 16 + fr) * 144 + ks * 64 + fq * 16); sacc[st] = MFMA16(aq[ks], bv, sacc[st]); } } }
    __syncthreads();
    float rowf[4];
#pragma unroll
    for (int j = 0; j < 4; ++j) rowf[j] = __expf((float)(fq * 4 + j - fr) * lg);
#pragma unroll
    for (int st = 0; st < 8; ++st) {
        if (st <= (wave | 1)) {
            const int s = st * 16 + fr; const float tf = __expf((float)((wave - st) * 16) * lg);
#pragma unroll
            for (int j = 0; j < 4; ++j) { const int l = wave * 16 + fq * 4 + j;
                const float wgt = (s <= l) ? rowf[j] * tf : 0.f;
                *(LAS unsigned short*)(SC + l * 272 + s * 2) = f2bf(sacc[st][j] * wgt); }
        }
    }
    asm volatile("" ::: "memory");
    f32x4 acc1[4];
#pragma unroll
    for (int n = 0; n < 4; ++n) acc1[n] = (f32x4){0.f, 0.f, 0.f, 0.f};
#pragma unroll
    for (int ks = 0; ks < 4; ++ks) {
        if (ks * 2 <= wave) {
            const bf16x8 av = *(const LAS bf16x8*)(SC + (wave * 16 + fr) * 272 + ks * 64 + fq * 16);
#pragma unroll
            for (int n = 0; n < 4; ++n) { const bf16x8 bv = *(const LAS bf16x8*)(VT + (n * 16 + fr) * 272 + ks * 64 + fq * 16); acc1[n] = MFMA16(av, bv, acc1[n]); }
        }
    }
#pragma unroll
    for (int i = 0; i < 2; ++i) { const int q = lane + 64 * i, r = q >> 3, cc = q & 7; *(LAS v4u*)(Q + (wave * 16 + r) * 144 + cc * 16) = gc[i]; }
#pragma unroll
    for (int j = 0; j < 4; ++j) {
        const int l = wave * 16 + fq * 4 + j;
        const float xi = __expf((float)(l + 1) * lg);
        float hv[4]; float ss = 0.f;
#pragma unroll
        for (int n = 0; n < 4; ++n) { hv[n] = acc1[n][j] + xi * acc2[n][j]; ss += hv[n] * hv[n]; }
        ss += __shfl_xor(ss, 1); ss += __shfl_xor(ss, 2); ss += __shfl_xor(ss, 4); ss += __shfl_xor(ss, 8);
        const float rstd = rsqrtf(ss * (1.f / 64.f) + EPS);
#pragma unroll
        for (int n = 0; n < 4; n += 2) { const int e = n * 16 + fr;
            const f32x2 sg = silu2((f32x2){bf2f(*(const LAS unsigned short*)(Q + l * 144 + e * 2)), bf2f(*(const LAS unsigned short*)(Q + l * 144 + (e + 16) * 2))});
            *(LAS unsigned short*)(SC + l * 272 + e * 2) = f2bf(hv[n] * rstd * gcol[n] * sg.x);
            *(LAS unsigned short*)(SC + l * 272 + (e + 16) * 2) = f2bf(hv[n + 1] * rstd * gcol[n + 1] * sg.y); }
    }
#pragma unroll
    for (int i = 0; i < 2; ++i) { const int q = lane + 64 * i, r = q >> 3, cc = q & 7;
        *(v4u*)(cat + (size_t)(t0 + wave * 16 + r) * DM + CAT_R + h * 64 + cc * 8) = *(const LAS v4u*)(SC + (wave * 16 + r) * 272 + cc * 16); }
    __syncthreads();
}


template <int MODE, int PER>
__device__ __forceinline__ void gemv4_item(const LAS float* A, const float* W, int ldw, int ncol0, int nvalid, int kb, float* out, int ldo, int ocol0, LAS float* red, int tid) {
    constexpr int klen = PER * 16, CH = PER < 32 ? PER : 32;
    const int kq = tid >> 5, c = tid & 31, k0 = kq * PER;
    float acc[4] = {0.f, 0.f, 0.f, 0.f};
    if (c < nvalid) {
        const float* wp = W + (size_t)(kb + k0) * ldw + ncol0 + c;
#pragma unroll
        for (int kk = 0; kk < PER; kk += CH) {
            float w[CH];
#pragma unroll
            for (int i = 0; i < CH; ++i) w[i] = wp[(size_t)(kk + i) * ldw];
#pragma unroll
            for (int i = 0; i < CH; ++i)
#pragma unroll
                for (int r = 0; r < 4; ++r) acc[r] += A[r * klen + k0 + kk + i] * w[i];
        }
    }
#pragma unroll
    for (int r = 0; r < 4; ++r) red[(kq * 4 + r) * 32 + c] = acc[r];
    __syncthreads();
    if (tid < 128) { const int r = tid >> 5; float s = 0.f;
#pragma unroll
        for (int q = 0; q < 16; ++q) s += red[(q * 4 + r) * 32 + c];
        if (c < nvalid) { float* o = out + (size_t)r * ldo + ocol0 + c;
            if (MODE == 0) *o = s; else if (MODE == 1) { const float t = fmaxf(s, 0.f); *o = t * t; } else atomicAdd(o, s); } }
    __syncthreads();
}
__device__ __forceinline__ void precise_norm_to_lds(const float* x0, size_t row_stride, const float* g, LAS float* A, int lane, int wave) {
    if (wave < 4) { const f32x4* xr = (const f32x4*)(x0 + (size_t)wave * row_stride) + lane; f32x4 v[4]; float ss = 0.f;
#pragma unroll
        for (int j = 0; j < 4; ++j) { v[j] = xr[64 * j]; ss += (v[j].x * v[j].x + v[j].y * v[j].y) + (v[j].z * v[j].z + v[j].w * v[j].w); }
        const float rstd = rsqrtf(wave_sum(ss) * (1.f / DM) + EPS);
#pragma unroll
        for (int j = 0; j < 4; ++j) { const f32x4 gv = ((const f32x4*)g)[lane + 64 * j]; *(LAS f32x4*)(A + wave * 1024 + 4 * lane + 256 * j) = v[j] * rstd * gv; } }
    __syncthreads();
}
__device__ __forceinline__ void lds_copy_rows(const float* src, int ld, int kb, int klen, LAS float* A, int tid) {
    for (int i = tid; i < 4 * klen; i += NTHR) { const int r = i / klen, k = i - r * klen; A[i] = src[(size_t)r * ld + kb + k]; }
    __syncthreads();
}
__device__ __forceinline__ void precise_mixer(ArgsP a, int L, int b, ldsp lds, int tid, int lane, int wave) {
    LAS float* XC = (LAS float*)lds, *XM = XC + 384, *Qs = XC + 768, *Ks = XC + 1152, *Vs = XC + 1536;
    const float* projP = (const float*)(a->ws + WS_PROJP); float* catP = (float*)(a->ws + WS_CATP);
    {
        const float* p = projP + (size_t)b * N_IN; float* o = catP + (size_t)b * DM;
        if (tid < 384) { const float x = p[tid]; XM[tid] = x; XC[tid] = silu_f(a->in[I_CONVW][(size_t)L * 4 * 384 + 3 * 384 + tid] * x + a->in[I_CONVB][(size_t)L * 384 + tid]); }
        __syncthreads();
        if (tid < 384) { const int nb = tid >> 2, j = tid & 3; float q = 0.f, k = 0.f, v = 0.f;
#pragma unroll
            for (int i = 0; i < 4; ++i) { const size_t wi = ((size_t)L * 96 + nb) * 16 + i * 4 + j; q += XC[nb * 4 + i] * a->in[I_WQ][wi]; k += XC[nb * 4 + i] * a->in[I_WK][wi]; v += XM[nb * 4 + i] * a->in[I_WV][wi]; }
            Qs[tid] = q; Ks[tid] = k * 0.10206207261596575f; Vs[tid] = v; }
        __syncthreads();
        if (wave < 4) {
            const int h = wave; const int d0 = h * 96 + lane, d1 = h * 96 + 64 + lane; const bool two = lane < 32;
            float s = Qs[d0] * Ks[d0] + (two ? Qs[d1] * Ks[d1] : 0.f); s = wave_sum(s);
            const float ig = p[768 + h] + a->in[I_IB][L * 4 + h], f = p[772 + h] + a->in[I_FB][L * 4 + h];
            const float logf = fminf(f, 0.f) - __logf(1.f + __expf(-fabsf(f)));
            const float mt = fmaxf(logf, ig), wts = __expf(ig - mt), den = s * wts, inv = 1.f / fmaxf(fabsf(den), __expf(-mt));
            const float h0 = den * Vs[d0] * inv, h1 = two ? den * Vs[d1] * inv : 0.f;
            const float rstd = rsqrtf(wave_sum(h0 * h0 + h1 * h1) * (1.f / 96.f) + EPS);
            const float* mg = a->in[I_MNG] + (size_t)L * 384; const float* sk = a->in[I_SKIP] + (size_t)L * 384;
            o[d0] = (h0 * rstd * mg[d0] + sk[d0] * XC[d0]) * silu_f(p[384 + d0]);
            if (two) o[d1] = (h1 * rstd * mg[d1] + sk[d1] * XC[d1]) * silu_f(p[384 + d1]);
        } else {
            for (int h = wave - 4; h < 6; h += 4) { const int d = h * 64 + lane;
                const float s = wave_sum(p[776 + d] * p[1160 + d]) * 0.125f; const float val = s * p[1544 + d];
                const float rstd = rsqrtf(wave_sum(val * val) * (1.f / 64.f) + EPS);
                o[CAT_R + d] = val * rstd * a->in[I_RNG][(size_t)L * 384 + d] * silu_f(p[1928 + d]); }
        }
        if (wave < 4) {
            const int g = wave; float gl[4]; float ss = 0.f;
#pragma unroll
            for (int i = 0; i < 4; ++i) { gl[i] = gelu_tanh(p[2568 + lane + 64 * i]); ss += gl[i] * gl[i]; }
            const float rstd = rsqrtf(wave_sum(ss) * (1.f / 256.f) + EPS);
            float gv = 0.f;
#pragma unroll
            for (int i = 0; i < 4; ++i) if (i == g) gv = gl[i];
            gv = gv * rstd * a->in[I_GNG][(size_t)L * 256 + g * 64 + lane];
            const float w00 = a->in[I_GWS][((size_t)L * 4 + g) * 128 * 128], b0 = a->in[I_GBS][((size_t)L * 4 + g) * 128];
            o[CAT_G + g * 64 + lane] = gelu_tanh(p[2312 + g * 64 + lane]) * (w00 * gv + b0);
        }
        __syncthreads();
    }
}

__global__ void __launch_bounds__(NTHR, 2) fwd_kernel(Args a_unused) {
    extern __shared__ __attribute__((aligned(16))) unsigned char lds_raw[];
    cg::grid_group grid = cg::this_grid();
    ldsp lds = (ldsp)lds_raw;
#define PHASE_BEGIN() int tid_o = threadIdx.x; asm volatile("" : "+v"(tid_o)); const int tid = tid_o, lane = tid & 63, wave = __builtin_amdgcn_readfirstlane(tid >> 6); (void)lane; (void)wave; \
    ArgsP a = (ArgsP)__builtin_amdgcn_kernarg_segment_ptr(); asm volatile("" : "+s"(a)); unsigned char* ws = a->ws; (void)ws; const int G = gridDim.x; (void)G;
    volatile LAS unsigned* MISC = (volatile LAS unsigned*)(lds + LDS_BYTES - 64);
    if (threadIdx.x < 16) MISC[threadIdx.x] = 0u;
    __syncthreads();
    { ArgsP a = (ArgsP)__builtin_amdgcn_kernarg_segment_ptr(); (void)xcd_barrier_post((unsigned*)(a->ws + WS_CTL), MISC); }
#define GRID_SYNC() do { ArgsP a_b = (ArgsP)__builtin_amdgcn_kernarg_segment_ptr(); asm volatile("" : "+s"(a_b)); XcdBarrier bar_; bar_.bar = (unsigned*)(a_b->ws + WS_CTL); bar_.x = xb_xcc_id(); \
        bar_.st = (volatile LAS unsigned*)(lds + LDS_BYTES - 64); xcd_barrier(bar_); } while (0)

    {
        PHASE_BEGIN();
        float* rope = (float*)(ws + WS_ROPE);
        for (int idx = blockIdx.x * NTHR + tid; idx < 4096 * 32; idx += G * NTHR) {
            const int pos = idx >> 5, j = idx & 31;
            const float freq = exp2f(-(float)j * (13.287712379549449f / 32.f));
            const double ang = (double)pos * (double)freq;
            double rev = ang * 0.15915494309189535; rev -= __builtin_rint(rev);
            const float fr = (float)rev;
            rope[idx] = __builtin_amdgcn_cosf(fr); rope[4096 * 32 + idx] = __builtin_amdgcn_sinf(fr);
        }
        {
            const int gw = blockIdx.x * NWAVES + wave, NGW = G * NWAVES;
            const float* x = a->in[I_X]; bf16* xb = (bf16*)(ws + WS_H); float* ssq = (float*)(ws + WS_SSQ);
            for (int m0 = gw; m0 < MTOK; m0 += 4 * NGW) {
                f32x4 v[4][4];
#pragma unroll
                for (int r = 0; r < 4; ++r) { const int m = m0 + r * NGW; if (m < MTOK) { const f32x4* xr = (const f32x4*)(x + (size_t)m * DM) + lane;
#pragma unroll
                    for (int j = 0; j < 4; ++j) v[r][j] = xr[64 * j]; } }
#pragma unroll
                for (int r = 0; r < 4; ++r) { const int m = m0 + r * NGW; if (m < MTOK) { float ss = 0.f;
#pragma unroll
                    for (int j = 0; j < 4; ++j) ss += (v[r][j].x * v[r][j].x + v[r][j].y * v[r][j].y) + (v[r][j].z * v[r][j].z + v[r][j].w * v[r][j].w);
                    ss = wave_sum(ss);
                    unsigned long long* o8 = (unsigned long long*)(xb + (size_t)m * DM) + lane;
#pragma unroll
                    for (int j = 0; j < 4; ++j) o8[64 * j] = (unsigned long long)pk2(v[r][j].x, v[r][j].y) | ((unsigned long long)pk2(v[r][j].z, v[r][j].w) << 32);
                    if (lane < 16) ssq[(size_t)m * 16 + lane] = lane == 0 ? ss : 0.f; } }
            }
        }
        convert_weights(a, 0, 0, lds, lane, wave);
        if (blockIdx.x == 0) { float* xP = (float*)(ws + WS_XP); for (int i = tid; i < 4 * DM; i += NTHR) xP[i] = a->in[I_X][(size_t)(i >> 10) * SEQ * DM + (i & 1023)]; }
    }
    { ArgsP a = (ArgsP)__builtin_amdgcn_kernarg_segment_ptr(); asm volatile("" : "+s"(a)); if (a->ws == nullptr) grid.sync(); }
    GRID_SYNC();

    for (int L = 0; L < DEPTH; ++L) {
        if ((int)blockIdx.x < 89) {
            PHASE_BEGIN();
            const float* xP = (const float*)(ws + WS_XP);
            LAS float* Ap = (LAS float*)(lds + 100352); LAS float* red = (LAS float*)(lds + 116736);
            precise_norm_to_lds(L == 0 ? a->in[I_X] : xP, L == 0 ? (size_t)SEQ * DM : (size_t)DM, a->in[I_NMG] + (size_t)L * DM, Ap, lane, wave);
            { const int cg_ = (int)blockIdx.x;
                gemv4_item<0, 64>(Ap, a->in[I_WIN] + (size_t)L * DM * N_IN, N_IN, cg_ * 32, cg_ == 88 ? 8 : 32, 0, (float*)(ws + WS_PROJP), N_IN, cg_ * 32, red, tid); }
        }
        {
            PHASE_BEGIN();
            const size_t wb = (L & 1) ? WS_WBUF1 : 0;
            pg8::Gemm g{(const bf16*)(ws + WS_H), (const bf16*)(ws + wb + WS_WIN), MTOK, NPAD, DM}; pg8::StaticOrder S; S.init(MTOK, NPAD, G, (int)blockIdx.x);
            pg8::EpiScaledBf16<0> E{(bf16*)(ws + WS_PROJ), NP, (const float*)(ws + WS_SSQ), 11, (float*)(ws + WS_GATES), a->in[I_IB] + L * 4, a->in[I_FB] + L * 4};
            for (int rep = 0; rep < 1 + XREP_B; ++rep) pg8::gemm_phase<pg8::EpiScaledBf16<0>, pg8::StaticOrder, GEMM_ALIGN, GEMM_SP2>(lds, g, S, E);
        }
        GRID_SYNC();
        if ((int)blockIdx.x >= (int)gridDim.x - 4) { PHASE_BEGIN(); precise_mixer(a, L, (int)blockIdx.x - (G - 4), lds, tid, lane, wave); }
        for (int rep = 0; rep < 1 + XREP_C; ++rep)
        for (int it = blockIdx.x; it < 1792; it += gridDim.x) {
            PHASE_BEGIN();
            if (it < 512) phaseC_mlstm(a, L, it, lds, tid, lane, wave);
            else if (it < 1280) phaseC_ret(a, L, it - 512, lds, tid, lane, wave);
            else phaseC_gmlp(a, L, it - 1280, lds, tid, lane, wave);
        }
        GRID_SYNC();
        {
            PHASE_BEGIN();
            phaseD(a, lds, tid);
            if ((int)blockIdx.x < 128) { const int pi = blockIdx.x, cg_ = pi & 31, ks = pi >> 5; LAS float* Ap = (LAS float*)lds; LAS float* red = (LAS float*)(lds + 16384);
                lds_copy_rows((const float*)(ws + WS_CATP), DM, ks * 256, 256, Ap, tid);
                gemv4_item<2, 16>(Ap, a->in[I_WOUT] + (size_t)L * DM * DM, DM, cg_ * 32, 32, ks * 256, (float*)(ws + WS_XP), DM, cg_ * 32, red, tid); }
            if (L + 1 < DEPTH) convert_weights(a, L + 1, ((L + 1) & 1) ? WS_WBUF1 : 0, lds, lane, wave);
        }
        GRID_SYNC();
        for (int rep = 0; rep < 1 + XREP_E; ++rep)
        for (int it = blockIdx.x; it < (rep == 0 ? 1280 + 128 : XREP_E_END); it += gridDim.x) {
            PHASE_BEGIN();
            if (it >= 1280) { const int cg_ = it - 1280; LAS float* Ap = (LAS float*)lds; LAS float* red = (LAS float*)(lds + 16384);
                precise_norm_to_lds((const float*)(ws + WS_XP), DM, a->in[I_NFG] + (size_t)L * DM, Ap, lane, wave);
                gemv4_item<1, 64>(Ap, a->in[I_WFF1] + (size_t)L * DM * DFF, DFF, cg_ * 32, 32, 0, (float*)(ws + WS_HIDP), DFF, cg_ * 32, red, tid); continue; }
            if (it < 512) phaseE_mlstm(a, L, it, lds, tid, lane, wave);
            else phaseE_ret(a, L, it - 512, lds, tid, lane, wave);
        }
        GRID_SYNC();
        {
            PHASE_BEGIN();
            const size_t wb = (L & 1) ? WS_WBUF1 : 0;
            pg8::Gemm g{(const bf16*)(ws + WS_CAT), (const bf16*)(ws + wb + WS_WOUT), MTOK, DM, DM}; pg8::StaticOrder S; S.init(MTOK, DM, G, (int)blockIdx.x);
            pg8::EpiResidNorm E{(L == 0) ? a->in[I_X] : a->out, a->out, (bf16*)(ws + WS_H), (float*)(ws + WS_SSQ), nullptr, DM};
            pg8::gemm_phase<pg8::EpiResidNorm, pg8::StaticOrder, true, GEMM_SP2>(lds, g, S, E);
        }
        GRID_SYNC();
        {
            PHASE_BEGIN();
            { const int pi = blockIdx.x, cg_ = pi & 31, ks = pi >> 5; LAS float* Ap = (LAS float*)lds; LAS float* red = (LAS float*)(lds + 16384);
              if (pi < 256) { lds_copy_rows((const float*)(ws + WS_HIDP), DFF, ks * 512, 512, Ap, tid);
                gemv4_item<2, 32>(Ap, a->in[I_WFF2] + (size_t)L * DFF * DM, DM, cg_ * 32, 32, ks * 512, (float*)(ws + WS_XP), DM, cg_ * 32, red, tid); } }
        }
        {
            PHASE_BEGIN();
            const size_t wb = (L & 1) ? WS_WBUF1 : 0;
            pg8::Gemm g{(const bf16*)(ws + WS_H), (const bf16*)(ws + wb + WS_W1), MTOK, DFF, DM}; pg8::StaticOrder S; S.init(MTOK, DFF, G, (int)blockIdx.x);
            pg8::EpiScaledBf16<2> E{(bf16*)(ws + WS_HID), DFF, (const float*)(ws + WS_SSQ), -1, nullptr, nullptr, nullptr};
            for (int rep = 0; rep < 1 + XREP_H; ++rep) pg8::gemm_phase<pg8::EpiScaledBf16<2>, pg8::StaticOrder, GEMM_ALIGN, GEMM_SP2>(lds, g, S, E);
        }
        GRID_SYNC();
        {
            PHASE_BEGIN();
            const size_t wb = (L & 1) ? WS_WBUF1 : 0;
            pg8::Gemm g{(const bf16*)(ws + WS_HID), (const bf16*)(ws + wb + WS_W2), MTOK, DM, DFF}; pg8::StaticOrder S; S.init(MTOK, DM, G, (int)blockIdx.x);
            pg8::EpiResidNorm E{a->out, a->out, (bf16*)(ws + WS_H), (float*)(ws + WS_SSQ), (const float*)(ws + WS_XP), DM};
            pg8::gemm_phase<pg8::EpiResidNorm, pg8::StaticOrder, true, GEMM_SP2>(lds, g, S, E);
        }
        GRID_SYNC();
    }
    {
        PHASE_BEGIN();
        const int gw = blockIdx.x * NWAVES + wave, NGW = G * NWAVES;
        const float* g = a->in[I_FNG]; const float* xP = (const float*)(ws + WS_XP);
        f32x4 gv[4];
#pragma unroll
        for (int j = 0; j < 4; ++j) gv[j] = ((const f32x4*)g)[lane + 64 * j];
        for (int m0 = gw; m0 < MTOK; m0 += 4 * NGW) {
            f32x4 v[4][4];
#pragma unroll
            for (int r = 0; r < 4; ++r) { const int m = m0 + r * NGW; if (m < MTOK) {
                const f32x4* xs = (m & (SEQ - 1)) == 0 ? (const f32x4*)(xP + (size_t)(m >> 12) * DM) + lane : (const f32x4*)(a->out + (size_t)m * DM) + lane;
#pragma unroll
                for (int j = 0; j < 4; ++j) v[r][j] = xs[64 * j]; } }
#pragma unroll
            for (int r = 0; r < 4; ++r) { const int m = m0 + r * NGW; if (m < MTOK) { float ss = 0.f;
#pragma unroll
                for (int j = 0; j < 4; ++j) ss += (v[r][j].x * v[r][j].x + v[r][j].y * v[r][j].y) + (v[r][j].z * v[r][j].z + v[r][j].w * v[r][j].w);
                const float rstd = rsqrtf(wave_sum(ss) * (1.f / DM) + EPS);
                f32x4* xr = (f32x4*)(a->out + (size_t)m * DM) + lane;
#pragma unroll
                for (int j = 0; j < 4; ++j) xr[64 * j] = v[r][j] * rstd * gv[j]; } }
        }
    }
}

extern "C" void kernel_launch(void* const* d_in, const int* in_sizes, int n_in, void* d_out, int out_size, void* d_ws, size_t ws_size, hipStream_t stream) {
    static int grid = 0;
    if (grid == 0) {
        if (n_in != 21 || out_size != MTOK * DM || ws_size < WS_END) { fprintf(stderr, "kernel_launch: unexpected shapes (n_in %d out %d ws %zu)\n", n_in, out_size, ws_size); grid = -1; return; }
        int dev = 0, cus = 0, per_cu = 0;
        hipGetDevice(&dev);
        hipDeviceGetAttribute(&cus, hipDeviceAttributeMultiprocessorCount, dev);
        if (hipFuncSetAttribute((const void*)fwd_kernel, hipFuncAttributeMaxDynamicSharedMemorySize, LDS_BYTES) != hipSuccess) { fprintf(stderr, "kernel_launch: hipFuncSetAttribute failed\n"); grid = -1; return; }
        if (hipOccupancyMaxActiveBlocksPerMultiprocessor(&per_cu, (const void*)fwd_kernel, NTHR, LDS_BYTES) != hipSuccess || per_cu < 1) { fprintf(stderr, "kernel_launch: occupancy query says %d\n", per_cu); per_cu = 1; }
        (void)hipGetLastError();
        grid = cus;
        fprintf(stderr, "kernel_launch: cus %d per_cu %d grid %d\n", cus, per_cu, grid);
    }
    if (grid < 0) return;
    if (hipMemsetAsync((char*)d_ws + WS_CTL, 0, 16384, stream) != hipSuccess) { fprintf(stderr, "kernel_launch: memset failed\n"); return; }
    Args a{};
    for (int i = 0; i < 21; ++i) a.in[i] = (const float*)d_in[i];
    a.out = (float*)d_out; a.ws = (unsigned char*)d_ws;
    void* args[] = {&a};
    hipError_t e = hipLaunchCooperativeKernel((const void*)fwd_kernel, dim3(grid), dim3(NTHR), args, LDS_BYTES, stream);
    if (e != hipSuccess) fprintf(stderr, "cooperative launch failed: %s (grid %d)\n", hipGetErrorString(e), grid);
}
```

```cpp
#define EPI_BATCH 4
#include <hip/hip_runtime.h>
#include <hip/hip_cooperative_groups.h>
#include <cstdio>
#include <cstdint>
namespace cg = cooperative_groups;
namespace pg8 {
#define PG8_LAS __attribute__((address_space(3)))
typedef unsigned short bf16_t;
typedef short bf16x8 __attribute__((ext_vector_type(8)));
typedef float f32x4 __attribute__((ext_vector_type(4)));
typedef unsigned u32x4 __attribute__((ext_vector_type(4)));
constexpr int BM = 256, BK = 64, HALF = 128, HTB = HALF * BK * 2  , STAGE_BYTES = 8 * HTB, NXCD = 8, WGM = 8;

__host__ __device__ __forceinline__ int lds_byte(int r, int c) { const int st = (r >> 4) * 2 + (c >> 5), rr = r & 15, cc = c & 31, ob = rr * 64 + cc * 2; return st * 1024 + (ob ^ (((ob >> 9) & 1) << 5)); }
__host__ __device__ __forceinline__ void stage_rc(int b, int& R, int& C) { const int st = b / 1024, sb = b % 1024, swz = sb ^ (((sb >> 9) & 1) << 5); R = (st >> 1) * 16 + swz / 64; C = (st & 1) * 32 + (swz % 64) / 2; }
__host__ __device__ __forceinline__ int perm32(int rho) { const int n = rho >> 4, i = rho & 15; return 8 * (i >> 2) + 4 * n + (i & 3); }

struct Unit { int pm, pn; };
struct Gemm { const bf16_t* A; const bf16_t* Bt; int M, N, K; };

struct StaticOrder {
    int nM, nN, nwg, G, c;
    __host__ __device__ void init(int M, int N, int G_, int c_) { nM = M / BM; nN = N / BM; nwg = nM * nN; G = G_; c = c_; }
    __host__ __device__ bool next(int i, Unit& u) const {
        const long L = (long)i * G + c; if (L >= nwg) return false;
        int wgid = (int)L; { const int q = nwg / NXCD, r = nwg % NXCD, xcd = wgid % NXCD, off = wgid / NXCD; wgid = (xcd < r ? xcd * (q + 1) : r * (q + 1) + (xcd - r) * q) + off; }
        const int nig = WGM * nN, gid = wgid / nig, fm = gid * WGM, gsz = (nM - fm) < WGM ? (nM - fm) : WGM;
        u.pm = fm + ((wgid % nig) % gsz); u.pn = (wgid % nig) / gsz; return true;
    }
    __device__ __forceinline__ void a_ready(const Unit&) const {}
    __device__ __forceinline__ void done(const Unit&) const {}
};

__device__ __forceinline__ unsigned cvt_pk_bf16(float lo, float hi) { unsigned r; asm volatile("v_cvt_pk_bf16_f32 %0, %1, %2" : "=v"(r) : "v"(lo), "v"(hi)); return r; }
typedef float f32x2 __attribute__((ext_vector_type(2)));
template <int ACT> struct EpiBf16 {
    static constexpr bool PERM = true, AFTER_DRAIN = false;
    bf16_t* O; int ldc;
    __device__ __forceinline__ void operator()(const f32x4 (&acc)[2][2][4][2], const Unit& u, int wr, int wc, int fr, int fq) const {
        const int row0 = u.pm * BM + wr * 64 + fr; const int col0 = u.pn * BM + wc * 32 + 8 * fq;
#pragma unroll
        for (int ai = 0; ai < 2; ++ai)
#pragma unroll
            for (int m = 0; m < 4; ++m) { bf16_t* rowp = O + (size_t)(row0 + ai * HALF + m * 16) * ldc + col0;
#pragma unroll
                for (int bj = 0; bj < 2; ++bj) { f32x4 v0 = acc[ai][bj][m][0], v1 = acc[ai][bj][m][1];
                    if (ACT == 2) {
#pragma unroll
                        for (int e = 0; e < 4; ++e) { float a = fmaxf(v0[e], 0.f), b = fmaxf(v1[e], 0.f); v0[e] = a * a; v1[e] = b * b; } }
                    u32x4 w; w.x = cvt_pk_bf16(v0[0], v0[1]); w.y = cvt_pk_bf16(v0[2], v0[3]); w.z = cvt_pk_bf16(v1[0], v1[1]); w.w = cvt_pk_bf16(v1[2], v1[3]);
                    *(u32x4*)(rowp + bj * HALF) = w; } }
    }
};
struct EpiResid {
    static constexpr bool PERM = false, AFTER_DRAIN = false;
    const float* base; float* out; int ldc;
    __device__ __forceinline__ void operator()(const f32x4 (&acc)[2][2][4][2], const Unit& u, int wr, int wc, int fr, int fq) const {
        const int col0 = u.pn * BM + wc * 32 + 4 * fq;
#pragma unroll
        for (int ai = 0; ai < 2; ++ai)
#pragma unroll
            for (int m = 0; m < 4; ++m) { const size_t off = (size_t)(u.pm * BM + ai * HALF + wr * 64 + m * 16 + fr) * ldc + col0;
#pragma unroll
                for (int bj = 0; bj < 2; ++bj)
#pragma unroll
                    for (int n = 0; n < 2; ++n) { const f32x4 bs = *(const f32x4*)(base + off + bj * HALF + n * 16); *(f32x4*)(out + off + bj * HALF + n * 16) = bs + acc[ai][bj][m][n]; } }
    }
};
__device__ __forceinline__ float row_rstd(const float* ssq, int row) {
    const f32x4* p = (const f32x4*)(ssq + (size_t)row * 16);
    const f32x4 a = p[0], b = p[1], c = p[2], d = p[3];
    const float s = (((a[0] + a[1]) + (a[2] + a[3])) + ((b[0] + b[1]) + (b[2] + b[3]))) + (((c[0] + c[1]) + (c[2] + c[3])) + ((d[0] + d[1]) + (d[2] + d[3])));
    return rsqrtf(s * (1.0f / 1024.0f) + 1e-6f);
}
#ifndef EPI_BATCH
#define EPI_BATCH 2
#endif
template <int ACT> struct EpiScaledBf16 {
    static constexpr bool PERM = true, AFTER_DRAIN = false;
    bf16_t* O; int ldc; const float* ssq; int gate_pn; float* gates; const float* ib; const float* fb;
    __device__ __forceinline__ void operator()(const f32x4 (&acc)[2][2][4][2], const Unit& u, int wr, int wc, int fr, int fq) const {
        const int row0 = u.pm * BM + wr * 64 + fr; const int col0 = u.pn * BM + wc * 32 + 8 * fq;
        const bool gate_tile = (u.pn == gate_pn);
        if (gate_tile && !(wc == 0 && fq == 0)) return;
#pragma unroll
        for (int ai = 0; ai < 2; ++ai)
#pragma unroll
        for (int mh = 0; mh < 4; mh += EPI_BATCH) {
            f32x4 p[EPI_BATCH][4]; float rs[EPI_BATCH];
#pragma unroll
            for (int m = 0; m < EPI_BATCH; ++m)
#pragma unroll
                for (int q = 0; q < 4; ++q) p[m][q] = *((const f32x4*)(ssq + (size_t)(row0 + ai * HALF + (mh + m) * 16) * 16) + q);
#pragma unroll
            for (int m = 0; m < EPI_BATCH; ++m) { const f32x4 t = (p[m][0] + p[m][1]) + (p[m][2] + p[m][3]); rs[m] = rsqrtf(((t[0] + t[1]) + (t[2] + t[3])) * (1.0f / 1024.0f) + 1e-6f); }
#pragma unroll
            for (int mm = 0; mm < EPI_BATCH; ++mm) { const int m = mh + mm; const int row = row0 + ai * HALF + m * 16; const float r = rs[mm];
                if (gate_tile) {
                    const f32x4 bi = *(const f32x4*)ib, bf = *(const f32x4*)fb;
                    *(f32x4*)(gates + (size_t)row * 8) = acc[ai][0][m][0] * r + bi; *(f32x4*)(gates + (size_t)row * 8 + 4) = acc[ai][0][m][1] * r + bf;
                } else {
                    bf16_t* rowp = O + (size_t)row * ldc + col0;
#pragma unroll
                    for (int bj = 0; bj < 2; ++bj) { f32x4 v0 = acc[ai][bj][m][0] * r, v1 = acc[ai][bj][m][1] * r;
                        if (ACT == 2) {
#pragma unroll
                            for (int e = 0; e < 4; ++e) { float a = fmaxf(v0[e], 0.f), b = fmaxf(v1[e], 0.f); v0[e] = a * a; v1[e] = b * b; } }
                        u32x4 w; w.x = cvt_pk_bf16(v0[0], v0[1]); w.y = cvt_pk_bf16(v0[2], v0[3]); w.z = cvt_pk_bf16(v1[0], v1[1]); w.w = cvt_pk_bf16(v1[2], v1[3]);
                        *(u32x4*)(rowp + bj * HALF) = w; }
                }
            }
            asm volatile("" ::: "memory");
        }
    }
};
struct EpiResidNorm {
    static constexpr bool PERM = false, AFTER_DRAIN = false;
    const float* base; float* out; bf16_t* xb; float* ssq; const float* xP; int ldc;
    __device__ __forceinline__ void operator()(const f32x4 (&acc)[2][2][4][2], const Unit& u, int wr, int wc, int fr, int fq) const {
        typedef unsigned u32x2v __attribute__((ext_vector_type(2)));
        const int col0 = u.pn * BM + wc * 32 + 4 * fq;
#pragma unroll
        for (int ai = 0; ai < 2; ++ai)
#pragma unroll
        for (int mh = 0; mh < 4; mh += EPI_BATCH) {
            f32x4 pre[EPI_BATCH][2][2];
#pragma unroll
            for (int mm = 0; mm < EPI_BATCH; ++mm) { const int m = mh + mm; const int row = u.pm * BM + ai * HALF + wr * 64 + m * 16 + fr; const bool p0 = xP != nullptr && (row & 4095) == 0;
                const float* src = p0 ? xP + (size_t)(row >> 12) * ldc + col0 : base + (size_t)row * ldc + col0;
#pragma unroll
                for (int bj = 0; bj < 2; ++bj)
#pragma unroll
                    for (int n = 0; n < 2; ++n) pre[mm][bj][n] = *(const f32x4*)(src + bj * HALF + n * 16); }
#pragma unroll
            for (int mm = 0; mm < EPI_BATCH; ++mm) { const int m = mh + mm; const int row = u.pm * BM + ai * HALF + wr * 64 + m * 16 + fr; const size_t off = (size_t)row * ldc + col0; float s = 0.f;
                const bool p0 = xP != nullptr && (row & 4095) == 0;
#pragma unroll
                for (int bj = 0; bj < 2; ++bj)
#pragma unroll
                    for (int n = 0; n < 2; ++n) { const int co = bj * HALF + n * 16;
                        f32x4 v = pre[mm][bj][n]; if (!p0) v = v + acc[ai][bj][m][n];
                        *(f32x4*)(out + off + co) = v; s += (v[0] * v[0] + v[1] * v[1]) + (v[2] * v[2] + v[3] * v[3]);
                        u32x2v w; w.x = cvt_pk_bf16(v[0], v[1]); w.y = cvt_pk_bf16(v[2], v[3]); *(u32x2v*)(xb + off + co) = w; }
                s += __shfl_xor(s, 16); s += __shfl_xor(s, 32);
                if (fq == 0) ssq[(size_t)row * 16 + u.pn * 4 + wc] = s; }
            asm volatile("" ::: "memory");
        }
    }
};
struct EpiNull {
    static constexpr bool PERM = false, AFTER_DRAIN = false;
    float* sink;
    __device__ __forceinline__ void operator()(const f32x4 (&acc)[2][2][4][2], const Unit& u, int wr, int wc, int fr, int fq) const {
        float s = 0.f;
#pragma unroll
        for (int ai = 0; ai < 2; ++ai)
#pragma unroll
            for (int bj = 0; bj < 2; ++bj)
#pragma unroll
                for (int m = 0; m < 4; ++m)
#pragma unroll
                    for (int n = 0; n < 2; ++n) s += (acc[ai][bj][m][n][0] + acc[ai][bj][m][n][1]) + (acc[ai][bj][m][n][2] + acc[ai][bj][m][n][3]);
        if (s == 1.2345678e33f) sink[0] = s;
    }
};
template <class Epi, class Sched, bool ALIGN_EPI = false, bool SP2 = false>
__device__ __forceinline__ void gemm_phase(PG8_LAS unsigned char* lds, const Gemm g, const Sched& S, const Epi& E) {
    int tid_o = threadIdx.x; asm volatile("" : "+v"(tid_o)); const int tid = tid_o, wid = __builtin_amdgcn_readfirstlane(tid >> 6), lane = tid & 63, wr = wid >> 2, wc = wid & 3, fr = lane & 15, fq = lane >> 4;
    const int K = g.K, nt = K / BK;
    unsigned voffA[2], voffB[2];
#pragma unroll
    for (int i = 0; i < 2; ++i) { int R, C; stage_rc(tid * 16 + i * 8192, R, C); const int Rb = Epi::PERM ? ((R & ~31) + perm32(R & 31)) : R;
        voffA[i] = (unsigned)(R * K + C) * 2u; voffB[i] = (unsigned)(Rb * K + C) * 2u; }
    const size_t kstep = (size_t)(BK * 2);
    const size_t hstep = (size_t)HALF * K * 2;
    const size_t tstep = 2 * hstep;
    const unsigned ldsw = (unsigned)wid * 1024u;
    const int aoff = lds_byte(wr * 64 + fr, fq * 8), boff = lds_byte(wc * 32 + fr, fq * 8);
#define PG8_SA(b, h) (((b) * 2 + (h)) * HTB)
#define PG8_SB(b, h) ((4 + (b) * 2 + (h)) * HTB)
#define PG8_STAGE(bufoff, gbase, voff) do { _Pragma("unroll") for (int _i = 0; _i < 2; ++_i) \
        __builtin_amdgcn_global_load_lds((const unsigned*)((const char*)(gbase) + (voff)[_i]), (PG8_LAS unsigned*)(lds + (bufoff) + ldsw + _i * 8192), 16, 0, 0); } while (0)
#define PG8_LDA(dst, b, h) do { _Pragma("unroll") for (int m = 0; m < 4; ++m) _Pragma("unroll") for (int k = 0; k < 2; ++k) dst[m][k] = *(const PG8_LAS bf16x8*)(lds + PG8_SA(b, h) + aoff + m * 2048 + k * 1024); } while (0)
#define PG8_LDB(dst, b, h) do { _Pragma("unroll") for (int n = 0; n < 2; ++n) _Pragma("unroll") for (int k = 0; k < 2; ++k) dst[n][k] = *(const PG8_LAS bf16x8*)(lds + PG8_SB(b, h) + boff + n * 2048 + k * 1024); } while (0)
#define PG8_MMA(ai, bj, At, Bt) do { __builtin_amdgcn_s_setprio(1); _Pragma("unroll") for (int m = 0; m < 4; ++m) _Pragma("unroll") for (int n = 0; n < 2; ++n) _Pragma("unroll") for (int k = 0; k < 2; ++k) \
        acc[ai][bj][m][n] = __builtin_amdgcn_mfma_f32_16x16x32_bf16(Bt[n][k], At[m][k], acc[ai][bj][m][n], 0, 0, 0); __builtin_amdgcn_s_setprio(0); } while (0)
#define PG8_WAIT_V(n) asm volatile("s_waitcnt vmcnt(" #n ")" ::: "memory")
#define PG8_WAIT_L(n) asm volatile("s_waitcnt lgkmcnt(" #n ")" ::: "memory")
#define PG8_BAR __builtin_amdgcn_s_barrier()
#define PG8_SCHED __builtin_amdgcn_sched_barrier(0)
    Unit cur, nxt; int ui = 0;
    if (!S.next(0, cur)) return;
    f32x4 acc[2][2][4][2];
#pragma unroll
    for (int a = 0; a < 2; ++a)
#pragma unroll
        for (int b = 0; b < 2; ++b)
#pragma unroll
            for (int m = 0; m < 4; ++m)
#pragma unroll
                for (int n = 0; n < 2; ++n) acc[a][b][m][n] = (f32x4){0.f, 0.f, 0.f, 0.f};
    bf16x8 At[4][2], B0[2][2], B1[2][2];
    const char* cA = (const char*)g.A + (size_t)cur.pm * tstep; const char* cB = (const char*)g.Bt + (size_t)cur.pn * tstep;
    S.a_ready(cur);
    if constexpr (SP2) {
        PG8_STAGE(PG8_SB(0, 0), cB, voffB); PG8_STAGE(PG8_SB(0, 1), cB + hstep, voffB); PG8_STAGE(PG8_SA(0, 0), cA, voffA); PG8_STAGE(PG8_SA(0, 1), cA + hstep, voffA);
        if (wr == 1) PG8_BAR;
        PG8_WAIT_V(2); PG8_BAR;
        PG8_STAGE(PG8_SB(1, 0), cB + kstep, voffB); PG8_STAGE(PG8_SA(1, 0), cA + kstep, voffA); PG8_STAGE(PG8_SB(1, 1), cB + hstep + kstep, voffB);
        PG8_WAIT_V(6); PG8_BAR;
    } else {
        PG8_STAGE(PG8_SB(0, 0), cB, voffB); PG8_STAGE(PG8_SA(0, 0), cA, voffA); PG8_STAGE(PG8_SB(0, 1), cB + hstep, voffB); PG8_STAGE(PG8_SA(0, 1), cA + hstep, voffA);
        if (wr == 1) PG8_BAR;
        PG8_WAIT_V(4); PG8_BAR;
        PG8_STAGE(PG8_SB(1, 0), cB + kstep, voffB); PG8_STAGE(PG8_SA(1, 0), cA + kstep, voffA); PG8_STAGE(PG8_SB(1, 1), cB + hstep + kstep, voffB);
        PG8_WAIT_V(6); PG8_BAR;
    }
    for (;;) {
        const bool has_next = S.next(ui + 1, nxt);
        const char* nA = has_next ? (const char*)g.A + (size_t)nxt.pm * tstep : cA; const char* nB = has_next ? (const char*)g.Bt + (size_t)nxt.pn * tstep : cB;
        for (int t = 0; t < nt; t += 2) {
            const bool last = (t == nt - 2);
            const char* a1 = cA + (size_t)(t + 1) * kstep;
            const char* a2 = last ? nA : cA + (size_t)(t + 2) * kstep; const char* b2 = last ? nB : cB + (size_t)(t + 2) * kstep;
            const char* a3 = a2 + kstep; const char* b3 = b2 + kstep;
            if (last && has_next) S.a_ready(nxt);
            if constexpr (SP2) {
            PG8_LDB(B0, 0, 0); PG8_LDB(B1, 0, 1); PG8_SCHED; PG8_LDA(At, 0, 0); PG8_STAGE(PG8_SA(1, 1), a1 + hstep, voffA);
            PG8_WAIT_V(8); PG8_WAIT_L(0); PG8_BAR; PG8_MMA(0, 0, At, B0); PG8_MMA(0, 1, At, B1); PG8_BAR; PG8_SCHED;
            PG8_LDA(At, 0, 1); PG8_STAGE(PG8_SB(0, 0), b2, voffB); PG8_STAGE(PG8_SB(0, 1), b2 + hstep, voffB); PG8_STAGE(PG8_SA(0, 0), a2, voffA);
            PG8_WAIT_V(8); PG8_WAIT_L(0); PG8_BAR; PG8_MMA(1, 0, At, B0); PG8_MMA(1, 1, At, B1); PG8_BAR; PG8_SCHED;
            PG8_LDB(B0, 1, 0); PG8_LDB(B1, 1, 1); PG8_SCHED; PG8_LDA(At, 1, 0); PG8_STAGE(PG8_SA(0, 1), a2 + hstep, voffA);
            PG8_WAIT_V(8); PG8_WAIT_L(0); PG8_BAR; PG8_MMA(0, 0, At, B0); PG8_MMA(0, 1, At, B1); PG8_BAR; PG8_SCHED;
            PG8_LDA(At, 1, 1); PG8_STAGE(PG8_SB(1, 0), b3, voffB); PG8_STAGE(PG8_SB(1, 1), b3 + hstep, voffB); PG8_STAGE(PG8_SA(1, 0), a3, voffA);
            PG8_WAIT_V(8); PG8_WAIT_L(0); PG8_BAR; PG8_MMA(1, 0, At, B0); PG8_MMA(1, 1, At, B1); PG8_BAR; PG8_SCHED;
            } else {
            PG8_LDB(B0, 0, 0); PG8_SCHED; PG8_LDA(At, 0, 0); PG8_STAGE(PG8_SA(1, 1), a1 + hstep, voffA);
            PG8_WAIT_L(8); PG8_BAR; PG8_WAIT_L(0); PG8_MMA(0, 0, At, B0); PG8_BAR; PG8_SCHED;
            PG8_LDB(B1, 0, 1); PG8_STAGE(PG8_SB(0, 0), b2, voffB);
            PG8_BAR; PG8_WAIT_L(0); PG8_MMA(0, 1, At, B1); PG8_BAR;
            PG8_LDA(At, 0, 1); PG8_STAGE(PG8_SA(0, 0), a2, voffA);
            PG8_BAR; PG8_WAIT_L(0); PG8_MMA(1, 0, At, B0); PG8_BAR; PG8_SCHED;
            PG8_STAGE(PG8_SB(0, 1), b2 + hstep, voffB);
            PG8_WAIT_V(6); PG8_BAR; PG8_MMA(1, 1, At, B1); PG8_BAR;
            PG8_LDB(B0, 1, 0); PG8_SCHED; PG8_LDA(At, 1, 0); PG8_STAGE(PG8_SA(0, 1), a2 + hstep, voffA);
            PG8_WAIT_L(8); PG8_BAR; PG8_WAIT_L(0); PG8_MMA(0, 0, At, B0); PG8_BAR; PG8_SCHED;
            PG8_LDB(B1, 1, 1); PG8_STAGE(PG8_SB(1, 0), b3, voffB);
            PG8_BAR; PG8_WAIT_L(0); PG8_MMA(0, 1, At, B1); PG8_BAR;
            PG8_LDA(At, 1, 1); PG8_STAGE(PG8_SA(1, 0), a3, voffA);
            PG8_BAR; PG8_WAIT_L(0); PG8_MMA(1, 0, At, B0); PG8_BAR; PG8_SCHED;
            PG8_STAGE(PG8_SB(1, 1), b3 + hstep, voffB);
            PG8_WAIT_V(6); PG8_BAR; PG8_MMA(1, 1, At, B1); PG8_BAR;
            }
        }
        if constexpr (ALIGN_EPI) { if (wr == 0) PG8_BAR; }
        if constexpr (!Epi::AFTER_DRAIN) { E(acc, cur, wr, wc, fr, fq); S.done(cur); }
        if (!has_next) break;
#pragma unroll
        for (int a = 0; a < 2; ++a)
#pragma unroll
            for (int b = 0; b < 2; ++b)
#pragma unroll
                for (int m = 0; m < 4; ++m)
#pragma unroll
                    for (int n = 0; n < 2; ++n) acc[a][b][m][n] = (f32x4){0.f, 0.f, 0.f, 0.f};
        cur = nxt; cA = nA; cB = nB; ++ui;
        if constexpr (ALIGN_EPI) { if (wr == 1) PG8_BAR; }
    }
    PG8_WAIT_V(0);
    if constexpr (!ALIGN_EPI) { if (wr == 0) PG8_BAR; }
    PG8_BAR;
    if constexpr (Epi::AFTER_DRAIN) { E.fused(acc, cur, wr, wc, fr, fq, lds, wid, lane); S.done(cur); }
#undef PG8_SA
#undef PG8_SB
#undef PG8_STAGE
#undef PG8_LDA
#undef PG8_LDB
#undef PG8_MMA
#undef PG8_WAIT_V
#undef PG8_WAIT_L
#undef PG8_BAR
#undef PG8_SCHED
}
}

constexpr int NWAVES = 8, NTHR = 512;
constexpr int BATCH = 4, SEQ = 4096, DM = 1024, DEPTH = 4, MTOK = BATCH * SEQ;
constexpr int N_IN = 2824, NP = 2816, NPAD = 3072, DFF = 4096;
constexpr int NCH = 32;
constexpr int PC_MX = 0, PC_MZ = 384, PC_RQ = 768, PC_RK = 1152, PC_RV = 1536, PC_RG = 1920, PC_GU = 2304, PC_GV = 2560;
constexpr int CAT_R = 384, CAT_G = 768;
constexpr float EPS = 1e-6f;
constexpr int NE_M = 97 * 96;
constexpr int NE_R = 64 * 64;

constexpr size_t MiB = 1u << 20;
constexpr size_t WS_CTL = 0;
constexpr size_t WS_WIN = 1 * MiB, WS_WOUT = 7 * MiB, WS_W1 = 9 * MiB, WS_W2 = 17 * MiB;
constexpr size_t WS_ROPE = 25 * MiB;
constexpr size_t WS_GATES = 26 * MiB;
constexpr size_t WS_SCAL = 27 * MiB;
constexpr size_t WS_XP = 27 * MiB + 65536;
constexpr size_t WS_PROJP = WS_XP + 16384;
constexpr size_t WS_CATP = WS_PROJP + 49152;
constexpr size_t WS_HIDP = WS_CATP + 16384;
constexpr size_t WS_H = 28 * MiB;
constexpr size_t WS_PROJ = 60 * MiB;
constexpr size_t WS_CAT = 148 * MiB;
constexpr size_t WS_MST = 180 * MiB;
constexpr size_t WS_RST = 199 * MiB;
constexpr size_t WS_HID = 60 * MiB;
constexpr size_t WS_WBUF1 = 210 * MiB;
constexpr size_t WS_SSQ = 236 * MiB;
constexpr size_t WS_END = 237 * MiB;
static_assert(WS_MST + (size_t)512 * NE_M * 4 <= WS_RST && WS_RST + (size_t)768 * NE_R * 4 <= 211 * MiB, "ws map");
static_assert(WS_HID + (size_t)MTOK * DFF * 2 <= WS_RST, "hid overlay");

#ifndef XREP_A
#define XREP_A 0
#endif
#ifndef XREP_C
#define XREP_C 0
#endif
#ifndef XREP_E_END
#define XREP_E_END 1280
#endif
#ifndef XREP_E
#define XREP_E 0
#endif
#ifndef XREP_D
#define XREP_D 0
#endif
#ifndef XREP_B
#define XREP_B 0
#endif
#ifndef XREP_H
#define XREP_H 0
#endif
#ifndef GEMM_SP2
#define GEMM_SP2 true
#endif
#ifndef GEMM_ALIGN
#define GEMM_ALIGN true
#endif
#ifndef XREP_G
#define XREP_G 0
#endif
constexpr int LDS_BYTES = 147456;

#define LAS __attribute__((address_space(3)))
typedef unsigned short bf16;
typedef unsigned v4u __attribute__((ext_vector_type(4)));
typedef unsigned v2u __attribute__((ext_vector_type(2)));
typedef float f32x4 __attribute__((ext_vector_type(4)));
typedef short bf16x8 __attribute__((ext_vector_type(8)));
typedef LAS unsigned char* ldsp;

__device__ __forceinline__ unsigned pk2(float lo, float hi) { return pg8::cvt_pk_bf16(lo, hi); }
__device__ __forceinline__ unsigned short f2bf(float f) { return (unsigned short)(pg8::cvt_pk_bf16(f, 0.f) & 0xffffu); }
__device__ __forceinline__ float bflo(unsigned u) { return __uint_as_float(u << 16); }
__device__ __forceinline__ float bfhi(unsigned u) { return __uint_as_float(u & 0xffff0000u); }
__device__ __forceinline__ float bf2f(unsigned short h) { return __uint_as_float((unsigned)h << 16); }
__device__ __forceinline__ float fast_rcp(float x) { return __builtin_amdgcn_rcpf(x); }
__device__ __forceinline__ float silu_f(float x) { return x * fast_rcp(1.f + __expf(-x)); }
__device__ __forceinline__ float gelu_tanh(float x) { const float u = 0.7978845608f * (x + 0.044715f * x * x * x); const float r = fast_rcp(__expf(2.f * u) + 1.f); return x - x * r; }
__device__ __forceinline__ float wave_sum(float v) {
#pragma unroll
    for (int o = 1; o < 64; o <<= 1) v += __shfl_xor(v, o);
    return v;
}
#define XB_TMO      128
#define XB_XCNT(j)  (256  + 64 * (j))
#define XB_XSUB(j)  (1280 + 64 * (j))
#define XB_XGEN(j)  (2304 + 64 * (j))
#define XB_TOP      3328
#define XB_TOPGEN   3392
#define XCD_BAR_WORDS 3456
#define XB_SPIN_CAP (1u << 18)

__device__ __forceinline__ unsigned xb_ld(unsigned* p)              { return __hip_atomic_load(p, __ATOMIC_RELAXED, __HIP_MEMORY_SCOPE_AGENT); }
__device__ __forceinline__ unsigned xb_add(unsigned* p, unsigned v) { return __hip_atomic_fetch_add(p, v, __ATOMIC_RELAXED, __HIP_MEMORY_SCOPE_AGENT); }
__device__ __forceinline__ unsigned xb_xcc_id() { return (unsigned)__builtin_amdgcn_s_getreg((3 << 11) | 20) & 0xFu; }
#define XB_SPIN(cond, bar) do { unsigned _sp = 0; while (cond) { __builtin_amdgcn_s_sleep(1); \
    if ((++_sp & 255u) == 0u) { if (xb_ld(&(bar)[XB_TMO])) break; if (_sp > XB_SPIN_CAP) { atomicAdd(&(bar)[XB_TMO], 1u); break; } } } } while (0)

struct XcdBarrier {
    unsigned* bar; unsigned x;
    volatile LAS unsigned* st;
};

__device__ __forceinline__ XcdBarrier xcd_barrier_post(unsigned* bar, volatile LAS unsigned* st) {
    XcdBarrier b; b.bar = bar; b.x = xb_xcc_id(); b.st = st;
    if (threadIdx.x == 0) (void)xb_add(&bar[XB_XCNT(b.x)], 1u);
    return b;
}
__device__ __forceinline__ void xcd_barrier_complete(unsigned* bar, unsigned x, unsigned& nloc, unsigned& nx) {
    const unsigned G = gridDim.x * gridDim.y * gridDim.z;
    unsigned sum, cnt, mine, sp = 0u;
    for (;;) {
        sum = 0u; cnt = 0u; mine = 0u;
#pragma unroll
        for (unsigned j = 0; j < 16; ++j) { const unsigned c = xb_ld(&bar[XB_XCNT(j)]); sum += c; cnt += (c > 0u) ? 1u : 0u; mine = (j == x) ? c : mine; }
        if (sum == G) break;
        __builtin_amdgcn_s_sleep(1);
        if ((++sp & 255u) == 0u) { if (xb_ld(&bar[XB_TMO])) break; if (sp > XB_SPIN_CAP) { atomicAdd(&bar[XB_TMO], 1u); break; } }
    }
    nloc = mine > 0u ? mine : 1u; nx = cnt > 0u ? cnt : 1u;
}

__device__ __forceinline__ void xcd_barrier(const XcdBarrier& b) {
    asm volatile("s_waitcnt vmcnt(0)" ::: "memory");
    __syncthreads();
    if (threadIdx.x == 0) {
        unsigned* bar = b.bar;
        __builtin_amdgcn_s_waitcnt(0);
        unsigned nloc = b.st[0], nx = b.st[1];
        if (nloc == 0u) { xcd_barrier_complete(bar, b.x, nloc, nx); b.st[0] = nloc; b.st[1] = nx; }
        const unsigned old = xb_add(&bar[XB_XSUB(b.x)], 1u);
        const unsigned gen = old / nloc;
        if (old + 1u == (gen + 1u) * nloc) {
            __builtin_amdgcn_fence(__ATOMIC_RELEASE, "agent");
            asm volatile("s_waitcnt vmcnt(0)" ::: "memory");
            const unsigned og = xb_add(&bar[XB_TOP], 1u);
            const unsigned tg = og / nx;
            if (og + 1u == (tg + 1u) * nx) xb_add(&bar[XB_TOPGEN], 1u);
            else XB_SPIN(xb_ld(&bar[XB_TOPGEN]) == tg, bar);
            __builtin_amdgcn_fence(__ATOMIC_ACQUIRE, "agent");
            xb_add(&bar[XB_XGEN(b.x)], 1u);
            asm volatile("s_waitcnt vmcnt(0)" ::: "memory");
        } else {
            XB_SPIN(xb_ld(&bar[XB_XGEN(b.x)]) == gen, bar);
            __builtin_amdgcn_fence(__ATOMIC_ACQUIRE, "agent");
            asm volatile("s_waitcnt vmcnt(0)" ::: "memory");
        }
    }
    __syncthreads();
}

typedef float f32x2 __attribute__((ext_vector_type(2)));
__device__ __forceinline__ f32x2 silu2(f32x2 x) { const f32x2 t = x * (-1.4426950408889634f); f32x2 e; e.x = __builtin_amdgcn_exp2f(t.x); e.y = __builtin_amdgcn_exp2f(t.y);
    const f32x2 d = e + 1.0f; f32x2 r; r.x = __builtin_amdgcn_rcpf(d.x); r.y = __builtin_amdgcn_rcpf(d.y); return x * r; }
__device__ __forceinline__ f32x2 gelu2(f32x2 x) { const f32x2 p = (x * x) * 0.10294324f + 2.3022082f; const f32x2 w = p * x; f32x2 e; e.x = __builtin_amdgcn_exp2f(w.x); e.y = __builtin_amdgcn_exp2f(w.y);
    const f32x2 d = e + 1.0f; f32x2 r; r.x = __builtin_amdgcn_rcpf(d.x); r.y = __builtin_amdgcn_rcpf(d.y); return x - x * r; }
#define LDS_WAIT() asm volatile("s_waitcnt lgkmcnt(0)" ::: "memory")
#define MFMA16(a, b, c) __builtin_amdgcn_mfma_f32_16x16x32_bf16((a), (b), (c), 0, 0, 0)

struct Args {
    const float* in[21];
    float* out; unsigned char* ws;
};
typedef const Args __attribute__((address_space(4)))* ArgsP;
enum { I_X = 0, I_NMG, I_WIN, I_CONVW, I_CONVB, I_WQ, I_WK, I_WV, I_IB, I_FB, I_MNG, I_SKIP, I_RNG, I_GNG, I_GWS, I_GBS, I_WOUT, I_NFG, I_WFF1, I_WFF2, I_FNG };

__device__ __forceinline__ void transpose_item(const float* W, int ldw, int col_src0, int nvalid, const float* gk, int K, bf16* WT, int n0, int k0, LAS float* scr, int lane) {
    float vv[32];
    const bool val = (lane & 31) < nvalid;
    const float* wp = W + (size_t)(k0 + (lane >> 5)) * ldw + col_src0 + (lane & 31);
#pragma unroll
    for (int i = 0; i < 32; ++i) vv[i] = val ? wp[(size_t)(2 * i) * ldw] : 0.f;
    if (gk) {
        const float* gp = gk + k0 + (lane >> 5);
#pragma unroll
        for (int i = 0; i < 32; ++i) vv[i] *= gp[2 * i];
    }
#pragma unroll
    for (int i = 0; i < 32; ++i) scr[(2 * i + (lane >> 5)) * 33 + (lane & 31)] = vv[i];
    LDS_WAIT(); asm volatile("" ::: "memory");
    const int c = lane & 7;
#pragma unroll
    for (int j = 0; j < 4; ++j) { const int n = (lane >> 3) + 8 * j; const LAS float* s = scr + (8 * c) * 33 + n;
        v4u o; o.x = pk2(s[0 * 33], s[1 * 33]); o.y = pk2(s[2 * 33], s[3 * 33]); o.z = pk2(s[4 * 33], s[5 * 33]); o.w = pk2(s[6 * 33], s[7 * 33]);
        *(v4u*)(WT + (size_t)(n0 + n) * K + k0 + 8 * c) = o; }
    LDS_WAIT(); asm volatile("" ::: "memory");
}

__device__ __forceinline__ void convert_weights(ArgsP a, int L, size_t wb, ldsp lds, int lane, int wave) {
    LAS float* scr = (LAS float*)(lds + 32768 + wave * 8448);
    const int gw = blockIdx.x * NWAVES + wave, NGW = gridDim.x * NWAVES;
    constexpr int I_IN = (DM / 64) * (NPAD / 32), I_O = (DM / 64) * (DM / 32), I_1 = (DM / 64) * (DFF / 32), I_2 = (DFF / 64) * (DM / 32);
    constexpr int NITEMS = I_IN + I_O + I_1 + I_2;
    unsigned char* ws = a->ws + wb;
    for (int it = gw; it < NITEMS; it += NGW) {
        int r = it;
        if (r < I_IN) { const int nblk = NPAD / 32, kb = r / nblk, nb = r % nblk, n0 = nb * 32;
            const int src = nb < 88 ? n0 + (n0 >= 768 ? 8 : 0) : 768, nv = nb < 88 ? 32 : (nb == 88 ? 8 : 0);
            transpose_item(a->in[I_WIN] + (size_t)L * DM * N_IN, N_IN, src, nv, a->in[I_NMG] + (size_t)L * DM, DM, (bf16*)(ws + WS_WIN), n0, kb * 64, scr, lane); continue; } r -= I_IN;
        if (r < I_O) { const int nblk = DM / 32, kb = r / nblk, nb = r % nblk; transpose_item(a->in[I_WOUT] + (size_t)L * DM * DM, DM, nb * 32, 32, nullptr, DM, (bf16*)(ws + WS_WOUT), nb * 32, kb * 64, scr, lane); continue; } r -= I_O;
        if (r < I_1) { const int nblk = DFF / 32, kb = r / nblk, nb = r % nblk; transpose_item(a->in[I_WFF1] + (size_t)L * DM * DFF, DFF, nb * 32, 32, a->in[I_NFG] + (size_t)L * DM, DM, (bf16*)(ws + WS_W1), nb * 32, kb * 64, scr, lane); continue; } r -= I_1;
        { const int nblk = DM / 32, kb = r / nblk, nb = r % nblk; transpose_item(a->in[I_WFF2] + (size_t)L * DFF * DM, DM, nb * 32, 32, nullptr, DFF, (bf16*)(ws + WS_W2), nb * 32, kb * 64, scr, lane); }
    }
}

template <bool GATES>
__device__ __forceinline__ void norm_rows(const float* x, const float* g, bf16* h, const LAS float* wgT, const float* ib, const float* fb, float* gates, int lane, int wave, const float* xP, float* wb) {
    const int gw = blockIdx.x * NWAVES + wave, NGW = gridDim.x * NWAVES;
    f32x4 gv[4];
#pragma unroll
    for (int j = 0; j < 4; ++j) gv[j] = ((const f32x4*)g)[lane + 64 * j];
    for (int m = gw; m < MTOK; m += NGW) {
        const bool p0 = xP != nullptr && (m & (SEQ - 1)) == 0;
        const f32x4* xr = (const f32x4*)(p0 ? xP + (size_t)(m >> 12) * DM : x + (size_t)m * DM) + lane;
        f32x4 v[4]; float ss = 0.f;
#pragma unroll
        for (int j = 0; j < 4; ++j) { v[j] = xr[64 * j]; ss += (v[j].x * v[j].x + v[j].y * v[j].y) + (v[j].z * v[j].z + v[j].w * v[j].w); }
        if (p0 && wb != nullptr) {
#pragma unroll
            for (int j = 0; j < 4; ++j) ((f32x4*)(wb + (size_t)m * DM) + lane)[64 * j] = v[j]; }
        const float rstd = rsqrtf(wave_sum(ss) * (1.f / DM) + EPS);
        unsigned long long* o8 = (unsigned long long*)(h + (size_t)m * DM) + lane;
#pragma unroll
        for (int j = 0; j < 4; ++j) { v[j] = v[j] * rstd * gv[j]; o8[64 * j] = (unsigned long long)pk2(v[j].x, v[j].y) | ((unsigned long long)pk2(v[j].z, v[j].w) << 32); }
        if (GATES) {
            float mine = 0.f;
#pragma unroll
            for (int c = 0; c < 8; ++c) {
                float p = 0.f;
#pragma unroll
                for (int j = 0; j < 4; ++j) { const f32x4 w = *(const LAS f32x4*)(wgT + c * 1024 + 4 * lane + 256 * j); p += (v[j].x * w.x + v[j].y * w.y) + (v[j].z * w.z + v[j].w * w.w); }
                p = wave_sum(p);
                if (lane == c) mine = p;
            }
            if (lane < 8) gates[(size_t)m * 8 + lane] = mine + (lane < 4 ? ib[lane] : fb[lane - 4]);
        }
    }
}

__device__ __forceinline__ float log_sigmoid_f(float f) { return fminf(f, 0.f) - __logf(1.f + __expf(-fabsf(f))); }
__device__ __forceinline__ void gates_cumsum(float f0, float f1, float& b0, float& b1, int lane) {
    const float l0 = log_sigmoid_f(f0), l1 = log_sigmoid_f(f1);
    float p = l0 + l1;
#pragma unroll
    for (int o = 1; o < 64; o <<= 1) { const float u = __shfl_up(p, o); if (lane >= o) p += u; }
    b1 = p; b0 = p - l1;
}
__device__ __forceinline__ void gates_prefmax(float g0, float g1, float& m0, float& m1, int lane) {
    float q = fmaxf(g0, g1);
#pragma unroll
    for (int o = 1; o < 64; o <<= 1) { const float u = __shfl_up(q, o); if (lane >= o) q = fmaxf(q, u); }
    const float ex = __shfl_up(q, 1);
    m1 = q; m0 = lane == 0 ? g0 : fmaxf(ex, g0);
}

struct MStage { f32x4 cw[4]; f32x4 cb; f32x4 wq[4], wk[4], wv[4]; v2u xr[11]; };
template <bool FULL>
__device__ __forceinline__ void mlstm_stage_load(ArgsP a, int L, int h, int t0, int s0, int tid, MStage& R) {
    if (tid < 384) {
        const bf16* proj = (const bf16*)(a->ws + WS_PROJ);
        const int blk = tid % 24, rg = tid / 24, l0 = rg * 8;
        const int ch0 = h * 96 + blk * 4, nb = h * 24 + blk;
#pragma unroll
        for (int r = 0; r < 11; ++r) { const int l = l0 - 3 + r;
            if (s0 + l >= 0) R.xr[r] = *(const v2u*)(proj + (size_t)(t0 + l) * NP + PC_MX + ch0); else R.xr[r] = (v2u){0u, 0u}; }
#pragma unroll
        for (int j = 0; j < 4; ++j) R.cw[j] = *(const f32x4*)(a->in[I_CONVW] + (size_t)L * 4 * 384 + j * 384 + ch0);
        R.cb = *(const f32x4*)(a->in[I_CONVB] + (size_t)L * 384 + ch0);
#pragma unroll
        for (int i = 0; i < 4; ++i) {
            R.wk[i] = *(const f32x4*)(a->in[I_WK] + ((size_t)L * 96 + nb) * 16 + i * 4);
            R.wv[i] = *(const f32x4*)(a->in[I_WV] + ((size_t)L * 96 + nb) * 16 + i * 4);
            if (FULL) R.wq[i] = *(const f32x4*)(a->in[I_WQ] + ((size_t)L * 96 + nb) * 16 + i * 4);
        }
    }
}
template <bool FULL>
__device__ __forceinline__ void mlstm_stage_compute(const MStage& R, ldsp XC, ldsp Q, ldsp K, ldsp VT, const LAS float* eend, int tid) {
    if (tid < 384) {
        const int blk = tid % 24, rg = tid / 24, l0 = rg * 8;
        f32x4 xm[11];
#pragma unroll
        for (int r = 0; r < 11; ++r) xm[r] = (f32x4){bflo(R.xr[r].x), bfhi(R.xr[r].x), bflo(R.xr[r].y), bfhi(R.xr[r].y)};
        const float kscale = 0.10206207261596575f;
        unsigned vpk[4][4], kpk[4][4];
        float vprev[4], kprev[4];
#pragma unroll
        for (int li = 0; li < 8; ++li) {
            f32x4 xc = R.cb;
#pragma unroll
            for (int j = 0; j < 4; ++j) xc = xc + R.cw[j] * xm[li + j];
            { const f32x2 s01 = silu2((f32x2){xc.x, xc.y}), s23 = silu2((f32x2){xc.z, xc.w}); xc = (f32x4){s01.x, s01.y, s23.x, s23.y}; }
            const f32x4 xr = xm[li + 3];
            f32x4 kk = (xc.x * R.wk[0] + xc.y * R.wk[1]) + (xc.z * R.wk[2] + xc.w * R.wk[3]);
            const f32x4 vv = (xr.x * R.wv[0] + xr.y * R.wv[1]) + (xr.z * R.wv[2] + xr.w * R.wv[3]);
            const int l = l0 + li;
            if (FULL) {
                const f32x4 qq = (xc.x * R.wq[0] + xc.y * R.wq[1]) + (xc.z * R.wq[2] + xc.w * R.wq[3]);
                kk = kk * kscale;
                *(LAS v2u*)(XC + l * 192 + blk * 8) = (v2u){pk2(xc.x, xc.y), pk2(xc.z, xc.w)};
                *(LAS v2u*)(Q + l * 208 + blk * 8) = (v2u){pk2(qq.x, qq.y), pk2(qq.z, qq.w)};
                *(LAS v2u*)(K + l * 208 + blk * 8) = (v2u){pk2(kk.x, kk.y), pk2(kk.z, kk.w)};
            } else {
                kk = kk * (kscale * eend[l]);
            }
            if (li & 1) {
#pragma unroll
                for (int jj = 0; jj < 4; ++jj) { vpk[jj][li >> 1] = pk2(vprev[jj], vv[jj]); if (!FULL) kpk[jj][li >> 1] = pk2(kprev[jj], kk[jj]); }
            } else {
#pragma unroll
                for (int jj = 0; jj < 4; ++jj) { vprev[jj] = vv[jj]; kprev[jj] = kk[jj]; }
            }
        }
#pragma unroll
        for (int jj = 0; jj < 4; ++jj) {
            *(LAS v4u*)(VT + (blk * 4 + jj) * 272 + l0 * 2) = (v4u){vpk[jj][0], vpk[jj][1], vpk[jj][2], vpk[jj][3]};
            if (!FULL) *(LAS v4u*)(K + (blk * 4 + jj) * 272 + l0 * 2) = (v4u){kpk[jj][0], kpk[jj][1], kpk[jj][2], kpk[jj][3]};
        }
    }
}

__device__ __forceinline__ void fill_vt_tail(ldsp VT, int tid) {
    if (tid < 384) return;
    const int i = tid - 384;
#pragma unroll
    for (int r = 0; r < 2; ++r) { const int idx = i + 128 * r;
        const int row = idx >> 4, c16 = idx & 15; unsigned w = row == 0 ? 0x3f803f80u : 0u; asm volatile("" : "+v"(w));
        *(LAS v4u*)(VT + (96 + row) * 272 + c16 * 16) = (v4u){w, w, w, w}; }
}

__device__ __forceinline__ void phaseC_mlstm(ArgsP a, int L, int item, ldsp lds, int tid, int lane, int wave) {
    const int bh = item >> 5, c = item & 31, b = bh >> 2, h = bh & 3;
    const int t0 = b * SEQ + c * 128, s0 = c * 128;
    ldsp EKT = lds, VT = lds + 26112;
    LAS float* eend = (LAS float*)(lds + 56576);
    const float* gates = (const float*)(a->ws + WS_GATES);
    float* scal = (float*)(a->ws + WS_SCAL);
    float i0 = 0.f, i1 = 0.f, f0 = 0.f, f1 = 0.f;
    if (wave == 7) { const float* gp = gates + (size_t)(t0 + 2 * lane) * 8; i0 = gp[h]; f0 = gp[4 + h]; i1 = gp[8 + h]; f1 = gp[12 + h]; }
    MStage R; mlstm_stage_load<false>(a, L, h, t0, s0, tid, R);
    if (wave == 7) {
        float b0, b1; gates_cumsum(f0, f1, b0, b1, lane);
        const float b_end = __shfl(b1, 63);
        const float w0 = b_end - b0 + i0, w1 = b_end - b1 + i1;
        float mx = fmaxf(w0, w1);
#pragma unroll
        for (int o = 1; o < 64; o <<= 1) mx = fmaxf(mx, __shfl_xor(mx, o));
        eend[2 * lane] = __expf(w0 - mx); eend[2 * lane + 1] = __expf(w1 - mx);
        if (lane == 0) { scal[item] = b_end; scal[512 + item] = mx; }
    }
    fill_vt_tail(VT, tid);
    __syncthreads();
    mlstm_stage_compute<false>(R, lds, lds, EKT, VT, eend, tid);
    __syncthreads();
    float* st = (float*)(a->ws + WS_MST) + (size_t)item * NE_M;
    const int fr = lane & 15, fq = lane >> 4;
    for (int tile = wave; tile < 42; tile += 8) {
        const int et = tile / 6, dt = tile % 6;
        f32x4 acc = {0.f, 0.f, 0.f, 0.f};
#pragma unroll
        for (int ks = 0; ks < 4; ++ks) {
            const bf16x8 av = *(const LAS bf16x8*)(VT + (et * 16 + fr) * 272 + ks * 64 + fq * 16);
            const bf16x8 bv = *(const LAS bf16x8*)(EKT + (dt * 16 + fr) * 272 + ks * 64 + fq * 16);
            acc = MFMA16(av, bv, acc);
        }
#pragma unroll
        for (int j = 0; j < 4; ++j) { const int e = et * 16 + fq * 4 + j; if (e < 97) st[e * 96 + dt * 16 + fr] = acc[j]; }
    }
    __syncthreads();
}

__device__ __forceinline__ float ret_log_gamma(int h) { return __logf(1.f - exp2f(-5.f - (float)h)); }

__device__ __forceinline__ void rotary16(const bf16* rowp, const float* cs, const float* sn, int j0, float scale, v4u& o1, v4u& o2) {
    const v4u u1 = *(const v4u*)(rowp + j0), u2 = *(const v4u*)(rowp + 32 + j0);
    const f32x4 c0 = *(const f32x4*)(cs + j0), c1 = *(const f32x4*)(cs + j0 + 4), s0 = *(const f32x4*)(sn + j0), s1 = *(const f32x4*)(sn + j0 + 4);
    float x1[8] = {bflo(u1.x), bfhi(u1.x), bflo(u1.y), bfhi(u1.y), bflo(u1.z), bfhi(u1.z), bflo(u1.w), bfhi(u1.w)};
    float x2[8] = {bflo(u2.x), bfhi(u2.x), bflo(u2.y), bfhi(u2.y), bflo(u2.z), bfhi(u2.z), bflo(u2.w), bfhi(u2.w)};
    float cc[8] = {c0.x, c0.y, c0.z, c0.w, c1.x, c1.y, c1.z, c1.w}, ss[8] = {s0.x, s0.y, s0.z, s0.w, s1.x, s1.y, s1.z, s1.w};
    float y1[8], y2[8];
#pragma unroll
    for (int i = 0; i < 8; ++i) { y1[i] = (x1[i] * cc[i] - x2[i] * ss[i]) * scale; y2[i] = (x2[i] * cc[i] + x1[i] * ss[i]) * scale; }
    o1 = (v4u){pk2(y1[0], y1[1]), pk2(y1[2], y1[3]), pk2(y1[4], y1[5]), pk2(y1[6], y1[7])};
    o2 = (v4u){pk2(y2[0], y2[1]), pk2(y2[2], y2[3]), pk2(y2[4], y2[5]), pk2(y2[6], y2[7])};
}

__device__ __forceinline__ void store_T8(ldsp dst, int e0, int stride, int l, v4u u) {
    const unsigned w[4] = {u.x, u.y, u.z, u.w};
#pragma unroll
    for (int i = 0; i < 4; ++i) {
        *(LAS unsigned short*)(dst + (e0 + 2 * i) * stride + l * 2) = (unsigned short)(w[i] & 0xffffu);
        *(LAS unsigned short*)(dst + (e0 + 2 * i + 1) * stride + l * 2) = (unsigned short)(w[i] >> 16);
    }
}

__device__ __forceinline__ void phaseC_ret(ArgsP a, int L, int item, ldsp lds, int tid, int lane, int wave) {
    const int bh = item >> 5, c = item & 31, b = bh / 6, h = bh % 6;
    const int t0 = b * SEQ + c * 128, s0 = c * 128;
    ldsp ZKT = lds, VT = lds + 17408;
    const bf16* proj = (const bf16*)(a->ws + WS_PROJ);
    const float* rope = (const float*)(a->ws + WS_ROPE);
    const float lg = ret_log_gamma(h);
    {
        const int l = tid >> 2, jc = tid & 3, j0 = jc * 8;
        const float zeta = __expf((127.f - (float)l) * lg);
        v4u o1, o2;
        rotary16(proj + (size_t)(t0 + l) * NP + PC_RK + h * 64, rope + (size_t)(s0 + l) * 32, rope + 4096 * 32 + (size_t)(s0 + l) * 32, j0, 0.125f * zeta, o1, o2);
        store_T8(ZKT, j0, 272, l, o1); store_T8(ZKT, 32 + j0, 272, l, o2);
        const bf16* vp = proj + (size_t)(t0 + l) * NP + PC_RV + h * 64 + jc * 16;
        const v4u v0 = *(const v4u*)vp, v1 = *(const v4u*)(vp + 8);
        store_T8(VT, jc * 16, 272, l, v0); store_T8(VT, jc * 16 + 8, 272, l, v1);
    }
    __syncthreads();
    float* st = (float*)(a->ws + WS_RST) + (size_t)item * NE_R;
    const int fr = lane & 15, fq = lane >> 4;
#pragma unroll
    for (int tt = 0; tt < 2; ++tt) {
        const int tile = wave * 2 + tt, et = tile >> 2, dt = tile & 3;
        f32x4 acc = {0.f, 0.f, 0.f, 0.f};
#pragma unroll
        for (int ks = 0; ks < 4; ++ks) {
            const bf16x8 av = *(const LAS bf16x8*)(VT + (et * 16 + fr) * 272 + ks * 64 + fq * 16);
            const bf16x8 bv = *(const LAS bf16x8*)(ZKT + (dt * 16 + fr) * 272 + ks * 64 + fq * 16);
            acc = MFMA16(av, bv, acc);
        }
#pragma unroll
        for (int j = 0; j < 4; ++j) st[(et * 16 + fq * 4 + j) * 64 + dt * 16 + fr] = acc[j];
    }
    __syncthreads();
}

__device__ __forceinline__ void phaseC_gmlp(ArgsP a, int L, int item, ldsp lds, int tid, int lane, int wave) {
    const int gp = item & 1, bc = item >> 1, b = bc >> 5, c = bc & 31;
    const int t0 = b * SEQ + c * 128;
    ldsp W = lds, GVT = lds + 34816;
    const bf16* proj = (const bf16*)(a->ws + WS_PROJ);
    bf16* cat = (bf16*)(a->ws + WS_CAT);
    const int l = tid >> 2, part = tid & 3;
    const bf16* vp = proj + (size_t)(t0 + l) * NP + PC_GV;
    float rstd;
    {
        float ss = 0.f;
#pragma unroll
        for (int i = 0; i < 8; ++i) { const v4u u = *(const v4u*)(vp + part * 64 + i * 8); const unsigned w[4] = {u.x, u.y, u.z, u.w};
#pragma unroll
            for (int q = 0; q < 4; ++q) { const f32x2 g = gelu2((f32x2){bflo(w[q]), bfhi(w[q])}); ss += g.x * g.x + g.y * g.y; } }
        ss += __shfl_xor(ss, 1); ss += __shfl_xor(ss, 2);
        rstd = rsqrtf(ss * (1.f / 256.f) + EPS);
    }
#pragma unroll
    for (int gi = 0; gi < 2; ++gi) {
        const int g = 2 * gp + gi;
        {
            const float* gn = a->in[I_GNG] + (size_t)L * 256 + g * 64 + part * 16;
#pragma unroll
            for (int i = 0; i < 2; ++i) { const v4u u = *(const v4u*)(vp + g * 64 + part * 16 + i * 8); const unsigned w[4] = {u.x, u.y, u.z, u.w}; unsigned o[4];
#pragma unroll
                for (int q = 0; q < 4; ++q) { const f32x2 gg = gelu2((f32x2){bflo(w[q]), bfhi(w[q])}) * rstd; o[q] = pk2(gg.x * gn[i * 8 + 2 * q], gg.y * gn[i * 8 + 2 * q + 1]); }
                store_T8(GVT, part * 16 + i * 8, 272, l, (v4u){o[0], o[1], o[2], o[3]}); }
        }
        {
            const float* wsrc = a->in[I_GWS] + ((size_t)L * 4 + g) * 128 * 128;
#pragma unroll
            for (int i = 0; i < 8; ++i) { const int idx4 = tid + 512 * i, t = idx4 >> 5, s4 = (idx4 & 31) * 4;
                f32x4 w = *(const f32x4*)(wsrc + (size_t)t * 128 + s4);
                if (s4 + 0 > t) w.x = 0.f; if (s4 + 1 > t) w.y = 0.f; if (s4 + 2 > t) w.z = 0.f; if (s4 + 3 > t) w.w = 0.f;
                *(LAS v2u*)(W + t * 272 + s4 * 2) = (v2u){pk2(w.x, w.y), pk2(w.z, w.w)}; }
        }
        __syncthreads();
        const int fr = lane & 15, fq = lane >> 4;
        const float* bs = a->in[I_GBS] + ((size_t)L * 4 + g) * 128;
        float bbv[4]; unsigned short uv[4][4];
#pragma unroll
        for (int j = 0; j < 4; ++j) { bbv[j] = bs[wave * 16 + fq * 4 + j];
#pragma unroll
            for (int n = 0; n < 4; ++n) uv[j][n] = proj[(size_t)(t0 + wave * 16 + fq * 4 + j) * NP + PC_GU + g * 64 + n * 16 + fr]; }
        f32x4 acc[4];
#pragma unroll
        for (int n = 0; n < 4; ++n) acc[n] = (f32x4){0.f, 0.f, 0.f, 0.f};
#pragma unroll
        for (int ks = 0; ks < 4; ++ks) {
            if (ks * 32 <= wave * 16 + 15) {
                const bf16x8 av = *(const LAS bf16x8*)(W + (wave * 16 + fr) * 272 + ks * 64 + fq * 16);
#pragma unroll
                for (int n = 0; n < 4; ++n) { const bf16x8 bv = *(const LAS bf16x8*)(GVT + (n * 16 + fr) * 272 + ks * 64 + fq * 16); acc[n] = MFMA16(av, bv, acc[n]); }
            }
        }
#pragma unroll
        for (int j = 0; j < 4; ++j) { const int t = wave * 16 + fq * 4 + j; const float bb = bbv[j];
#pragma unroll
            for (int n = 0; n < 4; n += 2) { const int e = n * 16 + fr;
                const f32x2 gu = gelu2((f32x2){bf2f(uv[j][n]), bf2f(uv[j][n + 1])});
                cat[(size_t)(t0 + t) * DM + CAT_G + g * 64 + e] = f2bf(gu.x * (acc[n][j] + bb));
                cat[(size_t)(t0 + t) * DM + CAT_G + g * 64 + e + 16] = f2bf(gu.y * (acc[n + 1][j] + bb)); } }
        __syncthreads();
    }
}

__device__ __forceinline__ void phaseD(ArgsP a, ldsp lds, int tid) {
    LAS float* so = (LAS float*)lds; LAS float* sn = so + 512;
    float* scal = (float*)(a->ws + WS_SCAL);
    const int gt = blockIdx.x * NTHR + tid, NT = gridDim.x * NTHR;
    constexpr int TOT_M = 16 * NE_M, TOT_R = 24 * NE_R;
    float v0[32]; float* p0 = nullptr; int bh0 = 0; float dec0 = 0.f; const bool m0 = gt < TOT_M;
    if (m0) { bh0 = gt / NE_M; p0 = (float*)(a->ws + WS_MST) + (size_t)bh0 * NCH * NE_M + (gt - bh0 * NE_M);
#pragma unroll
        for (int c = 0; c < 32; ++c) v0[c] = p0[(size_t)c * NE_M];
    } else if (gt < TOT_M + TOT_R) { const int j = gt - TOT_M; bh0 = j >> 12; dec0 = __expf(128.f * ret_log_gamma(bh0 % 6)); p0 = (float*)(a->ws + WS_RST) + (size_t)bh0 * NCH * NE_R + (j & 4095);
#pragma unroll
        for (int c = 0; c < 32; ++c) v0[c] = p0[(size_t)c * NE_R];
    }
    if (tid < 16) {
        float be[32], ac[32];
#pragma unroll
        for (int c = 0; c < 32; ++c) { be[c] = scal[tid * 32 + c]; ac[c] = scal[512 + tid * 32 + c]; }
        float m = 0.f;
#pragma unroll
        for (int c = 0; c < 32; ++c) { const float mn = fmaxf(be[c] + m, ac[c]); so[tid * 32 + c] = __expf(be[c] + m - mn); sn[tid * 32 + c] = __expf(ac[c] - mn);
            if (blockIdx.x == 0) scal[1024 + tid * 32 + c] = m; m = mn; }
    }
    __syncthreads();
    if (p0 != nullptr) {
        float st = 0.f;
        if (m0) {
#pragma unroll
            for (int c = 0; c < 32; ++c) { p0[(size_t)c * NE_M] = st; st = so[bh0 * 32 + c] * st + sn[bh0 * 32 + c] * v0[c]; }
        } else {
#pragma unroll
            for (int c = 0; c < 32; ++c) { p0[(size_t)c * NE_R] = st; st = dec0 * st + v0[c]; }
        }
    }
    for (int idx = gt + NT; idx < TOT_M + TOT_R; idx += NT) {
        float v[32];
        if (idx < TOT_M) {
            const int bh = idx / NE_M, e = idx - bh * NE_M;
            float* p = (float*)(a->ws + WS_MST) + (size_t)bh * NCH * NE_M + e;
#pragma unroll
            for (int c = 0; c < 32; ++c) v[c] = p[(size_t)c * NE_M];
            float st = 0.f;
#pragma unroll
            for (int c = 0; c < 32; ++c) { p[(size_t)c * NE_M] = st; st = so[bh * 32 + c] * st + sn[bh * 32 + c] * v[c]; }
        } else {
            const int j = idx - TOT_M, bh = j >> 12, e = j & 4095, h = bh % 6;
            const float dec = __expf(128.f * ret_log_gamma(h));
            float* p = (float*)(a->ws + WS_RST) + (size_t)bh * NCH * NE_R + e;
#pragma unroll
            for (int c = 0; c < 32; ++c) v[c] = p[(size_t)c * NE_R];
            float st = 0.f;
#pragma unroll
            for (int c = 0; c < 32; ++c) { p[(size_t)c * NE_R] = st; st = dec * st + v[c]; }
        }
    }
    __syncthreads();
}

__device__ __forceinline__ void phaseE_mlstm(ArgsP a, int L, int item, ldsp lds, int tid, int lane, int wave) {
    const int bh = item >> 5, c = item & 31, b = bh >> 2, h = bh & 3;
    const int t0 = b * SEQ + c * 128, s0 = c * 128;
    ldsp XC = lds, Q = lds + 24576, K = lds + 51200, VT = lds + 77824, SC = lds + 108288, CT = SC;
    LAS float* fl = (LAS float*)(lds + 143104);
    LAS float* bcum = fl, *gsv = fl + 256, *mmv = fl + 384;
    const float* gates = (const float*)(a->ws + WS_GATES);
    const float* scal = (const float*)(a->ws + WS_SCAL);
    const bf16* proj = (const bf16*)(a->ws + WS_PROJ);
    bf16* cat = (bf16*)(a->ws + WS_CAT);
    const float m_prev = scal[1024 + item];
    float i0 = 0.f, i1 = 0.f, f0 = 0.f, f1 = 0.f;
    if (wave == 7) { const float* gp = gates + (size_t)(t0 + 2 * lane) * 8; i0 = gp[h]; f0 = gp[4 + h]; i1 = gp[8 + h]; f1 = gp[12 + h]; }
    MStage R; mlstm_stage_load<true>(a, L, h, t0, s0, tid, R);
    f32x4 ctv[6];
    {   const float* st = (const float*)(a->ws + WS_MST) + (size_t)item * NE_M;
#pragma unroll
        for (int i = 0; i < 6; ++i) { const int idx4 = tid + 512 * i, e = idx4 / 24, d4 = (idx4 % 24) * 4;
            ctv[i] = (f32x4){0.f, 0.f, 0.f, 0.f}; if (e < 97) ctv[i] = *(const f32x4*)(st + e * 96 + d4); } }
    if (wave == 7) {
        float b0, b1; gates_cumsum(f0, f1, b0, b1, lane);
        const float g0 = i0 - b0, g1 = i1 - b1; float p0, p1; gates_prefmax(g0, g1, p0, p1, lane);
        bcum[2 * lane] = b0; bcum[2 * lane + 1] = b1; gsv[2 * lane] = g0; gsv[2 * lane + 1] = g1;
        mmv[2 * lane] = fmaxf(m_prev, p0); mmv[2 * lane + 1] = fmaxf(m_prev, p1);
    }
    mlstm_stage_compute<true>(R, XC, Q, K, VT, nullptr, tid);
    fill_vt_tail(VT, tid);
#pragma unroll
    for (int i = 0; i < 6; ++i) { const int idx4 = tid + 512 * i, e = idx4 / 24, d4 = (idx4 % 24) * 4;
        if (idx4 < 112 * 24) *(LAS v2u*)(CT + e * 208 + d4 * 2) = (v2u){pk2(ctv[i].x, ctv[i].y), pk2(ctv[i].z, ctv[i].w)}; }
    __syncthreads();
    const int fr = lane & 15, fq = lane >> 4;
    const float* mng = a->in[I_MNG] + (size_t)L * 384 + h * 96;
    const float* skp = a->in[I_SKIP] + (size_t)L * 384 + h * 96;
    float gcol[6], scol[6];
#pragma unroll
    for (int n = 0; n < 6; ++n) { gcol[n] = mng[n * 16 + fr]; scol[n] = skp[n * 16 + fr]; }
    v4u zc[3];
#pragma unroll
    for (int i = 0; i < 3; ++i) { const int q = lane + 64 * i, r = q / 12, cc = q % 12; zc[i] = *(const v4u*)(proj + (size_t)(t0 + wave * 16 + r) * NP + PC_MZ + h * 96 + cc * 8); }
    bf16x8 aq[3];
#pragma unroll
    for (int ks = 0; ks < 3; ++ks) aq[ks] = *(const LAS bf16x8*)(Q + (wave * 16 + fr) * 208 + ks * 64 + fq * 16);
    f32x4 acc2[7];
#pragma unroll
    for (int n = 0; n < 7; ++n) { acc2[n] = (f32x4){0.f, 0.f, 0.f, 0.f};
#pragma unroll
        for (int ks = 0; ks < 3; ++ks) { const bf16x8 bv = *(const LAS bf16x8*)(CT + (n * 16 + fr) * 208 + ks * 64 + fq * 16); acc2[n] = MFMA16(aq[ks], bv, acc2[n]); } }
    f32x4 sacc[8];
#pragma unroll
    for (int st = 0; st < 8; ++st) { sacc[st] = (f32x4){0.f, 0.f, 0.f, 0.f};
        if (st <= wave) {
#pragma unroll
            for (int ks = 0; ks < 3; ++ks) { const bf16x8 bv = *(const LAS bf16x8*)(K + (st * 16 + fr) * 208 + ks * 64 + fq * 16); sacc[st] = MFMA16(aq[ks], bv, sacc[st]); } } }
    float mmr[4];
#pragma unroll
    for (int j = 0; j < 4; ++j) mmr[j] = mmv[wave * 16 + fq * 4 + j];
    __syncthreads();
#pragma unroll
    for (int st = 0; st < 8; ++st) {
        if (st <= (wave | 1)) {
            const int s = st * 16 + fr; const float gsl = gsv[s];
#pragma unroll
            for (int j = 0; j < 4; ++j) { const int l = wave * 16 + fq * 4 + j;
                const float wgt = (s <= l) ? __expf(gsl - mmr[j]) : 0.f;
                *(LAS unsigned short*)(SC + l * 272 + s * 2) = f2bf(sacc[st][j] * wgt); }
        }
    }
    asm volatile("" ::: "memory");
    f32x4 acc1[7];
#pragma unroll
    for (int n = 0; n < 7; ++n) acc1[n] = (f32x4){0.f, 0.f, 0.f, 0.f};
#pragma unroll
    for (int ks = 0; ks < 4; ++ks) {
        if (ks * 2 <= wave) {
            const bf16x8 av = *(const LAS bf16x8*)(SC + (wave * 16 + fr) * 272 + ks * 64 + fq * 16);
#pragma unroll
            for (int n = 0; n < 7; ++n) { const bf16x8 bv = *(const LAS bf16x8*)(VT + (n * 16 + fr) * 272 + ks * 64 + fq * 16); acc1[n] = MFMA16(av, bv, acc1[n]); }
        }
    }
#pragma unroll
    for (int i = 0; i < 3; ++i) { const int q = lane + 64 * i, r = q / 12, cc = q % 12; *(LAS v4u*)(Q + (wave * 16 + r) * 208 + cc * 16) = zc[i]; }
#pragma unroll
    for (int j = 0; j < 4; ++j) {
        const int l = wave * 16 + fq * 4 + j;
        const float sint = __expf(m_prev - mmr[j]);
        float den = acc1[6][j] + sint * acc2[6][j];
        den = __shfl(den, lane & 48);
        const float flo = __expf(-(bcum[l] + mmr[j]));
        const float inv = fast_rcp(fmaxf(fabsf(den), flo));
        float hv[6]; float ss = 0.f;
#pragma unroll
        for (int n = 0; n < 6; ++n) { hv[n] = (acc1[n][j] + sint * acc2[n][j]) * inv; ss += hv[n] * hv[n]; }
        ss += __shfl_xor(ss, 1); ss += __shfl_xor(ss, 2); ss += __shfl_xor(ss, 4); ss += __shfl_xor(ss, 8);
        const float rstd = rsqrtf(ss * (1.f / 96.f) + EPS);
#pragma unroll
        for (int n = 0; n < 6; n += 2) { const int e = n * 16 + fr;
            const float xc0 = bf2f(*(const LAS unsigned short*)(XC + l * 192 + e * 2)), xc1 = bf2f(*(const LAS unsigned short*)(XC + l * 192 + (e + 16) * 2));
            const f32x2 sz = silu2((f32x2){bf2f(*(const LAS unsigned short*)(Q + l * 208 + e * 2)), bf2f(*(const LAS unsigned short*)(Q + l * 208 + (e + 16) * 2))});
            *(LAS unsigned short*)(SC + l * 272 + e * 2) = f2bf((hv[n] * rstd * gcol[n] + scol[n] * xc0) * sz.x);
            *(LAS unsigned short*)(SC + l * 272 + (e + 16) * 2) = f2bf((hv[n + 1] * rstd * gcol[n + 1] + scol[n + 1] * xc1) * sz.y); }
    }
#pragma unroll
    for (int i = 0; i < 3; ++i) { const int q = lane + 64 * i, r = q / 12, cc = q % 12;
        *(v4u*)(cat + (size_t)(t0 + wave * 16 + r) * DM + h * 96 + cc * 8) = *(const LAS v4u*)(SC + (wave * 16 + r) * 272 + cc * 16); }
    __syncthreads();
}

__device__ __forceinline__ void phaseE_ret(ArgsP a, int L, int item, ldsp lds, int tid, int lane, int wave) {
    const int bh = item >> 5, c = item & 31, b = bh / 6, h = bh % 6;
    const int t0 = b * SEQ + c * 128, s0 = c * 128;
    ldsp Q = lds, K = lds + 18432, VT = lds + 36864, SC = lds + 54272, RT = lds + 89088;
    const bf16* proj = (const bf16*)(a->ws + WS_PROJ);
    const float* rope = (const float*)(a->ws + WS_ROPE);
    bf16* cat = (bf16*)(a->ws + WS_CAT);
    const float lg = ret_log_gamma(h);
    {
        const int l = tid >> 2, jc = tid & 3, j0 = jc * 8;
        const float* cs = rope + (size_t)(s0 + l) * 32; const float* sn = rope + 4096 * 32 + (size_t)(s0 + l) * 32;
        v4u o1, o2;
        rotary16(proj + (size_t)(t0 + l) * NP + PC_RQ + h * 64, cs, sn, j0, 1.f, o1, o2);
        *(LAS v4u*)(Q + l * 144 + j0 * 2) = o1; *(LAS v4u*)(Q + l * 144 + (32 + j0) * 2) = o2;
        rotary16(proj + (size_t)(t0 + l) * NP + PC_RK + h * 64, cs, sn, j0, 0.125f, o1, o2);
        *(LAS v4u*)(K + l * 144 + j0 * 2) = o1; *(LAS v4u*)(K + l * 144 + (32 + j0) * 2) = o2;
        const bf16* vp = proj + (size_t)(t0 + l) * NP + PC_RV + h * 64 + jc * 16;
        const v4u v0 = *(const v4u*)vp, v1 = *(const v4u*)(vp + 8);
        store_T8(VT, jc * 16, 272, l, v0); store_T8(VT, jc * 16 + 8, 272, l, v1);
        const float* st = (const float*)(a->ws + WS_RST) + (size_t)item * NE_R;
#pragma unroll
        for (int i = 0; i < 2; ++i) { const int idx4 = tid + 512 * i, e = idx4 >> 4, d4 = (idx4 & 15) * 4;
            const f32x4 w = *(const f32x4*)(st + e * 64 + d4);
            *(LAS v2u*)(RT + e * 144 + d4 * 2) = (v2u){pk2(w.x, w.y), pk2(w.z, w.w)}; }
    }
    __syncthreads();
    const int fr = lane & 15, fq = lane >> 4;
    const float* rng = a->in[I_RNG] + (size_t)L * 384 + h * 64;
    float gcol[4];
#pragma unroll
    for (int n = 0; n < 4; ++n) gcol[n] = rng[n * 16 + fr];
    v4u gc[2];
#pragma unroll
    for (int i = 0; i < 2; ++i) { const int q = lane + 64 * i, r = q >> 3, cc = q & 7; gc[i] = *(const v4u*)(proj + (size_t)(t0 + wave * 16 + r) * NP + PC_RG + h * 64 + cc * 8); }
    bf16x8 aq[2];
#pragma unroll
    for (int ks = 0; ks < 2; ++ks) aq[ks] = *(const LAS bf16x8*)(Q + (wave * 16 + fr) * 144 + ks * 64 + fq * 16);
    f32x4 acc2[4];
#pragma unroll
    for (int n = 0; n < 4; ++n) { acc2[n] = (f32x4){0.f, 0.f, 0.f, 0.f};
#pragma unroll
        for (int ks = 0; ks < 2; ++ks) { const bf16x8 bv = *(const LAS bf16x8*)(RT + (n * 16 + fr) * 144 + ks * 64 + fq * 16); acc2[n] = MFMA16(aq[ks], bv, acc2[n]); } }
    f32x4 sacc[8];
#pragma unroll
    for (int st = 0; st < 8; ++st) { sacc[st] = (f32x4){0.f, 0.f, 0.f, 0.f};
        if (st <= wave) {
#pragma unroll
            for (int ks = 0; ks < 2; ++ks) { const bf16x8 bv = *(const LAS bf16x8*)(K + (st * 16 + fr) * 144 + ks * 64 + fq * 16); sacc[st] = MFMA16(aq[ks], bv, sacc[st]); } } }
    float rowf[4];
#pragma unroll
    for (int j = 0; j < 4; ++j) rowf[j] = __expf((float)(fq * 4 + j - fr) * lg);
#pragma unroll
    for (int st = 0; st < 8; ++st) {
        if (st <= (wave | 1)) {
            const int s = st * 16 + fr; const float tf = __expf((float)((wave - st) * 16) * lg);
#pragma unroll
            for (int j = 0; j < 4; ++j) { const int l = wave * 16 + fq * 4 + j;
                const float wgt = (s <= l) ? rowf[j] * tf : 0.f;
                *(LAS unsigned short*)(SC + l * 272 + s * 2) = f2bf(sacc[st][j] * wgt); }
        }
    }
    asm volatile("" ::: "memory");
    f32x4 acc1[4];
#pragma unroll
    for (int n = 0; n < 4; ++n) acc1[n] = (f32x4){0.f, 0.f, 0.f, 0.f};
#pragma unroll
    for (int ks = 0; ks < 4; ++ks) {
        if (ks * 2 <= wave) {
            const bf16x8 av = *(const LAS bf16x8*)(SC + (wave * 16 + fr) * 272 + ks * 64 + fq * 16);
#pragma unroll
            for (int n = 0; n < 4; ++n) { const bf16x8 bv = *(const LAS bf16x8*)(VT + (n * 16 + fr) * 272 + ks * 64 + fq * 16); acc1[n] = MFMA16(av, bv, acc1[n]); }
        }
    }
#pragma unroll
    for (int i = 0; i < 2; ++i) { const int q = lane + 64 * i, r = q >> 3, cc = q & 7; *(LAS v4u*)(Q + (wave * 16 + r) * 144 + cc * 16) = gc[i]; }
#pragma unroll
    for (int j = 0; j < 4; ++j) {
        const int l = wave * 16 + fq * 4 + j;
        const float xi = __expf((float)(l + 1) * lg);
        float hv[4]; float ss = 0.f;
#pragma unroll
        for (int n = 0; n < 4; ++n) { hv[n] = acc1[n][j] + xi * acc2[n][j]; ss += hv[n] * hv[n]; }
        ss += __shfl_xor(ss, 1); ss += __shfl_xor(ss, 2); ss += __shfl_xor(ss, 4); ss += __shfl_xor(ss, 8);
        const float rstd = rsqrtf(ss * (1.f / 64.f) + EPS);
#pragma unroll
        for (int n = 0; n < 4; n += 2) { const int e = n * 16 + fr;
            const f32x2 sg = silu2((f32x2){bf2f(*(const LAS unsigned short*)(Q + l * 144 + e * 2)), bf2f(*(const LAS unsigned short*)(Q + l * 144 + (e + 16) * 2))});
            *(LAS unsigned short*)(SC + l * 272 + e * 2) = f2bf(hv[n] * rstd * gcol[n] * sg.x);
            *(LAS unsigned short*)(SC + l * 272 + (e + 16) * 2) = f2bf(hv[n + 1] * rstd * gcol[n + 1] * sg.y); }
    }
#pragma unroll
    for (int i = 0; i < 2; ++i) { const int q = lane + 64 * i, r = q >> 3, cc = q & 7;
        *(v4u*)(cat + (size_t)(t0 + wave * 16 + r) * DM + CAT_R + h * 64 + cc * 8) = *(const LAS v4u*)(SC + (wave * 16 + r) * 272 + cc * 16); }
    __syncthreads();
}


template <int MODE, int PER>
__device__ __forceinline__ void gemv4_item(const LAS float* A, const float* W, int ldw, int ncol0, int nvalid, int kb, float* out, int ldo, int ocol0, LAS float* red, int tid) {
    constexpr int klen = PER * 16, CH = PER < 32 ? PER : 32;
    const int kq = tid >> 5, c = tid & 31, k0 = kq * PER;
    float acc[4] = {0.f, 0.f, 0.f, 0.f};
    if (c < nvalid) {
        const float* wp = W + (size_t)(kb + k0) * ldw + ncol0 + c;
#pragma unroll
        for (int kk = 0; kk < PER; kk += CH) {
            float w[CH];
#pragma unroll
            for (int i = 0; i < CH; ++i) w[i] = wp[(size_t)(kk + i) * ldw];
#pragma unroll
            for (int i = 0; i < CH; ++i)
#pragma unroll
                for (int r = 0; r < 4; ++r) acc[r] += A[r * klen + k0 + kk + i] * w[i];
        }
    }
#pragma unroll
    for (int r = 0; r < 4; ++r) red[(kq * 4 + r) * 32 + c] = acc[r];
    __syncthreads();
    if (tid < 128) { const int r = tid >> 5; float s = 0.f;
#pragma unroll
        for (int q = 0; q < 16; ++q) s += red[(q * 4 + r) * 32 + c];
        if (c < nvalid) { float* o = out + (size_t)r * ldo + ocol0 + c;
            if (MODE == 0) *o = s; else if (MODE == 1) { const float t = fmaxf(s, 0.f); *o = t * t; } else atomicAdd(o, s); } }
    __syncthreads();
}
__device__ __forceinline__ void precise_norm_to_lds(const float* x0, size_t row_stride, const float* g, LAS float* A, int lane, int wave) {
    if (wave < 4) { const f32x4* xr = (const f32x4*)(x0 + (size_t)wave * row_stride) + lane; f32x4 v[4]; float ss = 0.f;
#pragma unroll
        for (int j = 0; j < 4; ++j) { v[j] = xr[64 * j]; ss += (v[j].x * v[j].x + v[j].y * v[j].y) + (v[j].z * v[j].z + v[j].w * v[j].w); }
        const float rstd = rsqrtf(wave_sum(ss) * (1.f / DM) + EPS);
#pragma unroll
        for (int j = 0; j < 4; ++j) { const f32x4 gv = ((const f32x4*)g)[lane + 64 * j]; *(LAS f32x4*)(A + wave * 1024 + 4 * lane + 256 * j) = v[j] * rstd * gv; } }
    __syncthreads();
}
__device__ __forceinline__ void lds_copy_rows(const float* src, int ld, int kb, int klen, LAS float* A, int tid) {
    for (int i = tid; i < 4 * klen; i += NTHR) { const int r = i / klen, k = i - r * klen; A[i] = src[(size_t)r * ld + kb + k]; }
    __syncthreads();
}
__device__ __forceinline__ void precise_mixer(ArgsP a, int L, int b, ldsp lds, int tid, int lane, int wave) {
    LAS float* XC = (LAS float*)lds, *XM = XC + 384, *Qs = XC + 768, *Ks = XC + 1152, *Vs = XC + 1536;
    const float* projP = (const float*)(a->ws + WS_PROJP); float* catP = (float*)(a->ws + WS_CATP);
    {
        const float* p = projP + (size_t)b * N_IN; float* o = catP + (size_t)b * DM;
        if (tid < 384) { const float x = p[tid]; XM[tid] = x; XC[tid] = silu_f(a->in[I_CONVW][(size_t)L * 4 * 384 + 3 * 384 + tid] * x + a->in[I_CONVB][(size_t)L * 384 + tid]); }
        __syncthreads();
        if (tid < 384) { const int nb = tid >> 2, j = tid & 3; float q = 0.f, k = 0.f, v = 0.f;
#pragma unroll
            for (int i = 0; i < 4; ++i) { const size_t wi = ((size_t)L * 96 + nb) * 16 + i * 4 + j; q += XC[nb * 4 + i] * a->in[I_WQ][wi]; k += XC[nb * 4 + i] * a->in[I_WK][wi]; v += XM[nb * 4 + i] * a->in[I_WV][wi]; }
            Qs[tid] = q; Ks[tid] = k * 0.10206207261596575f; Vs[tid] = v; }
        __syncthreads();
        if (wave < 4) {
            const int h = wave; const int d0 = h * 96 + lane, d1 = h * 96 + 64 + lane; const bool two = lane < 32;
            float s = Qs[d0] * Ks[d0] + (two ? Qs[d1] * Ks[d1] : 0.f); s = wave_sum(s);
            const float ig = p[768 + h] + a->in[I_IB][L * 4 + h], f = p[772 + h] + a->in[I_FB][L * 4 + h];
            const float logf = fminf(f, 0.f) - __logf(1.f + __expf(-fabsf(f)));
            const float mt = fmaxf(logf, ig), wts = __expf(ig - mt), den = s * wts, inv = 1.f / fmaxf(fabsf(den), __expf(-mt));
            const float h0 = den * Vs[d0] * inv, h1 = two ? den * Vs[d1] * inv : 0.f;
            const float rstd = rsqrtf(wave_sum(h0 * h0 + h1 * h1) * (1.f / 96.f) + EPS);
            const float* mg = a->in[I_MNG] + (size_t)L * 384; const float* sk = a->in[I_SKIP] + (size_t)L * 384;
            o[d0] = (h0 * rstd * mg[d0] + sk[d0] * XC[d0]) * silu_f(p[384 + d0]);
            if (two) o[d1] = (h1 * rstd * mg[d1] + sk[d1] * XC[d1]) * silu_f(p[384 + d1]);
        } else {
            for (int h = wave - 4; h < 6; h += 4) { const int d = h * 64 + lane;
                const float s = wave_sum(p[776 + d] * p[1160 + d]) * 0.125f; const float val = s * p[1544 + d];
                const float rstd = rsqrtf(wave_sum(val * val) * (1.f / 64.f) + EPS);
                o[CAT_R + d] = val * rstd * a->in[I_RNG][(size_t)L * 384 + d] * silu_f(p[1928 + d]); }
        }
        if (wave < 4) {
            const int g = wave; float gl[4]; float ss = 0.f;
#pragma unroll
            for (int i = 0; i < 4; ++i) { gl[i] = gelu_tanh(p[2568 + lane + 64 * i]); ss += gl[i] * gl[i]; }
            const float rstd = rsqrtf(wave_sum(ss) * (1.f / 256.f) + EPS);
            float gv = 0.f;
#pragma unroll
            for (int i = 0; i < 4; ++i) if (i == g) gv = gl[i];
            gv = gv * rstd * a->in[I_GNG][(size_t)L * 256 + g * 64 + lane];
            const float w00 = a->in[I_GWS][((size_t)L * 4 + g) * 128 * 128], b0 = a->in[I_GBS][((size_t)L * 4 + g) * 128];
            o[CAT_G + g * 64 + lane] = gelu_tanh(p[2312 + g * 64 + lane]) * (w00 * gv + b0);
        }
        __syncthreads();
    }
}

__global__ void __launch_bounds__(NTHR, 2) fwd_kernel(Args a_unused) {
    extern __shared__ __attribute__((aligned(16))) unsigned char lds_raw[];
    cg::grid_group grid = cg::this_grid();
    ldsp lds = (ldsp)lds_raw;
#define PHASE_BEGIN() int tid_o = threadIdx.x; asm volatile("" : "+v"(tid_o)); const int tid = tid_o, lane = tid & 63, wave = __builtin_amdgcn_readfirstlane(tid >> 6); (void)lane; (void)wave; \
    ArgsP a = (ArgsP)__builtin_amdgcn_kernarg_segment_ptr(); asm volatile("" : "+s"(a)); unsigned char* ws = a->ws; (void)ws; const int G = gridDim.x; (void)G;
    volatile LAS unsigned* MISC = (volatile LAS unsigned*)(lds + LDS_BYTES - 64);
    if (threadIdx.x < 16) MISC[threadIdx.x] = 0u;
    __syncthreads();
    { ArgsP a = (ArgsP)__builtin_amdgcn_kernarg_segment_ptr(); (void)xcd_barrier_post((unsigned*)(a->ws + WS_CTL), MISC); }
#define GRID_SYNC() do { ArgsP a_b = (ArgsP)__builtin_amdgcn_kernarg_segment_ptr(); asm volatile("" : "+s"(a_b)); XcdBarrier bar_; bar_.bar = (unsigned*)(a_b->ws + WS_CTL); bar_.x = xb_xcc_id(); \
        bar_.st = (volatile LAS unsigned*)(lds + LDS_BYTES - 64); xcd_barrier(bar_); } while (0)

    {
        PHASE_BEGIN();
        float* rope = (float*)(ws + WS_ROPE);
        for (int idx = blockIdx.x * NTHR + tid; idx < 4096 * 32; idx += G * NTHR) {
            const int pos = idx >> 5, j = idx & 31;
            const float freq = exp2f(-(float)j * (13.287712379549449f / 32.f));
            const double ang = (double)pos * (double)freq;
            double rev = ang * 0.15915494309189535; rev -= __builtin_rint(rev);
            const float fr = (float)rev;
            rope[idx] = __builtin_amdgcn_cosf(fr); rope[4096 * 32 + idx] = __builtin_amdgcn_sinf(fr);
        }
        {
            const int gw = blockIdx.x * NWAVES + wave, NGW = G * NWAVES;
            const float* x = a->in[I_X]; bf16* xb = (bf16*)(ws + WS_H); float* ssq = (float*)(ws + WS_SSQ);
            for (int m0 = gw; m0 < MTOK; m0 += 4 * NGW) {
                f32x4 v[4][4];
#pragma unroll
                for (int r = 0; r < 4; ++r) { const int m = m0 + r * NGW; if (m < MTOK) { const f32x4* xr = (const f32x4*)(x + (size_t)m * DM) + lane;
#pragma unroll
                    for (int j = 0; j < 4; ++j) v[r][j] = xr[64 * j]; } }
#pragma unroll
                for (int r = 0; r < 4; ++r) { const int m = m0 + r * NGW; if (m < MTOK) { float ss = 0.f;
#pragma unroll
                    for (int j = 0; j < 4; ++j) ss += (v[r][j].x * v[r][j].x + v[r][j].y * v[r][j].y) + (v[r][j].z * v[r][j].z + v[r][j].w * v[r][j].w);
                    ss = wave_sum(ss);
                    unsigned long long* o8 = (unsigned long long*)(xb + (size_t)m * DM) + lane;
#pragma unroll
                    for (int j = 0; j < 4; ++j) o8[64 * j] = (unsigned long long)pk2(v[r][j].x, v[r][j].y) | ((unsigned long long)pk2(v[r][j].z, v[r][j].w) << 32);
                    if (lane < 16) ssq[(size_t)m * 16 + lane] = lane == 0 ? ss : 0.f; } }
            }
        }
        convert_weights(a, 0, 0, lds, lane, wave);
        if (blockIdx.x == 0) { float* xP = (float*)(ws + WS_XP); for (int i = tid; i < 4 * DM; i += NTHR) xP[i] = a->in[I_X][(size_t)(i >> 10) * SEQ * DM + (i & 1023)]; }
    }
    { ArgsP a = (ArgsP)__builtin_amdgcn_kernarg_segment_ptr(); asm volatile("" : "+s"(a)); if (a->ws == nullptr) grid.sync(); }
    GRID_SYNC();

    for (int L = 0; L < DEPTH; ++L) {
        if ((int)blockIdx.x < 89) {
            PHASE_BEGIN();
            const float* xP = (const float*)(ws + WS_XP);
            LAS float* Ap = (LAS float*)(lds + 100352); LAS float* red = (LAS float*)(lds + 116736);
            precise_norm_to_lds(L == 0 ? a->in[I_X] : xP, L == 0 ? (size_t)SEQ * DM : (size_t)DM, a->in[I_NMG] + (size_t)L * DM, Ap, lane, wave);
            { const int cg_ = (int)blockIdx.x;
                gemv4_item<0, 64>(Ap, a->in[I_WIN] + (size_t)L * DM * N_IN, N_IN, cg_ * 32, cg_ == 88 ? 8 : 32, 0, (float*)(ws + WS_PROJP), N_IN, cg_ * 32, red, tid); }
        }
        {
            PHASE_BEGIN();
            const size_t wb = (L & 1) ? WS_WBUF1 : 0;
            pg8::Gemm g{(const bf16*)(ws + WS_H), (const bf16*)(ws + wb + WS_WIN), MTOK, NPAD, DM}; pg8::StaticOrder S; S.init(MTOK, NPAD, G, (int)blockIdx.x);
            pg8::EpiScaledBf16<0> E{(bf16*)(ws + WS_PROJ), NP, (const float*)(ws + WS_SSQ), 11, (float*)(ws + WS_GATES), a->in[I_IB] + L * 4, a->in[I_FB] + L * 4};
            for (int rep = 0; rep < 1 + XREP_B; ++rep) pg8::gemm_phase<pg8::EpiScaledBf16<0>, pg8::StaticOrder, GEMM_ALIGN, GEMM_SP2>(lds, g, S, E);
        }
        GRID_SYNC();
        if ((int)blockIdx.x >= (int)gridDim.x - 4) { PHASE_BEGIN(); precise_mixer(a, L, (int)blockIdx.x - (G - 4), lds, tid, lane, wave); }
        for (int rep = 0; rep < 1 + XREP_C; ++rep)
        for (int it = blockIdx.x; it < 1536; it += gridDim.x) {
            PHASE_BEGIN();
            if (it < 512) phaseC_mlstm(a, L, it, lds, tid, lane, wave);
            else if (it < 1280) phaseC_ret(a, L, it - 512, lds, tid, lane, wave);
            else phaseC_gmlp(a, L, it - 1280, lds, tid, lane, wave);
        }
        GRID_SYNC();
        {
            PHASE_BEGIN();
            phaseD(a, lds, tid);
            if ((int)blockIdx.x < 128) { const int pi = blockIdx.x, cg_ = pi & 31, ks = pi >> 5; LAS float* Ap = (LAS float*)lds; LAS float* red = (LAS float*)(lds + 16384);
                lds_copy_rows((const float*)(ws + WS_CATP), DM, ks * 256, 256, Ap, tid);
                gemv4_item<2, 16>(Ap, a->in[I_WOUT] + (size_t)L * DM * DM, DM, cg_ * 32, 32, ks * 256, (float*)(ws + WS_XP), DM, cg_ * 32, red, tid); }
            if (L + 1 < DEPTH) convert_weights(a, L + 1, ((L + 1) & 1) ? WS_WBUF1 : 0, lds, lane, wave);
        }
        GRID_SYNC();
        for (int rep = 0; rep < 1 + XREP_E; ++rep)
        for (int it = blockIdx.x; it < (rep == 0 ? 1280 + 128 : XREP_E_END); it += gridDim.x) {
            PHASE_BEGIN();
            if (it >= 1280) { const int cg_ = it - 1280; LAS float* Ap = (LAS float*)lds; LAS float* red = (LAS float*)(lds + 16384);
                precise_norm_to_lds((const float*)(ws + WS_XP), DM, a->in[I_NFG] + (size_t)L * DM, Ap, lane, wave);
                gemv4_item<1, 64>(Ap, a->in[I_WFF1] + (size_t)L * DM * DFF, DFF, cg_ * 32, 32, 0, (float*)(ws + WS_HIDP), DFF, cg_ * 32, red, tid); continue; }
            if (it < 512) phaseE_mlstm(a, L, it, lds, tid, lane, wave);
            else phaseE_ret(a, L, it - 512, lds, tid, lane, wave);
        }
        GRID_SYNC();
        {
            PHASE_BEGIN();
            const size_t wb = (L & 1) ? WS_WBUF1 : 0;
            pg8::Gemm g{(const bf16*)(ws + WS_CAT), (const bf16*)(ws + wb + WS_WOUT), MTOK, DM, DM}; pg8::StaticOrder S; S.init(MTOK, DM, G, (int)blockIdx.x);
            pg8::EpiResidNorm E{(L == 0) ? a->in[I_X] : a->out, a->out, (bf16*)(ws + WS_H), (float*)(ws + WS_SSQ), nullptr, DM};
            pg8::gemm_phase<pg8::EpiResidNorm, pg8::StaticOrder, true, GEMM_SP2>(lds, g, S, E);
        }
        GRID_SYNC();
        {
            PHASE_BEGIN();
            { const int pi = blockIdx.x, cg_ = pi & 31, ks = pi >> 5; LAS float* Ap = (LAS float*)lds; LAS float* red = (LAS float*)(lds + 16384);
              if (pi < 256) { lds_copy_rows((const float*)(ws + WS_HIDP), DFF, ks * 512, 512, Ap, tid);
                gemv4_item<2, 32>(Ap, a->in[I_WFF2] + (size_t)L * DFF * DM, DM, cg_ * 32, 32, ks * 512, (float*)(ws + WS_XP), DM, cg_ * 32, red, tid); } }
        }
        {
            PHASE_BEGIN();
            const size_t wb = (L & 1) ? WS_WBUF1 : 0;
            pg8::Gemm g{(const bf16*)(ws + WS_H), (const bf16*)(ws + wb + WS_W1), MTOK, DFF, DM}; pg8::StaticOrder S; S.init(MTOK, DFF, G, (int)blockIdx.x);
            pg8::EpiScaledBf16<2> E{(bf16*)(ws + WS_HID), DFF, (const float*)(ws + WS_SSQ), -1, nullptr, nullptr, nullptr};
            for (int rep = 0; rep < 1 + XREP_H; ++rep) pg8::gemm_phase<pg8::EpiScaledBf16<2>, pg8::StaticOrder, GEMM_ALIGN, GEMM_SP2>(lds, g, S, E);
        }
        GRID_SYNC();
        {
            PHASE_BEGIN();
            const size_t wb = (L & 1) ? WS_WBUF1 : 0;
            pg8::Gemm g{(const bf16*)(ws + WS_HID), (const bf16*)(ws + wb + WS_W2), MTOK, DM, DFF}; pg8::StaticOrder S; S.init(MTOK, DM, G, (int)blockIdx.x);
            pg8::EpiResidNorm E{a->out, a->out, (bf16*)(ws + WS_H), (float*)(ws + WS_SSQ), (const float*)(ws + WS_XP), DM};
            pg8::gemm_phase<pg8::EpiResidNorm, pg8::StaticOrder, true, GEMM_SP2>(lds, g, S, E);
        }
        GRID_SYNC();
    }
    {
        PHASE_BEGIN();
        const int gw = blockIdx.x * NWAVES + wave, NGW = G * NWAVES;
        const float* g = a->in[I_FNG]; const float* xP = (const float*)(ws + WS_XP);
        f32x4 gv[4];
#pragma unroll
        for (int j = 0; j < 4; ++j) gv[j] = ((const f32x4*)g)[lane + 64 * j];
        for (int m0 = gw; m0 < MTOK; m0 += 4 * NGW) {
            f32x4 v[4][4];
#pragma unroll
            for (int r = 0; r < 4; ++r) { const int m = m0 + r * NGW; if (m < MTOK) {
                const f32x4* xs = (m & (SEQ - 1)) == 0 ? (const f32x4*)(xP + (size_t)(m >> 12) * DM) + lane : (const f32x4*)(a->out + (size_t)m * DM) + lane;
#pragma unroll
                for (int j = 0; j < 4; ++j) v[r][j] = xs[64 * j]; } }
#pragma unroll
            for (int r = 0; r < 4; ++r) { const int m = m0 + r * NGW; if (m < MTOK) { float ss = 0.f;
#pragma unroll
                for (int j = 0; j < 4; ++j) ss += (v[r][j].x * v[r][j].x + v[r][j].y * v[r][j].y) + (v[r][j].z * v[r][j].z + v[r][j].w * v[r][j].w);
                const float rstd = rsqrtf(wave_sum(ss) * (1.f / DM) + EPS);
                f32x4* xr = (f32x4*)(a->out + (size_t)m * DM) + lane;
#pragma unroll
                for (int j = 0; j < 4; ++j) xr[64 * j] = v[r][j] * rstd * gv[j]; } }
        }
    }
}

extern "C" void kernel_launch(void* const* d_in, const int* in_sizes, int n_in, void* d_out, int out_size, void* d_ws, size_t ws_size, hipStream_t stream) {
    static int grid = 0;
    if (grid == 0) {
        if (n_in != 21 || out_size != MTOK * DM || ws_size < WS_END) { fprintf(stderr, "kernel_launch: unexpected shapes (n_in %d out %d ws %zu)\n", n_in, out_size, ws_size); grid = -1; return; }
        int dev = 0, cus = 0, per_cu = 0;
        hipGetDevice(&dev);
        hipDeviceGetAttribute(&cus, hipDeviceAttributeMultiprocessorCount, dev);
        if (hipFuncSetAttribute((const void*)fwd_kernel, hipFuncAttributeMaxDynamicSharedMemorySize, LDS_BYTES) != hipSuccess) { fprintf(stderr, "kernel_launch: hipFuncSetAttribute failed\n"); grid = -1; return; }
        if (hipOccupancyMaxActiveBlocksPerMultiprocessor(&per_cu, (const void*)fwd_kernel, NTHR, LDS_BYTES) != hipSuccess || per_cu < 1) { fprintf(stderr, "kernel_launch: occupancy query says %d\n", per_cu); per_cu = 1; }
        (void)hipGetLastError();
        grid = cus;
        fprintf(stderr, "kernel_launch: cus %d per_cu %d grid %d\n", cus, per_cu, grid);
    }
    if (grid < 0) return;
    if (hipMemsetAsync((char*)d_ws + WS_CTL, 0, 16384, stream) != hipSuccess) { fprintf(stderr, "kernel_launch: memset failed\n"); return; }
    Args a{};
    for (int i = 0; i < 21; ++i) a.in[i] = (const float*)d_in[i];
    a.out = (float*)d_out; a.ws = (unsigned char*)d_ws;
    void* args[] = {&a};
    hipError_t e = hipLaunchCooperativeKernel((const void*)fwd_kernel, dim3(grid), dim3(NTHR), args, LDS_BYTES, stream);
    if (e != hipSuccess) fprintf(stderr, "cooperative launch failed: %s (grid %d)\n", hipGetErrorString(e), grid);
}
```

```cpp
#define EPI_BATCH 4
#include <hip/hip_runtime.h>
#include <hip/hip_cooperative_groups.h>
#include <cstdio>
#include <cstdint>
namespace cg = cooperative_groups;
namespace pg8 {
#define PG8_LAS __attribute__((address_space(3)))
typedef unsigned short bf16_t;
typedef short bf16x8 __attribute__((ext_vector_type(8)));
typedef float f32x4 __attribute__((ext_vector_type(4)));
typedef unsigned u32x4 __attribute__((ext_vector_type(4)));
constexpr int BM = 256, BK = 64, HALF = 128, HTB = HALF * BK * 2  , STAGE_BYTES = 8 * HTB, NXCD = 8, WGM = 8;

__host__ __device__ __forceinline__ int lds_byte(int r, int c) { const int st = (r >> 4) * 2 + (c >> 5), rr = r & 15, cc = c & 31, ob = rr * 64 + cc * 2; return st * 1024 + (ob ^ (((ob >> 9) & 1) << 5)); }
__host__ __device__ __forceinline__ void stage_rc(int b, int& R, int& C) { const int st = b / 1024, sb = b % 1024, swz = sb ^ (((sb >> 9) & 1) << 5); R = (st >> 1) * 16 + swz / 64; C = (st & 1) * 32 + (swz % 64) / 2; }
__host__ __device__ __forceinline__ int perm32(int rho) { const int n = rho >> 4, i = rho & 15; return 8 * (i >> 2) + 4 * n + (i & 3); }

struct Unit { int pm, pn; };
struct Gemm { const bf16_t* A; const bf16_t* Bt; int M, N, K; };

struct StaticOrder {
    int nM, nN, nwg, G, c;
    __host__ __device__ void init(int M, int N, int G_, int c_) { nM = M / BM; nN = N / BM; nwg = nM * nN; G = G_; c = c_; }
    __host__ __device__ bool next(int i, Unit& u) const {
        const long L = (long)i * G + c; if (L >= nwg) return false;
        int wgid = (int)L; { const int q = nwg / NXCD, r = nwg % NXCD, xcd = wgid % NXCD, off = wgid / NXCD; wgid = (xcd < r ? xcd * (q + 1) : r * (q + 1) + (xcd - r) * q) + off; }
        const int nig = WGM * nN, gid = wgid / nig, fm = gid * WGM, gsz = (nM - fm) < WGM ? (nM - fm) : WGM;
        u.pm = fm + ((wgid % nig) % gsz); u.pn = (wgid % nig) / gsz; return true;
    }
    __device__ __forceinline__ void a_ready(const Unit&) const {}
    __device__ __forceinline__ void done(const Unit&) const {}
};

__device__ __forceinline__ unsigned cvt_pk_bf16(float lo, float hi) { unsigned r; asm volatile("v_cvt_pk_bf16_f32 %0, %1, %2" : "=v"(r) : "v"(lo), "v"(hi)); return r; }
typedef float f32x2 __attribute__((ext_vector_type(2)));
template <int ACT> struct EpiBf16 {
    static constexpr bool PERM = true, AFTER_DRAIN = false;
    bf16_t* O; int ldc;
    __device__ __forceinline__ void operator()(const f32x4 (&acc)[2][2][4][2], const Unit& u, int wr, int wc, int fr, int fq) const {
        const int row0 = u.pm * BM + wr * 64 + fr; const int col0 = u.pn * BM + wc * 32 + 8 * fq;
#pragma unroll
        for (int ai = 0; ai < 2; ++ai)
#pragma unroll
            for (int m = 0; m < 4; ++m) { bf16_t* rowp = O + (size_t)(row0 + ai * HALF + m * 16) * ldc + col0;
#pragma unroll
                for (int bj = 0; bj < 2; ++bj) { f32x4 v0 = acc[ai][bj][m][0], v1 = acc[ai][bj][m][1];
                    if (ACT == 2) {
#pragma unroll
                        for (int e = 0; e < 4; ++e) { float a = fmaxf(v0[e], 0.f), b = fmaxf(v1[e], 0.f); v0[e] = a * a; v1[e] = b * b; } }
                    u32x4 w; w.x = cvt_pk_bf16(v0[0], v0[1]); w.y = cvt_pk_bf16(v0[2], v0[3]); w.z = cvt_pk_bf16(v1[0], v1[1]); w.w = cvt_pk_bf16(v1[2], v1[3]);
                    *(u32x4*)(rowp + bj * HALF) = w; } }
    }
};
struct EpiResid {
    static constexpr bool PERM = false, AFTER_DRAIN = false;
    const float* base; float* out; int ldc;
    __device__ __forceinline__ void operator()(const f32x4 (&acc)[2][2][4][2], const Unit& u, int wr, int wc, int fr, int fq) const {
        const int col0 = u.pn * BM + wc * 32 + 4 * fq;
#pragma unroll
        for (int ai = 0; ai < 2; ++ai)
#pragma unroll
            for (int m = 0; m < 4; ++m) { const size_t off = (size_t)(u.pm * BM + ai * HALF + wr * 64 + m * 16 + fr) * ldc + col0;
#pragma unroll
                for (int bj = 0; bj < 2; ++bj)
#pragma unroll
                    for (int n = 0; n < 2; ++n) { const f32x4 bs = *(const f32x4*)(base + off + bj * HALF + n * 16); *(f32x4*)(out + off + bj * HALF + n * 16) = bs + acc[ai][bj][m][n]; } }
    }
};
__device__ __forceinline__ float row_rstd(const float* ssq, int row) {
    const f32x4* p = (const f32x4*)(ssq + (size_t)row * 16);
    const f32x4 a = p[0], b = p[1], c = p[2], d = p[3];
    const float s = (((a[0] + a[1]) + (a[2] + a[3])) + ((b[0] + b[1]) + (b[2] + b[3]))) + (((c[0] + c[1]) + (c[2] + c[3])) + ((d[0] + d[1]) + (d[2] + d[3])));
    return rsqrtf(s * (1.0f / 1024.0f) + 1e-6f);
}
#ifndef EPI_BATCH
#define EPI_BATCH 2
#endif
template <int ACT> struct EpiScaledBf16 {
    static constexpr bool PERM = true, AFTER_DRAIN = false;
    bf16_t* O; int ldc; const float* ssq; int gate_pn; float* gates; const float* ib; const float* fb;
    __device__ __forceinline__ void operator()(const f32x4 (&acc)[2][2][4][2], const Unit& u, int wr, int wc, int fr, int fq) const {
        const int row0 = u.pm * BM + wr * 64 + fr; const int col0 = u.pn * BM + wc * 32 + 8 * fq;
        const bool gate_tile = (u.pn == gate_pn);
        if (gate_tile && !(wc == 0 && fq == 0)) return;
#pragma unroll
        for (int ai = 0; ai < 2; ++ai)
#pragma unroll
        for (int mh = 0; mh < 4; mh += EPI_BATCH) {
            f32x4 p[EPI_BATCH][4]; float rs[EPI_BATCH];
#pragma unroll
            for (int m = 0; m < EPI_BATCH; ++m)
#pragma unroll
                for (int q = 0; q < 4; ++q) p[m][q] = *((const f32x4*)(ssq + (size_t)(row0 + ai * HALF + (mh + m) * 16) * 16) + q);
#pragma unroll
            for (int m = 0; m < EPI_BATCH; ++m) { const f32x4 t = (p[m][0] + p[m][1]) + (p[m][2] + p[m][3]); rs[m] = rsqrtf(((t[0] + t[1]) + (t[2] + t[3])) * (1.0f / 1024.0f) + 1e-6f); }
#pragma unroll
            for (int mm = 0; mm < EPI_BATCH; ++mm) { const int m = mh + mm; const int row = row0 + ai * HALF + m * 16; const float r = rs[mm];
                if (gate_tile) {
                    const f32x4 bi = *(const f32x4*)ib, bf = *(const f32x4*)fb;
                    *(f32x4*)(gates + (size_t)row * 8) = acc[ai][0][m][0] * r + bi; *(f32x4*)(gates + (size_t)row * 8 + 4) = acc[ai][0][m][1] * r + bf;
                } else {
                    bf16_t* rowp = O + (size_t)row * ldc + col0;
#pragma unroll
                    for (int bj = 0; bj < 2; ++bj) { f32x4 v0 = acc[ai][bj][m][0] * r, v1 = acc[ai][bj][m][1] * r;
                        if (ACT == 2) {
#pragma unroll
                            for (int e = 0; e < 4; ++e) { float a = fmaxf(v0[e], 0.f), b = fmaxf(v1[e], 0.f); v0[e] = a * a; v1[e] = b * b; } }
                        u32x4 w; w.x = cvt_pk_bf16(v0[0], v0[1]); w.y = cvt_pk_bf16(v0[2], v0[3]); w.z = cvt_pk_bf16(v1[0], v1[1]); w.w = cvt_pk_bf16(v1[2], v1[3]);
                        *(u32x4*)(rowp + bj * HALF) = w; }
                }
            }
            asm volatile("" ::: "memory");
        }
    }
};
struct EpiResidNorm {
    static constexpr bool PERM = false, AFTER_DRAIN = false;
    const float* base; float* out; bf16_t* xb; float* ssq; const float* xP; int ldc;
    __device__ __forceinline__ void operator()(const f32x4 (&acc)[2][2][4][2], const Unit& u, int wr, int wc, int fr, int fq) const {
        typedef unsigned u32x2v __attribute__((ext_vector_type(2)));
        const int col0 = u.pn * BM + wc * 32 + 4 * fq;
#pragma unroll
        for (int ai = 0; ai < 2; ++ai)
#pragma unroll
        for (int mh = 0; mh < 4; mh += EPI_BATCH) {
            f32x4 pre[EPI_BATCH][2][2];
#pragma unroll
            for (int mm = 0; mm < EPI_BATCH; ++mm) { const int m = mh + mm; const int row = u.pm * BM + ai * HALF + wr * 64 + m * 16 + fr; const bool p0 = xP != nullptr && (row & 4095) == 0;
                const float* src = p0 ? xP + (size_t)(row >> 12) * ldc + col0 : base + (size_t)row * ldc + col0;
#pragma unroll
                for (int bj = 0; bj < 2; ++bj)
#pragma unroll
                    for (int n = 0; n < 2; ++n) pre[mm][bj][n] = *(const f32x4*)(src + bj * HALF + n * 16); }
#pragma unroll
            for (int mm = 0; mm < EPI_BATCH; ++mm) { const int m = mh + mm; const int row = u.pm * BM + ai * HALF + wr * 64 + m * 16 + fr; const size_t off = (size_t)row * ldc + col0; float s = 0.f;
                const bool p0 = xP != nullptr && (row & 4095) == 0;
#pragma unroll
                for (int bj = 0; bj < 2; ++bj)
#pragma unroll
                    for (int n = 0; n < 2; ++n) { const int co = bj * HALF + n * 16;
                        f32x4 v = pre[mm][bj][n]; if (!p0) v = v + acc[ai][bj][m][n];
                        *(f32x4*)(out + off + co) = v; s += (v[0] * v[0] + v[1] * v[1]) + (v[2] * v[2] + v[3] * v[3]);
                        if (xb != nullptr) { u32x2v w; w.x = cvt_pk_bf16(v[0], v[1]); w.y = cvt_pk_bf16(v[2], v[3]); *(u32x2v*)(xb + off + co) = w; } }
                s += __shfl_xor(s, 16); s += __shfl_xor(s, 32);
                if (fq == 0 && ssq != nullptr) ssq[(size_t)row * 16 + u.pn * 4 + wc] = s; }
            asm volatile("" ::: "memory");
        }
    }
};
struct EpiNull {
    static constexpr bool PERM = false, AFTER_DRAIN = false;
    float* sink;
    __device__ __forceinline__ void operator()(const f32x4 (&acc)[2][2][4][2], const Unit& u, int wr, int wc, int fr, int fq) const {
        float s = 0.f;
#pragma unroll
        for (int ai = 0; ai < 2; ++ai)
#pragma unroll
            for (int bj = 0; bj < 2; ++bj)
#pragma unroll
                for (int m = 0; m < 4; ++m)
#pragma unroll
                    for (int n = 0; n < 2; ++n) s += (acc[ai][bj][m][n][0] + acc[ai][bj][m][n][1]) + (acc[ai][bj][m][n][2] + acc[ai][bj][m][n][3]);
        if (s == 1.2345678e33f) sink[0] = s;
    }
};
template <class Epi, class Sched, bool ALIGN_EPI = false, bool SP2 = false>
__device__ __forceinline__ void gemm_phase(PG8_LAS unsigned char* lds, const Gemm g, const Sched& S, const Epi& E) {
    int tid_o = threadIdx.x; asm volatile("" : "+v"(tid_o)); const int tid = tid_o, wid = __builtin_amdgcn_readfirstlane(tid >> 6), lane = tid & 63, wr = wid >> 2, wc = wid & 3, fr = lane & 15, fq = lane >> 4;
    const int K = g.K, nt = K / BK;
    unsigned voffA[2], voffB[2];
#pragma unroll
    for (int i = 0; i < 2; ++i) { int R, C; stage_rc(tid * 16 + i * 8192, R, C); const int Rb = Epi::PERM ? ((R & ~31) + perm32(R & 31)) : R;
        voffA[i] = (unsigned)(R * K + C) * 2u; voffB[i] = (unsigned)(Rb * K + C) * 2u; }
    const size_t kstep = (size_t)(BK * 2);
    const size_t hstep = (size_t)HALF * K * 2;
    const size_t tstep = 2 * hstep;
    const unsigned ldsw = (unsigned)wid * 1024u;
    const int aoff = lds_byte(wr * 64 + fr, fq * 8), boff = lds_byte(wc * 32 + fr, fq * 8);
#define PG8_SA(b, h) (((b) * 2 + (h)) * HTB)
#define PG8_SB(b, h) ((4 + (b) * 2 + (h)) * HTB)
#define PG8_STAGE(bufoff, gbase, voff) do { _Pragma("unroll") for (int _i = 0; _i < 2; ++_i) \
        __builtin_amdgcn_global_load_lds((const unsigned*)((const char*)(gbase) + (voff)[_i]), (PG8_LAS unsigned*)(lds + (bufoff) + ldsw + _i * 8192), 16, 0, 0); } while (0)
#define PG8_LDA(dst, b, h) do { _Pragma("unroll") for (int m = 0; m < 4; ++m) _Pragma("unroll") for (int k = 0; k < 2; ++k) dst[m][k] = *(const PG8_LAS bf16x8*)(lds + PG8_SA(b, h) + aoff + m * 2048 + k * 1024); } while (0)
#define PG8_LDB(dst, b, h) do { _Pragma("unroll") for (int n = 0; n < 2; ++n) _Pragma("unroll") for (int k = 0; k < 2; ++k) dst[n][k] = *(const PG8_LAS bf16x8*)(lds + PG8_SB(b, h) + boff + n * 2048 + k * 1024); } while (0)
#define PG8_MMA(ai, bj, At, Bt) do { __builtin_amdgcn_s_setprio(1); _Pragma("unroll") for (int m = 0; m < 4; ++m) _Pragma("unroll") for (int n = 0; n < 2; ++n) _Pragma("unroll") for (int k = 0; k < 2; ++k) \
        acc[ai][bj][m][n] = __builtin_amdgcn_mfma_f32_16x16x32_bf16(Bt[n][k], At[m][k], acc[ai][bj][m][n], 0, 0, 0); __builtin_amdgcn_s_setprio(0); } while (0)
#define PG8_WAIT_V(n) asm volatile("s_waitcnt vmcnt(" #n ")" ::: "memory")
#define PG8_WAIT_L(n) asm volatile("s_waitcnt lgkmcnt(" #n ")" ::: "memory")
#define PG8_BAR __builtin_amdgcn_s_barrier()
#define PG8_SCHED __builtin_amdgcn_sched_barrier(0)
    Unit cur, nxt; int ui = 0;
    if (!S.next(0, cur)) return;
    f32x4 acc[2][2][4][2];
#pragma unroll
    for (int a = 0; a < 2; ++a)
#pragma unroll
        for (int b = 0; b < 2; ++b)
#pragma unroll
            for (int m = 0; m < 4; ++m)
#pragma unroll
                for (int n = 0; n < 2; ++n) acc[a][b][m][n] = (f32x4){0.f, 0.f, 0.f, 0.f};
    bf16x8 At[4][2], B0[2][2], B1[2][2];
    const char* cA = (const char*)g.A + (size_t)cur.pm * tstep; const char* cB = (const char*)g.Bt + (size_t)cur.pn * tstep;
    S.a_ready(cur);
    if constexpr (SP2) {
        PG8_STAGE(PG8_SB(0, 0), cB, voffB); PG8_STAGE(PG8_SB(0, 1), cB + hstep, voffB); PG8_STAGE(PG8_SA(0, 0), cA, voffA); PG8_STAGE(PG8_SA(0, 1), cA + hstep, voffA);
        if (wr == 1) PG8_BAR;
        PG8_WAIT_V(2); PG8_BAR;
        PG8_STAGE(PG8_SB(1, 0), cB + kstep, voffB); PG8_STAGE(PG8_SA(1, 0), cA + kstep, voffA); PG8_STAGE(PG8_SB(1, 1), cB + hstep + kstep, voffB);
        PG8_WAIT_V(6); PG8_BAR;
    } else {
        PG8_STAGE(PG8_SB(0, 0), cB, voffB); PG8_STAGE(PG8_SA(0, 0), cA, voffA); PG8_STAGE(PG8_SB(0, 1), cB + hstep, voffB); PG8_STAGE(PG8_SA(0, 1), cA + hstep, voffA);
        if (wr == 1) PG8_BAR;
        PG8_WAIT_V(4); PG8_BAR;
        PG8_STAGE(PG8_SB(1, 0), cB + kstep, voffB); PG8_STAGE(PG8_SA(1, 0), cA + kstep, voffA); PG8_STAGE(PG8_SB(1, 1), cB + hstep + kstep, voffB);
        PG8_WAIT_V(6); PG8_BAR;
    }
    for (;;) {
        const bool has_next = S.next(ui + 1, nxt);
        const char* nA = has_next ? (const char*)g.A + (size_t)nxt.pm * tstep : cA; const char* nB = has_next ? (const char*)g.Bt + (size_t)nxt.pn * tstep : cB;
        for (int t = 0; t < nt; t += 2) {
            const bool last = (t == nt - 2);
            const char* a1 = cA + (size_t)(t + 1) * kstep;
            const char* a2 = last ? nA : cA + (size_t)(t + 2) * kstep; const char* b2 = last ? nB : cB + (size_t)(t + 2) * kstep;
            const char* a3 = a2 + kstep; const char* b3 = b2 + kstep;
            if (last && has_next) S.a_ready(nxt);
            if constexpr (SP2) {
            PG8_LDB(B0, 0, 0); PG8_LDB(B1, 0, 1); PG8_SCHED; PG8_LDA(At, 0, 0); PG8_STAGE(PG8_SA(1, 1), a1 + hstep, voffA);
            PG8_WAIT_V(8); PG8_WAIT_L(0); PG8_BAR; PG8_MMA(0, 0, At, B0); PG8_MMA(0, 1, At, B1); PG8_BAR; PG8_SCHED;
            PG8_LDA(At, 0, 1); PG8_STAGE(PG8_SB(0, 0), b2, voffB); PG8_STAGE(PG8_SB(0, 1), b2 + hstep, voffB); PG8_STAGE(PG8_SA(0, 0), a2, voffA);
            PG8_WAIT_V(8); PG8_WAIT_L(0); PG8_BAR; PG8_MMA(1, 0, At, B0); PG8_MMA(1, 1, At, B1); PG8_BAR; PG8_SCHED;
            PG8_LDB(B0, 1, 0); PG8_LDB(B1, 1, 1); PG8_SCHED; PG8_LDA(At, 1, 0); PG8_STAGE(PG8_SA(0, 1), a2 + hstep, voffA);
            PG8_WAIT_V(8); PG8_WAIT_L(0); PG8_BAR; PG8_MMA(0, 0, At, B0); PG8_MMA(0, 1, At, B1); PG8_BAR; PG8_SCHED;
            PG8_LDA(At, 1, 1); PG8_STAGE(PG8_SB(1, 0), b3, voffB); PG8_STAGE(PG8_SB(1, 1), b3 + hstep, voffB); PG8_STAGE(PG8_SA(1, 0), a3, voffA);
            PG8_WAIT_V(8); PG8_WAIT_L(0); PG8_BAR; PG8_MMA(1, 0, At, B0); PG8_MMA(1, 1, At, B1); PG8_BAR; PG8_SCHED;
            } else {
            PG8_LDB(B0, 0, 0); PG8_SCHED; PG8_LDA(At, 0, 0); PG8_STAGE(PG8_SA(1, 1), a1 + hstep, voffA);
            PG8_WAIT_L(8); PG8_BAR; PG8_WAIT_L(0); PG8_MMA(0, 0, At, B0); PG8_BAR; PG8_SCHED;
            PG8_LDB(B1, 0, 1); PG8_STAGE(PG8_SB(0, 0), b2, voffB);
            PG8_BAR; PG8_WAIT_L(0); PG8_MMA(0, 1, At, B1); PG8_BAR;
            PG8_LDA(At, 0, 1); PG8_STAGE(PG8_SA(0, 0), a2, voffA);
            PG8_BAR; PG8_WAIT_L(0); PG8_MMA(1, 0, At, B0); PG8_BAR; PG8_SCHED;
            PG8_STAGE(PG8_SB(0, 1), b2 + hstep, voffB);
            PG8_WAIT_V(6); PG8_BAR; PG8_MMA(1, 1, At, B1); PG8_BAR;
            PG8_LDB(B0, 1, 0); PG8_SCHED; PG8_LDA(At, 1, 0); PG8_STAGE(PG8_SA(0, 1), a2 + hstep, voffA);
            PG8_WAIT_L(8); PG8_BAR; PG8_WAIT_L(0); PG8_MMA(0, 0, At, B0); PG8_BAR; PG8_SCHED;
            PG8_LDB(B1, 1, 1); PG8_STAGE(PG8_SB(1, 0), b3, voffB);
            PG8_BAR; PG8_WAIT_L(0); PG8_MMA(0, 1, At, B1); PG8_BAR;
            PG8_LDA(At, 1, 1); PG8_STAGE(PG8_SA(1, 0), a3, voffA);
            PG8_BAR; PG8_WAIT_L(0); PG8_MMA(1, 0, At, B0); PG8_BAR; PG8_SCHED;
            PG8_STAGE(PG8_SB(1, 1), b3 + hstep, voffB);
            PG8_WAIT_V(6); PG8_BAR; PG8_MMA(1, 1, At, B1); PG8_BAR;
            }
        }
        if constexpr (ALIGN_EPI) { if (wr == 0) PG8_BAR; }
        if constexpr (!Epi::AFTER_DRAIN) { E(acc, cur, wr, wc, fr, fq); S.done(cur); }
        if (!has_next) break;
#pragma unroll
        for (int a = 0; a < 2; ++a)
#pragma unroll
            for (int b = 0; b < 2; ++b)
#pragma unroll
                for (int m = 0; m < 4; ++m)
#pragma unroll
                    for (int n = 0; n < 2; ++n) acc[a][b][m][n] = (f32x4){0.f, 0.f, 0.f, 0.f};
        cur = nxt; cA = nA; cB = nB; ++ui;
        if constexpr (ALIGN_EPI) { if (wr == 1) PG8_BAR; }
    }
    PG8_WAIT_V(0);
    if constexpr (!ALIGN_EPI) { if (wr == 0) PG8_BAR; }
    PG8_BAR;
    if constexpr (Epi::AFTER_DRAIN) { E.fused(acc, cur, wr, wc, fr, fq, lds, wid, lane); S.done(cur); }
#undef PG8_SA
#undef PG8_SB
#undef PG8_STAGE
#undef PG8_LDA
#undef PG8_LDB
#undef PG8_MMA
#undef PG8_WAIT_V
#undef PG8_WAIT_L
#undef PG8_BAR
#undef PG8_SCHED
}
}

constexpr int NWAVES = 8, NTHR = 512;
constexpr int BATCH = 4, SEQ = 4096, DM = 1024, DEPTH = 4, MTOK = BATCH * SEQ;
constexpr int N_IN = 2824, NP = 2816, NPAD = 3072, DFF = 4096;
constexpr int NCH = 32;
constexpr int PC_MX = 0, PC_MZ = 384, PC_RQ = 768, PC_RK = 1152, PC_RV = 1536, PC_RG = 1920, PC_GU = 2304, PC_GV = 2560;
constexpr int CAT_R = 384, CAT_G = 768;
constexpr float EPS = 1e-6f;
constexpr int NE_M = 97 * 96;
constexpr int NE_R = 64 * 64;

constexpr size_t MiB = 1u << 20;
constexpr size_t WS_CTL = 0;
constexpr size_t WS_WIN = 1 * MiB, WS_WOUT = 7 * MiB, WS_W1 = 9 * MiB, WS_W2 = 17 * MiB;
constexpr size_t WS_ROPE = 25 * MiB;
constexpr size_t WS_GATES = 26 * MiB;
constexpr size_t WS_SCAL = 27 * MiB;
constexpr size_t WS_XP = 27 * MiB + 65536;
constexpr size_t WS_PROJP = WS_XP + 16384;
constexpr size_t WS_CATP = WS_PROJP + 49152;
constexpr size_t WS_HIDP = WS_CATP + 16384;
constexpr size_t WS_H = 28 * MiB;
constexpr size_t WS_PROJ = 60 * MiB;
constexpr size_t WS_CAT = 148 * MiB;
constexpr size_t WS_MST = 180 * MiB;
constexpr size_t WS_RST = 199 * MiB;
constexpr size_t WS_HID = 60 * MiB;
constexpr size_t WS_WBUF1 = 210 * MiB;
constexpr size_t WS_SSQ = 236 * MiB;
constexpr size_t WS_END = 237 * MiB;
static_assert(WS_MST + (size_t)512 * NE_M * 4 <= WS_RST && WS_RST + (size_t)768 * NE_R * 4 <= 211 * MiB, "ws map");
static_assert(WS_HID + (size_t)MTOK * DFF * 2 <= WS_RST, "hid overlay");

#ifndef XREP_A
#define XREP_A 0
#endif
#ifndef XREP_C
#define XREP_C 0
#endif
#ifndef XREP_E_END
#define XREP_E_END 1280
#endif
#ifndef XREP_E
#define XREP_E 0
#endif
#ifndef XREP_D
#define XREP_D 0
#endif
#ifndef XREP_B
#define XREP_B 0
#endif
#ifndef XREP_H
#define XREP_H 0
#endif
#ifndef GEMM_SP2
#define GEMM_SP2 true
#endif
#ifndef GEMM_ALIGN
#define GEMM_ALIGN true
#endif
#ifndef XREP_G
#define XREP_G 0
#endif
constexpr int LDS_BYTES = 147456;

#define LAS __attribute__((address_space(3)))
typedef unsigned short bf16;
typedef unsigned v4u __attribute__((ext_vector_type(4)));
typedef unsigned v2u __attribute__((ext_vector_type(2)));
typedef float f32x4 __attribute__((ext_vector_type(4)));
typedef short bf16x8 __attribute__((ext_vector_type(8)));
typedef LAS unsigned char* ldsp;

__device__ __forceinline__ unsigned pk2(float lo, float hi) { return pg8::cvt_pk_bf16(lo, hi); }
__device__ __forceinline__ unsigned short f2bf(float f) { return (unsigned short)(pg8::cvt_pk_bf16(f, 0.f) & 0xffffu); }
__device__ __forceinline__ float bflo(unsigned u) { return __uint_as_float(u << 16); }
__device__ __forceinline__ float bfhi(unsigned u) { return __uint_as_float(u & 0xffff0000u); }
__device__ __forceinline__ float bf2f(unsigned short h) { return __uint_as_float((unsigned)h << 16); }
__device__ __forceinline__ float fast_rcp(float x) { return __builtin_amdgcn_rcpf(x); }
__device__ __forceinline__ float silu_f(float x) { return x * fast_rcp(1.f + __expf(-x)); }
__device__ __forceinline__ float gelu_tanh(float x) { const float u = 0.7978845608f * (x + 0.044715f * x * x * x); const float r = fast_rcp(__expf(2.f * u) + 1.f); return x - x * r; }
__device__ __forceinline__ float wave_sum(float v) {
#pragma unroll
    for (int o = 1; o < 64; o <<= 1) v += __shfl_xor(v, o);
    return v;
}
#define XB_TMO      128
#define XB_XCNT(j)  (256  + 64 * (j))
#define XB_XSUB(j)  (1280 + 64 * (j))
#define XB_XGEN(j)  (2304 + 64 * (j))
#define XB_TOP      3328
#define XB_TOPGEN   3392
#define XCD_BAR_WORDS 3456
#define XB_SPIN_CAP (1u << 18)

__device__ __forceinline__ unsigned xb_ld(unsigned* p)              { return __hip_atomic_load(p, __ATOMIC_RELAXED, __HIP_MEMORY_SCOPE_AGENT); }
__device__ __forceinline__ unsigned xb_add(unsigned* p, unsigned v) { return __hip_atomic_fetch_add(p, v, __ATOMIC_RELAXED, __HIP_MEMORY_SCOPE_AGENT); }
__device__ __forceinline__ unsigned xb_xcc_id() { return (unsigned)__builtin_amdgcn_s_getreg((3 << 11) | 20) & 0xFu; }
#define XB_SPIN(cond, bar) do { unsigned _sp = 0; while (cond) { __builtin_amdgcn_s_sleep(1); \
    if ((++_sp & 255u) == 0u) { if (xb_ld(&(bar)[XB_TMO])) break; if (_sp > XB_SPIN_CAP) { atomicAdd(&(bar)[XB_TMO], 1u); break; } } } } while (0)

struct XcdBarrier {
    unsigned* bar; unsigned x;
    volatile LAS unsigned* st;
};

__device__ __forceinline__ XcdBarrier xcd_barrier_post(unsigned* bar, volatile LAS unsigned* st) {
    XcdBarrier b; b.bar = bar; b.x = xb_xcc_id(); b.st = st;
    if (threadIdx.x == 0) (void)xb_add(&bar[XB_XCNT(b.x)], 1u);
    return b;
}
__device__ __forceinline__ void xcd_barrier_complete(unsigned* bar, unsigned x, unsigned& nloc, unsigned& nx) {
    const unsigned G = gridDim.x * gridDim.y * gridDim.z;
    unsigned sum, cnt, mine, sp = 0u;
    for (;;) {
        sum = 0u; cnt = 0u; mine = 0u;
#pragma unroll
        for (unsigned j = 0; j < 16; ++j) { const unsigned c = xb_ld(&bar[XB_XCNT(j)]); sum += c; cnt += (c > 0u) ? 1u : 0u; mine = (j == x) ? c : mine; }
        if (sum == G) break;
        __builtin_amdgcn_s_sleep(1);
        if ((++sp & 255u) == 0u) { if (xb_ld(&bar[XB_TMO])) break; if (sp > XB_SPIN_CAP) { atomicAdd(&bar[XB_TMO], 1u); break; } }
    }
    nloc = mine > 0u ? mine : 1u; nx = cnt > 0u ? cnt : 1u;
}

__device__ __forceinline__ void xcd_barrier(const XcdBarrier& b) {
    asm volatile("s_waitcnt vmcnt(0)" ::: "memory");
    __syncthreads();
    if (threadIdx.x == 0) {
        unsigned* bar = b.bar;
        __builtin_amdgcn_s_waitcnt(0);
        unsigned nloc = b.st[0], nx = b.st[1];
        if (nloc == 0u) { xcd_barrier_complete(bar, b.x, nloc, nx); b.st[0] = nloc; b.st[1] = nx; }
        const unsigned old = xb_add(&bar[XB_XSUB(b.x)], 1u);
        const unsigned gen = old / nloc;
        if (old + 1u == (gen + 1u) * nloc) {
            __builtin_amdgcn_fence(__ATOMIC_RELEASE, "agent");
            asm volatile("s_waitcnt vmcnt(0)" ::: "memory");
            const unsigned og = xb_add(&bar[XB_TOP], 1u);
            const unsigned tg = og / nx;
            if (og + 1u == (tg + 1u) * nx) xb_add(&bar[XB_TOPGEN], 1u);
            else XB_SPIN(xb_ld(&bar[XB_TOPGEN]) == tg, bar);
            __builtin_amdgcn_fence(__ATOMIC_ACQUIRE, "agent");
            xb_add(&bar[XB_XGEN(b.x)], 1u);
            asm volatile("s_waitcnt vmcnt(0)" ::: "memory");
        } else {
            XB_SPIN(xb_ld(&bar[XB_XGEN(b.x)]) == gen, bar);
            __builtin_amdgcn_fence(__ATOMIC_ACQUIRE, "agent");
            asm volatile("s_waitcnt vmcnt(0)" ::: "memory");
        }
    }
    __syncthreads();
}

typedef float f32x2 __attribute__((ext_vector_type(2)));
__device__ __forceinline__ f32x2 silu2(f32x2 x) { const f32x2 t = x * (-1.4426950408889634f); f32x2 e; e.x = __builtin_amdgcn_exp2f(t.x); e.y = __builtin_amdgcn_exp2f(t.y);
    const f32x2 d = e + 1.0f; f32x2 r; r.x = __builtin_amdgcn_rcpf(d.x); r.y = __builtin_amdgcn_rcpf(d.y); return x * r; }
__device__ __forceinline__ f32x2 gelu2(f32x2 x) { const f32x2 p = (x * x) * 0.10294324f + 2.3022082f; const f32x2 w = p * x; f32x2 e; e.x = __builtin_amdgcn_exp2f(w.x); e.y = __builtin_amdgcn_exp2f(w.y);
    const f32x2 d = e + 1.0f; f32x2 r; r.x = __builtin_amdgcn_rcpf(d.x); r.y = __builtin_amdgcn_rcpf(d.y); return x - x * r; }
#define LDS_WAIT() asm volatile("s_waitcnt lgkmcnt(0)" ::: "memory")
#define MFMA16(a, b, c) __builtin_amdgcn_mfma_f32_16x16x32_bf16((a), (b), (c), 0, 0, 0)

struct Args {
    const float* in[21];
    float* out; unsigned char* ws;
};
typedef const Args __attribute__((address_space(4)))* ArgsP;
enum { I_X = 0, I_NMG, I_WIN, I_CONVW, I_CONVB, I_WQ, I_WK, I_WV, I_IB, I_FB, I_MNG, I_SKIP, I_RNG, I_GNG, I_GWS, I_GBS, I_WOUT, I_NFG, I_WFF1, I_WFF2, I_FNG };

__device__ __forceinline__ void transpose_item(const float* W, int ldw, int col_src0, int nvalid, const float* gk, int K, bf16* WT, int n0, int k0, LAS float* scr, int lane) {
    float vv[32];
    const bool val = (lane & 31) < nvalid;
    const float* wp = W + (size_t)(k0 + (lane >> 5)) * ldw + col_src0 + (lane & 31);
#pragma unroll
    for (int i = 0; i < 32; ++i) vv[i] = val ? wp[(size_t)(2 * i) * ldw] : 0.f;
    if (gk) {
        const float* gp = gk + k0 + (lane >> 5);
#pragma unroll
        for (int i = 0; i < 32; ++i) vv[i] *= gp[2 * i];
    }
#pragma unroll
    for (int i = 0; i < 32; ++i) scr[(2 * i + (lane >> 5)) * 33 + (lane & 31)] = vv[i];
    LDS_WAIT(); asm volatile("" ::: "memory");
    const int c = lane & 7;
#pragma unroll
    for (int j = 0; j < 4; ++j) { const int n = (lane >> 3) + 8 * j; const LAS float* s = scr + (8 * c) * 33 + n;
        v4u o; o.x = pk2(s[0 * 33], s[1 * 33]); o.y = pk2(s[2 * 33], s[3 * 33]); o.z = pk2(s[4 * 33], s[5 * 33]); o.w = pk2(s[6 * 33], s[7 * 33]);
        *(v4u*)(WT + (size_t)(n0 + n) * K + k0 + 8 * c) = o; }
    LDS_WAIT(); asm volatile("" ::: "memory");
}

__device__ __forceinline__ void convert_weights(ArgsP a, int L, size_t wb, ldsp lds, int lane, int wave) {
    LAS float* scr = (LAS float*)(lds + 32768 + wave * 8448);
    const int gw = blockIdx.x * NWAVES + wave, NGW = gridDim.x * NWAVES;
    constexpr int I_IN = (DM / 64) * (NPAD / 32), I_O = (DM / 64) * (DM / 32), I_1 = (DM / 64) * (DFF / 32), I_2 = (DFF / 64) * (DM / 32);
    constexpr int NITEMS = I_IN + I_O + I_1 + I_2;
    unsigned char* ws = a->ws + wb;
    for (int it = gw; it < NITEMS; it += NGW) {
        int r = it;
        if (r < I_IN) { const int nblk = NPAD / 32, kb = r / nblk, nb = r % nblk, n0 = nb * 32;
            const int src = nb < 88 ? n0 + (n0 >= 768 ? 8 : 0) : 768, nv = nb < 88 ? 32 : (nb == 88 ? 8 : 0);
            transpose_item(a->in[I_WIN] + (size_t)L * DM * N_IN, N_IN, src, nv, a->in[I_NMG] + (size_t)L * DM, DM, (bf16*)(ws + WS_WIN), n0, kb * 64, scr, lane); continue; } r -= I_IN;
        if (r < I_O) { const int nblk = DM / 32, kb = r / nblk, nb = r % nblk; transpose_item(a->in[I_WOUT] + (size_t)L * DM * DM, DM, nb * 32, 32, nullptr, DM, (bf16*)(ws + WS_WOUT), nb * 32, kb * 64, scr, lane); continue; } r -= I_O;
        if (r < I_1) { const int nblk = DFF / 32, kb = r / nblk, nb = r % nblk; transpose_item(a->in[I_WFF1] + (size_t)L * DM * DFF, DFF, nb * 32, 32, a->in[I_NFG] + (size_t)L * DM, DM, (bf16*)(ws + WS_W1), nb * 32, kb * 64, scr, lane); continue; } r -= I_1;
        { const int nblk = DM / 32, kb = r / nblk, nb = r % nblk; transpose_item(a->in[I_WFF2] + (size_t)L * DFF * DM, DM, nb * 32, 32, nullptr, DFF, (bf16*)(ws + WS_W2), nb * 32, kb * 64, scr, lane); }
    }
}

template <bool GATES>
__device__ __forceinline__ void norm_rows(const float* x, const float* g, bf16* h, const LAS float* wgT, const float* ib, const float* fb, float* gates, int lane, int wave, const float* xP, float* wb) {
    const int gw = blockIdx.x * NWAVES + wave, NGW = gridDim.x * NWAVES;
    f32x4 gv[4];
#pragma unroll
    for (int j = 0; j < 4; ++j) gv[j] = ((const f32x4*)g)[lane + 64 * j];
    for (int m = gw; m < MTOK; m += NGW) {
        const bool p0 = xP != nullptr && (m & (SEQ - 1)) == 0;
        const f32x4* xr = (const f32x4*)(p0 ? xP + (size_t)(m >> 12) * DM : x + (size_t)m * DM) + lane;
        f32x4 v[4]; float ss = 0.f;
#pragma unroll
        for (int j = 0; j < 4; ++j) { v[j] = xr[64 * j]; ss += (v[j].x * v[j].x + v[j].y * v[j].y) + (v[j].z * v[j].z + v[j].w * v[j].w); }
        if (p0 && wb != nullptr) {
#pragma unroll
            for (int j = 0; j < 4; ++j) ((f32x4*)(wb + (size_t)m * DM) + lane)[64 * j] = v[j]; }
        const float rstd = rsqrtf(wave_sum(ss) * (1.f / DM) + EPS);
        unsigned long long* o8 = (unsigned long long*)(h + (size_t)m * DM) + lane;
#pragma unroll
        for (int j = 0; j < 4; ++j) { v[j] = v[j] * rstd * gv[j]; o8[64 * j] = (unsigned long long)pk2(v[j].x, v[j].y) | ((unsigned long long)pk2(v[j].z, v[j].w) << 32); }
        if (GATES) {
            float mine = 0.f;
#pragma unroll
            for (int c = 0; c < 8; ++c) {
                float p = 0.f;
#pragma unroll
                for (int j = 0; j < 4; ++j) { const f32x4 w = *(const LAS f32x4*)(wgT + c * 1024 + 4 * lane + 256 * j); p += (v[j].x * w.x + v[j].y * w.y) + (v[j].z * w.z + v[j].w * w.w); }
                p = wave_sum(p);
                if (lane == c) mine = p;
            }
            if (lane < 8) gates[(size_t)m * 8 + lane] = mine + (lane < 4 ? ib[lane] : fb[lane - 4]);
        }
    }
}

__device__ __forceinline__ float log_sigmoid_f(float f) { return fminf(f, 0.f) - __logf(1.f + __expf(-fabsf(f))); }
__device__ __forceinline__ void gates_cumsum(float f0, float f1, float& b0, float& b1, int lane) {
    const float l0 = log_sigmoid_f(f0), l1 = log_sigmoid_f(f1);
    float p = l0 + l1;
#pragma unroll
    for (int o = 1; o < 64; o <<= 1) { const float u = __shfl_up(p, o); if (lane >= o) p += u; }
    b1 = p; b0 = p - l1;
}
__device__ __forceinline__ void gates_prefmax(float g0, float g1, float& m0, float& m1, int lane) {
    float q = fmaxf(g0, g1);
#pragma unroll
    for (int o = 1; o < 64; o <<= 1) { const float u = __shfl_up(q, o); if (lane >= o) q = fmaxf(q, u); }
    const float ex = __shfl_up(q, 1);
    m1 = q; m0 = lane == 0 ? g0 : fmaxf(ex, g0);
}

struct MStage { f32x4 cw[4]; f32x4 cb; f32x4 wq[4], wk[4], wv[4]; v2u xr[11]; };
template <bool FULL>
__device__ __forceinline__ void mlstm_stage_load(ArgsP a, int L, int h, int t0, int s0, int tid, MStage& R) {
    if (tid < 384) {
        const bf16* proj = (const bf16*)(a->ws + WS_PROJ);
        const int blk = tid % 24, rg = tid / 24, l0 = rg * 8;
        const int ch0 = h * 96 + blk * 4, nb = h * 24 + blk;
#pragma unroll
        for (int r = 0; r < 11; ++r) { const int l = l0 - 3 + r;
            if (s0 + l >= 0) R.xr[r] = *(const v2u*)(proj + (size_t)(t0 + l) * NP + PC_MX + ch0); else R.xr[r] = (v2u){0u, 0u}; }
#pragma unroll
        for (int j = 0; j < 4; ++j) R.cw[j] = *(const f32x4*)(a->in[I_CONVW] + (size_t)L * 4 * 384 + j * 384 + ch0);
        R.cb = *(const f32x4*)(a->in[I_CONVB] + (size_t)L * 384 + ch0);
#pragma unroll
        for (int i = 0; i < 4; ++i) {
            R.wk[i] = *(const f32x4*)(a->in[I_WK] + ((size_t)L * 96 + nb) * 16 + i * 4);
            R.wv[i] = *(const f32x4*)(a->in[I_WV] + ((size_t)L * 96 + nb) * 16 + i * 4);
            if (FULL) R.wq[i] = *(const f32x4*)(a->in[I_WQ] + ((size_t)L * 96 + nb) * 16 + i * 4);
        }
    }
}
template <bool FULL>
__device__ __forceinline__ void mlstm_stage_compute(const MStage& R, ldsp XC, ldsp Q, ldsp K, ldsp VT, const LAS float* eend, int tid) {
    if (tid < 384) {
        const int blk = tid % 24, rg = tid / 24, l0 = rg * 8;
        f32x4 xm[11];
#pragma unroll
        for (int r = 0; r < 11; ++r) xm[r] = (f32x4){bflo(R.xr[r].x), bfhi(R.xr[r].x), bflo(R.xr[r].y), bfhi(R.xr[r].y)};
        const float kscale = 0.10206207261596575f;
        unsigned vpk[4][4], kpk[4][4];
        float vprev[4], kprev[4];
#pragma unroll
        for (int li = 0; li < 8; ++li) {
            f32x4 xc = R.cb;
#pragma unroll
            for (int j = 0; j < 4; ++j) xc = xc + R.cw[j] * xm[li + j];
            { const f32x2 s01 = silu2((f32x2){xc.x, xc.y}), s23 = silu2((f32x2){xc.z, xc.w}); xc = (f32x4){s01.x, s01.y, s23.x, s23.y}; }
            const f32x4 xr = xm[li + 3];
            f32x4 kk = (xc.x * R.wk[0] + xc.y * R.wk[1]) + (xc.z * R.wk[2] + xc.w * R.wk[3]);
            const f32x4 vv = (xr.x * R.wv[0] + xr.y * R.wv[1]) + (xr.z * R.wv[2] + xr.w * R.wv[3]);
            const int l = l0 + li;
            if (FULL) {
                const f32x4 qq = (xc.x * R.wq[0] + xc.y * R.wq[1]) + (xc.z * R.wq[2] + xc.w * R.wq[3]);
                kk = kk * kscale;
                *(LAS v2u*)(XC + l * 192 + blk * 8) = (v2u){pk2(xc.x, xc.y), pk2(xc.z, xc.w)};
                *(LAS v2u*)(Q + l * 208 + blk * 8) = (v2u){pk2(qq.x, qq.y), pk2(qq.z, qq.w)};
                *(LAS v2u*)(K + l * 208 + blk * 8) = (v2u){pk2(kk.x, kk.y), pk2(kk.z, kk.w)};
            } else {
                kk = kk * (kscale * eend[l]);
            }
            if (li & 1) {
#pragma unroll
                for (int jj = 0; jj < 4; ++jj) { vpk[jj][li >> 1] = pk2(vprev[jj], vv[jj]); if (!FULL) kpk[jj][li >> 1] = pk2(kprev[jj], kk[jj]); }
            } else {
#pragma unroll
                for (int jj = 0; jj < 4; ++jj) { vprev[jj] = vv[jj]; kprev[jj] = kk[jj]; }
            }
        }
#pragma unroll
        for (int jj = 0; jj < 4; ++jj) {
            *(LAS v4u*)(VT + (blk * 4 + jj) * 272 + l0 * 2) = (v4u){vpk[jj][0], vpk[jj][1], vpk[jj][2], vpk[jj][3]};
            if (!FULL) *(LAS v4u*)(K + (blk * 4 + jj) * 272 + l0 * 2) = (v4u){kpk[jj][0], kpk[jj][1], kpk[jj][2], kpk[jj][3]};
        }
    }
}

__device__ __forceinline__ void fill_vt_tail(ldsp VT, int tid) {
    if (tid < 384) return;
    const int i = tid - 384;
#pragma unroll
    for (int r = 0; r < 2; ++r) { const int idx = i + 128 * r;
        const int row = idx >> 4, c16 = idx & 15; unsigned w = row == 0 ? 0x3f803f80u : 0u; asm volatile("" : "+v"(w));
        *(LAS v4u*)(VT + (96 + row) * 272 + c16 * 16) = (v4u){w, w, w, w}; }
}

__device__ __forceinline__ void phaseC_mlstm(ArgsP a, int L, int item, ldsp lds, int tid, int lane, int wave) {
    const int bh = item >> 5, c = item & 31, b = bh >> 2, h = bh & 3;
    const int t0 = b * SEQ + c * 128, s0 = c * 128;
    ldsp EKT = lds, VT = lds + 26112;
    LAS float* eend = (LAS float*)(lds + 56576);
    const float* gates = (const float*)(a->ws + WS_GATES);
    float* scal = (float*)(a->ws + WS_SCAL);
    float i0 = 0.f, i1 = 0.f, f0 = 0.f, f1 = 0.f;
    if (wave == 7) { const float* gp = gates + (size_t)(t0 + 2 * lane) * 8; i0 = gp[h]; f0 = gp[4 + h]; i1 = gp[8 + h]; f1 = gp[12 + h]; }
    MStage R; mlstm_stage_load<false>(a, L, h, t0, s0, tid, R);
    if (wave == 7) {
        float b0, b1; gates_cumsum(f0, f1, b0, b1, lane);
        const float b_end = __shfl(b1, 63);
        const float w0 = b_end - b0 + i0, w1 = b_end - b1 + i1;
        float mx = fmaxf(w0, w1);
#pragma unroll
        for (int o = 1; o < 64; o <<= 1) mx = fmaxf(mx, __shfl_xor(mx, o));
        eend[2 * lane] = __expf(w0 - mx); eend[2 * lane + 1] = __expf(w1 - mx);
        if (lane == 0) { scal[item] = b_end; scal[512 + item] = mx; }
    }
    fill_vt_tail(VT, tid);
    __syncthreads();
    mlstm_stage_compute<false>(R, lds, lds, EKT, VT, eend, tid);
    __syncthreads();
    float* st = (float*)(a->ws + WS_MST) + (size_t)item * NE_M;
    const int fr = lane & 15, fq = lane >> 4;
#pragma unroll
    for (int ti = 0; ti < 6; ++ti) { const int tile = wave + 8 * ti; if (tile >= 42) break;
        const int et = tile / 6, dt = tile % 6;
        f32x4 acc = {0.f, 0.f, 0.f, 0.f};
#pragma unroll
        for (int ks = 0; ks < 4; ++ks) {
            const bf16x8 av = *(const LAS bf16x8*)(VT + (et * 16 + fr) * 272 + ks * 64 + fq * 16);
            const bf16x8 bv = *(const LAS bf16x8*)(EKT + (dt * 16 + fr) * 272 + ks * 64 + fq * 16);
            acc = MFMA16(av, bv, acc);
        }
#pragma unroll
        for (int j = 0; j < 4; ++j) { const int e = et * 16 + fq * 4 + j; if (e < 97) st[e * 96 + dt * 16 + fr] = acc[j]; }
    }
    __syncthreads();
}

__device__ __forceinline__ float ret_log_gamma(int h) { return __logf(1.f - exp2f(-5.f - (float)h)); }

__device__ __forceinline__ void rotary16(const bf16* rowp, const float* cs, const float* sn, int j0, float scale, v4u& o1, v4u& o2) {
    const v4u u1 = *(const v4u*)(rowp + j0), u2 = *(const v4u*)(rowp + 32 + j0);
    const f32x4 c0 = *(const f32x4*)(cs + j0), c1 = *(const f32x4*)(cs + j0 + 4), s0 = *(const f32x4*)(sn + j0), s1 = *(const f32x4*)(sn + j0 + 4);
    float x1[8] = {bflo(u1.x), bfhi(u1.x), bflo(u1.y), bfhi(u1.y), bflo(u1.z), bfhi(u1.z), bflo(u1.w), bfhi(u1.w)};
    float x2[8] = {bflo(u2.x), bfhi(u2.x), bflo(u2.y), bfhi(u2.y), bflo(u2.z), bfhi(u2.z), bflo(u2.w), bfhi(u2.w)};
    float cc[8] = {c0.x, c0.y, c0.z, c0.w, c1.x, c1.y, c1.z, c1.w}, ss[8] = {s0.x, s0.y, s0.z, s0.w, s1.x, s1.y, s1.z, s1.w};
    float y1[8], y2[8];
#pragma unroll
    for (int i = 0; i < 8; ++i) { y1[i] = (x1[i] * cc[i] - x2[i] * ss[i]) * scale; y2[i] = (x2[i] * cc[i] + x1[i] * ss[i]) * scale; }
    o1 = (v4u){pk2(y1[0], y1[1]), pk2(y1[2], y1[3]), pk2(y1[4], y1[5]), pk2(y1[6], y1[7])};
    o2 = (v4u){pk2(y2[0], y2[1]), pk2(y2[2], y2[3]), pk2(y2[4], y2[5]), pk2(y2[6], y2[7])};
}

__device__ __forceinline__ void store_T8(ldsp dst, int e0, int stride, int l, v4u u) {
    const unsigned w[4] = {u.x, u.y, u.z, u.w};
#pragma unroll
    for (int i = 0; i < 4; ++i) {
        *(LAS unsigned short*)(dst + (e0 + 2 * i) * stride + l * 2) = (unsigned short)(w[i] & 0xffffu);
        *(LAS unsigned short*)(dst + (e0 + 2 * i + 1) * stride + l * 2) = (unsigned short)(w[i] >> 16);
    }
}

__device__ __forceinline__ void phaseC_ret(ArgsP a, int L, int item, ldsp lds, int tid, int lane, int wave) {
    const int bh = item >> 5, c = item & 31, b = bh / 6, h = bh % 6;
    const int t0 = b * SEQ + c * 128, s0 = c * 128;
    ldsp ZKT = lds, VT = lds + 17408;
    const bf16* proj = (const bf16*)(a->ws + WS_PROJ);
    const float* rope = (const float*)(a->ws + WS_ROPE);
    const float lg = ret_log_gamma(h);
    {
        const int l = tid >> 2, jc = tid & 3, j0 = jc * 8;
        const float zeta = __expf((127.f - (float)l) * lg);
        v4u o1, o2;
        rotary16(proj + (size_t)(t0 + l) * NP + PC_RK + h * 64, rope + (size_t)(s0 + l) * 32, rope + 4096 * 32 + (size_t)(s0 + l) * 32, j0, 0.125f * zeta, o1, o2);
        store_T8(ZKT, j0, 272, l, o1); store_T8(ZKT, 32 + j0, 272, l, o2);
        const bf16* vp = proj + (size_t)(t0 + l) * NP + PC_RV + h * 64 + jc * 16;
        const v4u v0 = *(const v4u*)vp, v1 = *(const v4u*)(vp + 8);
        store_T8(VT, jc * 16, 272, l, v0); store_T8(VT, jc * 16 + 8, 272, l, v1);
    }
    __syncthreads();
    float* st = (float*)(a->ws + WS_RST) + (size_t)item * NE_R;
    const int fr = lane & 15, fq = lane >> 4;
#pragma unroll
    for (int tt = 0; tt < 2; ++tt) {
        const int tile = wave * 2 + tt, et = tile >> 2, dt = tile & 3;
        f32x4 acc = {0.f, 0.f, 0.f, 0.f};
#pragma unroll
        for (int ks = 0; ks < 4; ++ks) {
            const bf16x8 av = *(const LAS bf16x8*)(VT + (et * 16 + fr) * 272 + ks * 64 + fq * 16);
            const bf16x8 bv = *(const LAS bf16x8*)(ZKT + (dt * 16 + fr) * 272 + ks * 64 + fq * 16);
            acc = MFMA16(av, bv, acc);
        }
#pragma unroll
        for (int j = 0; j < 4; ++j) st[(et * 16 + fq * 4 + j) * 64 + dt * 16 + fr] = acc[j];
    }
    __syncthreads();
}

__device__ __forceinline__ void phaseC_gmlp(ArgsP a, int L, int item, ldsp lds, int tid, int lane, int wave) {
    const int gp = item & 1, bc = item >> 1, b = bc >> 5, c = bc & 31;
    const int t0 = b * SEQ + c * 128;
    ldsp W = lds, GVT = lds + 34816;
    const bf16* proj = (const bf16*)(a->ws + WS_PROJ);
    bf16* cat = (bf16*)(a->ws + WS_CAT);
    const int l = tid >> 2, part = tid & 3;
    const bf16* vp = proj + (size_t)(t0 + l) * NP + PC_GV;
    float rstd;
    {
        float ss = 0.f;
#pragma unroll
        for (int i = 0; i < 8; ++i) { const v4u u = *(const v4u*)(vp + part * 64 + i * 8); const unsigned w[4] = {u.x, u.y, u.z, u.w};
#pragma unroll
            for (int q = 0; q < 4; ++q) { const f32x2 g = gelu2((f32x2){bflo(w[q]), bfhi(w[q])}); ss += g.x * g.x + g.y * g.y; } }
        ss += __shfl_xor(ss, 1); ss += __shfl_xor(ss, 2);
        rstd = rsqrtf(ss * (1.f / 256.f) + EPS);
    }
#pragma unroll
    for (int gi = 0; gi < 2; ++gi) {
        const int g = 2 * gp + gi;
        {
            const float* gn = a->in[I_GNG] + (size_t)L * 256 + g * 64 + part * 16;
#pragma unroll
            for (int i = 0; i < 2; ++i) { const v4u u = *(const v4u*)(vp + g * 64 + part * 16 + i * 8); const unsigned w[4] = {u.x, u.y, u.z, u.w}; unsigned o[4];
#pragma unroll
                for (int q = 0; q < 4; ++q) { const f32x2 gg = gelu2((f32x2){bflo(w[q]), bfhi(w[q])}) * rstd; o[q] = pk2(gg.x * gn[i * 8 + 2 * q], gg.y * gn[i * 8 + 2 * q + 1]); }
                store_T8(GVT, part * 16 + i * 8, 272, l, (v4u){o[0], o[1], o[2], o[3]}); }
        }
        {
            const float* wsrc = a->in[I_GWS] + ((size_t)L * 4 + g) * 128 * 128;
#pragma unroll
            for (int i = 0; i < 8; ++i) { const int idx4 = tid + 512 * i, t = idx4 >> 5, s4 = (idx4 & 31) * 4;
                f32x4 w = *(const f32x4*)(wsrc + (size_t)t * 128 + s4);
                if (s4 + 0 > t) w.x = 0.f; if (s4 + 1 > t) w.y = 0.f; if (s4 + 2 > t) w.z = 0.f; if (s4 + 3 > t) w.w = 0.f;
                *(LAS v2u*)(W + t * 272 + s4 * 2) = (v2u){pk2(w.x, w.y), pk2(w.z, w.w)}; }
        }
        __syncthreads();
        const int fr = lane & 15, fq = lane >> 4;
        const float* bs = a->in[I_GBS] + ((size_t)L * 4 + g) * 128;
        float bbv[4]; unsigned short uv[4][4];
#pragma unroll
        for (int j = 0; j < 4; ++j) { bbv[j] = bs[wave * 16 + fq * 4 + j];
#pragma unroll
            for (int n = 0; n < 4; ++n) uv[j][n] = proj[(size_t)(t0 + wave * 16 + fq * 4 + j) * NP + PC_GU + g * 64 + n * 16 + fr]; }
        f32x4 acc[4];
#pragma unroll
        for (int n = 0; n < 4; ++n) acc[n] = (f32x4){0.f, 0.f, 0.f, 0.f};
#pragma unroll
        for (int ks = 0; ks < 4; ++ks) {
            if (ks * 32 <= wave * 16 + 15) {
                const bf16x8 av = *(const LAS bf16x8*)(W + (wave * 16 + fr) * 272 + ks * 64 + fq * 16);
#pragma unroll
                for (int n = 0; n < 4; ++n) { const bf16x8 bv = *(const LAS bf16x8*)(GVT + (n * 16 + fr) * 272 + ks * 64 + fq * 16); acc[n] = MFMA16(av, bv, acc[n]); }
            }
        }
#pragma unroll
        for (int j = 0; j < 4; ++j) { const int t = wave * 16 + fq * 4 + j; const float bb = bbv[j];
#pragma unroll
            for (int n = 0; n < 4; n += 2) { const int e = n * 16 + fr;
                const f32x2 gu = gelu2((f32x2){bf2f(uv[j][n]), bf2f(uv[j][n + 1])});
                cat[(size_t)(t0 + t) * DM + CAT_G + g * 64 + e] = f2bf(gu.x * (acc[n][j] + bb));
                cat[(size_t)(t0 + t) * DM + CAT_G + g * 64 + e + 16] = f2bf(gu.y * (acc[n + 1][j] + bb)); } }
        __syncthreads();
    }
}

__device__ __forceinline__ void phaseD(ArgsP a, ldsp lds, int tid) {
    LAS float* so = (LAS float*)lds; LAS float* sn = so + 512;
    float* scal = (float*)(a->ws + WS_SCAL);
    const int gt = blockIdx.x * NTHR + tid, NT = gridDim.x * NTHR;
    constexpr int TOT_M = 16 * NE_M, TOT_R = 24 * NE_R;
    float v0[32]; float* p0 = nullptr; int bh0 = 0; float dec0 = 0.f; const bool m0 = gt < TOT_M;
    if (m0) { bh0 = gt / NE_M; p0 = (float*)(a->ws + WS_MST) + (size_t)bh0 * NCH * NE_M + (gt - bh0 * NE_M);
#pragma unroll
        for (int c = 0; c < 32; ++c) v0[c] = p0[(size_t)c * NE_M];
    } else if (gt < TOT_M + TOT_R) { const int j = gt - TOT_M; bh0 = j >> 12; dec0 = __expf(128.f * ret_log_gamma(bh0 % 6)); p0 = (float*)(a->ws + WS_RST) + (size_t)bh0 * NCH * NE_R + (j & 4095);
#pragma unroll
        for (int c = 0; c < 32; ++c) v0[c] = p0[(size_t)c * NE_R];
    }
    if (tid < 16) {
        float be[32], ac[32];
#pragma unroll
        for (int c = 0; c < 32; ++c) { be[c] = scal[tid * 32 + c]; ac[c] = scal[512 + tid * 32 + c]; }
        float m = 0.f;
#pragma unroll
        for (int c = 0; c < 32; ++c) { const float mn = fmaxf(be[c] + m, ac[c]); so[tid * 32 + c] = __expf(be[c] + m - mn); sn[tid * 32 + c] = __expf(ac[c] - mn);
            if (blockIdx.x == 0) scal[1024 + tid * 32 + c] = m; m = mn; }
    }
    __syncthreads();
    if (p0 != nullptr) {
        float st = 0.f;
        if (m0) {
#pragma unroll
            for (int c = 0; c < 32; ++c) { p0[(size_t)c * NE_M] = st; st = so[bh0 * 32 + c] * st + sn[bh0 * 32 + c] * v0[c]; }
        } else {
#pragma unroll
            for (int c = 0; c < 32; ++c) { p0[(size_t)c * NE_R] = st; st = dec0 * st + v0[c]; }
        }
    }
    for (int idx = gt + NT; idx < TOT_M + TOT_R; idx += NT) {
        float v[32];
        if (idx < TOT_M) {
            const int bh = idx / NE_M, e = idx - bh * NE_M;
            float* p = (float*)(a->ws + WS_MST) + (size_t)bh * NCH * NE_M + e;
#pragma unroll
            for (int c = 0; c < 32; ++c) v[c] = p[(size_t)c * NE_M];
            float st = 0.f;
#pragma unroll
            for (int c = 0; c < 32; ++c) { p[(size_t)c * NE_M] = st; st = so[bh * 32 + c] * st + sn[bh * 32 + c] * v[c]; }
        } else {
            const int j = idx - TOT_M, bh = j >> 12, e = j & 4095, h = bh % 6;
            const float dec = __expf(128.f * ret_log_gamma(h));
            float* p = (float*)(a->ws + WS_RST) + (size_t)bh * NCH * NE_R + e;
#pragma unroll
            for (int c = 0; c < 32; ++c) v[c] = p[(size_t)c * NE_R];
            float st = 0.f;
#pragma unroll
            for (int c = 0; c < 32; ++c) { p[(size_t)c * NE_R] = st; st = dec * st + v[c]; }
        }
    }
    __syncthreads();
}

__device__ __forceinline__ void phaseE_mlstm(ArgsP a, int L, int item, ldsp lds, int tid, int lane, int wave) {
    const int bh = item >> 5, c = item & 31, b = bh >> 2, h = bh & 3;
    const int t0 = b * SEQ + c * 128, s0 = c * 128;
    ldsp XC = lds, Q = lds + 24576, K = lds + 51200, VT = lds + 77824, SC = lds + 108288, CT = SC;
    LAS float* fl = (LAS float*)(lds + 143104);
    LAS float* bcum = fl, *gsv = fl + 256, *mmv = fl + 384;
    const float* gates = (const float*)(a->ws + WS_GATES);
    const float* scal = (const float*)(a->ws + WS_SCAL);
    const bf16* proj = (const bf16*)(a->ws + WS_PROJ);
    bf16* cat = (bf16*)(a->ws + WS_CAT);
    const float m_prev = scal[1024 + item];
    float i0 = 0.f, i1 = 0.f, f0 = 0.f, f1 = 0.f;
    if (wave == 7) { const float* gp = gates + (size_t)(t0 + 2 * lane) * 8; i0 = gp[h]; f0 = gp[4 + h]; i1 = gp[8 + h]; f1 = gp[12 + h]; }
    MStage R; mlstm_stage_load<true>(a, L, h, t0, s0, tid, R);
    f32x4 ctv[6];
    {   const float* st = (const float*)(a->ws + WS_MST) + (size_t)item * NE_M;
#pragma unroll
        for (int i = 0; i < 6; ++i) { const int idx4 = tid + 512 * i, e = idx4 / 24, d4 = (idx4 % 24) * 4;
            ctv[i] = (f32x4){0.f, 0.f, 0.f, 0.f}; if (e < 97) ctv[i] = *(const f32x4*)(st + e * 96 + d4); } }
    if (wave == 7) {
        float b0, b1; gates_cumsum(f0, f1, b0, b1, lane);
        const float g0 = i0 - b0, g1 = i1 - b1; float p0, p1; gates_prefmax(g0, g1, p0, p1, lane);
        bcum[2 * lane] = b0; bcum[2 * lane + 1] = b1; gsv[2 * lane] = g0; gsv[2 * lane + 1] = g1;
        mmv[2 * lane] = fmaxf(m_prev, p0); mmv[2 * lane + 1] = fmaxf(m_prev, p1);
    }
    mlstm_stage_compute<true>(R, XC, Q, K, VT, nullptr, tid);
    fill_vt_tail(VT, tid);
#pragma unroll
    for (int i = 0; i < 6; ++i) { const int idx4 = tid + 512 * i, e = idx4 / 24, d4 = (idx4 % 24) * 4;
        if (idx4 < 112 * 24) *(LAS v2u*)(CT + e * 208 + d4 * 2) = (v2u){pk2(ctv[i].x, ctv[i].y), pk2(ctv[i].z, ctv[i].w)}; }
    __syncthreads();
    const int fr = lane & 15, fq = lane >> 4;
    const float* mng = a->in[I_MNG] + (size_t)L * 384 + h * 96;
    const float* skp = a->in[I_SKIP] + (size_t)L * 384 + h * 96;
    float gcol[6], scol[6];
#pragma unroll
    for (int n = 0; n < 6; ++n) { gcol[n] = mng[n * 16 + fr]; scol[n] = skp[n * 16 + fr]; }
    v4u zc[3];
#pragma unroll
    for (int i = 0; i < 3; ++i) { const int q = lane + 64 * i, r = q / 12, cc = q % 12; zc[i] = *(const v4u*)(proj + (size_t)(t0 + wave * 16 + r) * NP + PC_MZ + h * 96 + cc * 8); }
    bf16x8 aq[3];
#pragma unroll
    for (int ks = 0; ks < 3; ++ks) aq[ks] = *(const LAS bf16x8*)(Q + (wave * 16 + fr) * 208 + ks * 64 + fq * 16);
    f32x4 acc2[7];
#pragma unroll
    for (int n = 0; n < 7; ++n) { acc2[n] = (f32x4){0.f, 0.f, 0.f, 0.f};
#pragma unroll
        for (int ks = 0; ks < 3; ++ks) { const bf16x8 bv = *(const LAS bf16x8*)(CT + (n * 16 + fr) * 208 + ks * 64 + fq * 16); acc2[n] = MFMA16(aq[ks], bv, acc2[n]); } }
    f32x4 sacc[8];
#pragma unroll
    for (int st = 0; st < 8; ++st) { sacc[st] = (f32x4){0.f, 0.f, 0.f, 0.f};
        if (st <= wave) {
#pragma unroll
            for (int ks = 0; ks < 3; ++ks) { const bf16x8 bv = *(const LAS bf16x8*)(K + (st * 16 + fr) * 208 + ks * 64 + fq * 16); sacc[st] = MFMA16(aq[ks], bv, sacc[st]); } } }
    float mmr[4];
#pragma unroll
    for (int j = 0; j < 4; ++j) mmr[j] = mmv[wave * 16 + fq * 4 + j];
    __syncthreads();
#pragma unroll
    for (int st = 0; st < 8; ++st) {
        if (st <= (wave | 1)) {
            const int s = st * 16 + fr; const float gsl = gsv[s];
#pragma unroll
            for (int j = 0; j < 4; ++j) { const int l = wave * 16 + fq * 4 + j;
                const float wgt = (s <= l) ? __expf(gsl - mmr[j]) : 0.f;
                *(LAS unsigned short*)(SC + l * 272 + s * 2) = f2bf(sacc[st][j] * wgt); }
        }
    }
    asm volatile("" ::: "memory");
    f32x4 acc1[7];
#pragma unroll
    for (int n = 0; n < 7; ++n) acc1[n] = (f32x4){0.f, 0.f, 0.f, 0.f};
#pragma unroll
    for (int ks = 0; ks < 4; ++ks) {
        if (ks * 2 <= wave) {
            const bf16x8 av = *(const LAS bf16x8*)(SC + (wave * 16 + fr) * 272 + ks * 64 + fq * 16);
#pragma unroll
            for (int n = 0; n < 7; ++n) { const bf16x8 bv = *(const LAS bf16x8*)(VT + (n * 16 + fr) * 272 + ks * 64 + fq * 16); acc1[n] = MFMA16(av, bv, acc1[n]); }
        }
    }
#pragma unroll
    for (int i = 0; i < 3; ++i) { const int q = lane + 64 * i, r = q / 12, cc = q % 12; *(LAS v4u*)(Q + (wave * 16 + r) * 208 + cc * 16) = zc[i]; }
#pragma unroll
    for (int j = 0; j < 4; ++j) {
        const int l = wave * 16 + fq * 4 + j;
        const float sint = __expf(m_prev - mmr[j]);
        float den = acc1[6][j] + sint * acc2[6][j];
        den = __shfl(den, lane & 48);
        const float flo = __expf(-(bcum[l] + mmr[j]));
        const float inv = fast_rcp(fmaxf(fabsf(den), flo));
        float hv[6]; float ss = 0.f;
#pragma unroll
        for (int n = 0; n < 6; ++n) { hv[n] = (acc1[n][j] + sint * acc2[n][j]) * inv; ss += hv[n] * hv[n]; }
        ss += __shfl_xor(ss, 1); ss += __shfl_xor(ss, 2); ss += __shfl_xor(ss, 4); ss += __shfl_xor(ss, 8);
        const float rstd = rsqrtf(ss * (1.f / 96.f) + EPS);
#pragma unroll
        for (int n = 0; n < 6; n += 2) { const int e = n * 16 + fr;
            const float xc0 = bf2f(*(const LAS unsigned short*)(XC + l * 192 + e * 2)), xc1 = bf2f(*(const LAS unsigned short*)(XC + l * 192 + (e + 16) * 2));
            const f32x2 sz = silu2((f32x2){bf2f(*(const LAS unsigned short*)(Q + l * 208 + e * 2)), bf2f(*(const LAS unsigned short*)(Q + l * 208 + (e + 16) * 2))});
            *(LAS unsigned short*)(SC + l * 272 + e * 2) = f2bf((hv[n] * rstd * gcol[n] + scol[n] * xc0) * sz.x);
            *(LAS unsigned short*)(SC + l * 272 + (e + 16) * 2) = f2bf((hv[n + 1] * rstd * gcol[n + 1] + scol[n + 1] * xc1) * sz.y); }
    }
#pragma unroll
    for (int i = 0; i < 3; ++i) { const int q = lane + 64 * i, r = q / 12, cc = q % 12;
        *(v4u*)(cat + (size_t)(t0 + wave * 16 + r) * DM + h * 96 + cc * 8) = *(const LAS v4u*)(SC + (wave * 16 + r) * 272 + cc * 16); }
    __syncthreads();
}

__device__ __forceinline__ void phaseE_ret(ArgsP a, int L, int item, ldsp lds, int tid, int lane, int wave) {
    const int bh = item >> 5, c = item & 31, b = bh / 6, h = bh % 6;
    const int t0 = b * SEQ + c * 128, s0 = c * 128;
    ldsp Q = lds, K = lds + 18432, VT = lds + 36864, SC = lds + 54272, RT = lds + 89088;
    const bf16* proj = (const bf16*)(a->ws + WS_PROJ);
    const float* rope = (const float*)(a->ws + WS_ROPE);
    bf16* cat = (bf16*)(a->ws + WS_CAT);
    const float lg = ret_log_gamma(h);
    {
        const int l = tid >> 2, jc = tid & 3, j0 = jc * 8;
        const float* cs = rope + (size_t)(s0 + l) * 32; const float* sn = rope + 4096 * 32 + (size_t)(s0 + l) * 32;
        v4u o1, o2;
        rotary16(proj + (size_t)(t0 + l) * NP + PC_RQ + h * 64, cs, sn, j0, 1.f, o1, o2);
        *(LAS v4u*)(Q + l * 144 + j0 * 2) = o1; *(LAS v4u*)(Q + l * 144 + (32 + j0) * 2) = o2;
        rotary16(proj + (size_t)(t0 + l) * NP + PC_RK + h * 64, cs, sn, j0, 0.125f, o1, o2);
        *(LAS v4u*)(K + l * 144 + j0 * 2) = o1; *(LAS v4u*)(K + l * 144 + (32 + j0) * 2) = o2;
        const bf16* vp = proj + (size_t)(t0 + l) * NP + PC_RV + h * 64 + jc * 16;
        const v4u v0 = *(const v4u*)vp, v1 = *(const v4u*)(vp + 8);
        store_T8(VT, jc * 16, 272, l, v0); store_T8(VT, jc * 16 + 8, 272, l, v1);
        const float* st = (const float*)(a->ws + WS_RST) + (size_t)item * NE_R;
#pragma unroll
        for (int i = 0; i < 2; ++i) { const int idx4 = tid + 512 * i, e = idx4 >> 4, d4 = (idx4 & 15) * 4;
            const f32x4 w = *(const f32x4*)(st + e * 64 + d4);
            *(LAS v2u*)(RT + e * 144 + d4 * 2) = (v2u){pk2(w.x, w.y), pk2(w.z, w.w)}; }
    }
    __syncthreads();
    const int fr = lane & 15, fq = lane >> 4;
    const float* rng = a->in[I_RNG] + (size_t)L * 384 + h * 64;
    float gcol[4];
#pragma unroll
    for (int n = 0; n < 4; ++n) gcol[n] = rng[n * 16 + fr];
    v4u gc[2];
#pragma unroll
    for (int i = 0; i < 2; ++i) { const int q = lane + 64 * i, r = q >> 3, cc = q & 7; gc[i] = *(const v4u*)(proj + (size_t)(t0 + wave * 16 + r) * NP + PC_RG + h * 64 + cc * 8); }
    bf16x8 aq[2];
#pragma unroll
    for (int ks = 0; ks < 2; ++ks) aq[ks] = *(const LAS bf16x8*)(Q + (wave * 16 + fr) * 144 + ks * 64 + fq * 16);
    f32x4 acc2[4];
#pragma unroll
    for (int n = 0; n < 4; ++n) { acc2[n] = (f32x4){0.f, 0.f, 0.f, 0.f};
#pragma unroll
        for (int ks = 0; ks < 2; ++ks) { const bf16x8 bv = *(const LAS bf16x8*)(RT + (n * 16 + fr) * 144 + ks * 64 + fq * 16); acc2[n] = MFMA16(aq[ks], bv, acc2[n]); } }
    f32x4 sacc[8];
#pragma unroll
    for (int st = 0; st < 8; ++st) { sacc[st] = (f32x4){0.f, 0.f, 0.f, 0.f};
        if (st <= wave) {
#pragma unroll
            for (int ks = 0; ks < 2; ++ks) { const bf16x8 bv = *(const LAS bf16x8*)(K + (st * 16 + fr) * 144 + ks * 64 + fq * 16); sacc[st] = MFMA16(aq[ks], bv, sacc[st]); } } }
    float rowf[4];
#pragma unroll
    for (int j = 0; j < 4; ++j) rowf[j] = __expf((float)(fq * 4 + j - fr) * lg);
#pragma unroll
    for (int st = 0; st < 8; ++st) {
        if (st <= (wave | 1)) {
            const int s = st * 16 + fr; const float tf = __expf((float)((wave - st) * 16) * lg);
#pragma unroll
            for (int j = 0; j < 4; ++j) { const int l = wave * 16 + fq * 4 + j;
                const float wgt = (s <= l) ? rowf[j] * tf : 0.f;
                *(LAS unsigned short*)(SC + l * 272 + s * 2) = f2bf(sacc[st][j] * wgt); }
        }
    }
    asm volatile("" ::: "memory");
    f32x4 acc1[4];
#pragma unroll
    for (int n = 0; n < 4; ++n) acc1[n] = (f32x4){0.f, 0.f, 0.f, 0.f};
#pragma unroll
    for (int ks = 0; ks < 4; ++ks) {
        if (ks * 2 <= wave) {
            const bf16x8 av = *(const LAS bf16x8*)(SC + (wave * 16 + fr) * 272 + ks * 64 + fq * 16);
#pragma unroll
            for (int n = 0; n < 4; ++n) { const bf16x8 bv = *(const LAS bf16x8*)(VT + (n * 16 + fr) * 272 + ks * 64 + fq * 16); acc1[n] = MFMA16(av, bv, acc1[n]); }
        }
    }
#pragma unroll
    for (int i = 0; i < 2; ++i) { const int q = lane + 64 * i, r = q >> 3, cc = q & 7; *(LAS v4u*)(Q + (wave * 16 + r) * 144 + cc * 16) = gc[i]; }
#pragma unroll
    for (int j = 0; j < 4; ++j) {
        const int l = wave * 16 + fq * 4 + j;
        const float xi = __expf((float)(l + 1) * lg);
        float hv[4]; float ss = 0.f;
#pragma unroll
        for (int n = 0; n < 4; ++n) { hv[n] = acc1[n][j] + xi * acc2[n][j]; ss += hv[n] * hv[n]; }
        ss += __shfl_xor(ss, 1); ss += __shfl_xor(ss, 2); ss += __shfl_xor(ss, 4); ss += __shfl_xor(ss, 8);
        const float rstd = rsqrtf(ss * (1.f / 64.f) + EPS);
#pragma unroll
        for (int n = 0; n < 4; n += 2) { const int e = n * 16 + fr;
            const f32x2 sg = silu2((f32x2){bf2f(*(const LAS unsigned short*)(Q + l * 144 + e * 2)), bf2f(*(const LAS unsigned short*)(Q + l * 144 + (e + 16) * 2))});
            *(LAS unsigned short*)(SC + l * 272 + e * 2) = f2bf(hv[n] * rstd * gcol[n] * sg.x);
            *(LAS unsigned short*)(SC + l * 272 + (e + 16) * 2) = f2bf(hv[n + 1] * rstd * gcol[n + 1] * sg.y); }
    }
#pragma unroll
    for (int i = 0; i < 2; ++i) { const int q = lane + 64 * i, r = q >> 3, cc = q & 7;
        *(v4u*)(cat + (size_t)(t0 + wave * 16 + r) * DM + CAT_R + h * 64 + cc * 8) = *(const LAS v4u*)(SC + (wave * 16 + r) * 272 + cc * 16); }
    __syncthreads();
}


template <int MODE, int PER>
__device__ __forceinline__ void gemv4_item(const LAS float* A, const float* W, int ldw, int ncol0, int nvalid, int kb, float* out, int ldo, int ocol0, LAS float* red, int tid) {
    constexpr int klen = PER * 16, CH = PER < 32 ? PER : 32;
    const int kq = tid >> 5, c = tid & 31, k0 = kq * PER;
    float acc[4] = {0.f, 0.f, 0.f, 0.f};
    if (c < nvalid) {
        const float* wp = W + (size_t)(kb + k0) * ldw + ncol0 + c;
#pragma unroll
        for (int kk = 0; kk < PER; kk += CH) {
            float w[CH];
#pragma unroll
            for (int i = 0; i < CH; ++i) w[i] = wp[(size_t)(kk + i) * ldw];
#pragma unroll
            for (int i = 0; i < CH; ++i)
#pragma unroll
                for (int r = 0; r < 4; ++r) acc[r] += A[r * klen + k0 + kk + i] * w[i];
        }
    }
#pragma unroll
    for (int r = 0; r < 4; ++r) red[(kq * 4 + r) * 32 + c] = acc[r];
    __syncthreads();
    if (tid < 128) { const int r = tid >> 5; float s = 0.f;
#pragma unroll
        for (int q = 0; q < 16; ++q) s += red[(q * 4 + r) * 32 + c];
        if (c < nvalid) { float* o = out + (size_t)r * ldo + ocol0 + c;
            if (MODE == 0) *o = s; else if (MODE == 1) { const float t = fmaxf(s, 0.f); *o = t * t; } else atomicAdd(o, s); } }
    __syncthreads();
}
__device__ __forceinline__ void precise_norm_to_lds(const float* x0, size_t row_stride, const float* g, LAS float* A, int lane, int wave) {
    if (wave < 4) { const f32x4* xr = (const f32x4*)(x0 + (size_t)wave * row_stride) + lane; f32x4 v[4]; float ss = 0.f;
#pragma unroll
        for (int j = 0; j < 4; ++j) { v[j] = xr[64 * j]; ss += (v[j].x * v[j].x + v[j].y * v[j].y) + (v[j].z * v[j].z + v[j].w * v[j].w); }
        const float rstd = rsqrtf(wave_sum(ss) * (1.f / DM) + EPS);
#pragma unroll
        for (int j = 0; j < 4; ++j) { const f32x4 gv = ((const f32x4*)g)[lane + 64 * j]; *(LAS f32x4*)(A + wave * 1024 + 4 * lane + 256 * j) = v[j] * rstd * gv; } }
    __syncthreads();
}
__device__ __forceinline__ void lds_copy_rows(const float* src, int ld, int kb, int klen, LAS float* A, int tid) {
    for (int i = tid; i < 4 * klen; i += NTHR) { const int r = i / klen, k = i - r * klen; A[i] = src[(size_t)r * ld + kb + k]; }
    __syncthreads();
}
__device__ __forceinline__ void precise_mixer(ArgsP a, int L, int b, ldsp lds, int tid, int lane, int wave) {
    LAS float* XC = (LAS float*)lds, *XM = XC + 384, *Qs = XC + 768, *Ks = XC + 1152, *Vs = XC + 1536;
    const float* projP = (const float*)(a->ws + WS_PROJP); float* catP = (float*)(a->ws + WS_CATP);
    {
        const float* p = projP + (size_t)b * N_IN; float* o = catP + (size_t)b * DM;
        if (tid < 384) { const float x = p[tid]; XM[tid] = x; XC[tid] = silu_f(a->in[I_CONVW][(size_t)L * 4 * 384 + 3 * 384 + tid] * x + a->in[I_CONVB][(size_t)L * 384 + tid]); }
        __syncthreads();
        if (tid < 384) { const int nb = tid >> 2, j = tid & 3; float q = 0.f, k = 0.f, v = 0.f;
#pragma unroll
            for (int i = 0; i < 4; ++i) { const size_t wi = ((size_t)L * 96 + nb) * 16 + i * 4 + j; q += XC[nb * 4 + i] * a->in[I_WQ][wi]; k += XC[nb * 4 + i] * a->in[I_WK][wi]; v += XM[nb * 4 + i] * a->in[I_WV][wi]; }
            Qs[tid] = q; Ks[tid] = k * 0.10206207261596575f; Vs[tid] = v; }
        __syncthreads();
        if (wave < 4) {
            const int h = wave; const int d0 = h * 96 + lane, d1 = h * 96 + 64 + lane; const bool two = lane < 32;
            float s = Qs[d0] * Ks[d0] + (two ? Qs[d1] * Ks[d1] : 0.f); s = wave_sum(s);
            const float ig = p[768 + h] + a->in[I_IB][L * 4 + h], f = p[772 + h] + a->in[I_FB][L * 4 + h];
            const float logf = fminf(f, 0.f) - __logf(1.f + __expf(-fabsf(f)));
            const float mt = fmaxf(logf, ig), wts = __expf(ig - mt), den = s * wts, inv = 1.f / fmaxf(fabsf(den), __expf(-mt));
            const float h0 = den * Vs[d0] * inv, h1 = two ? den * Vs[d1] * inv : 0.f;
            const float rstd = rsqrtf(wave_sum(h0 * h0 + h1 * h1) * (1.f / 96.f) + EPS);
            const float* mg = a->in[I_MNG] + (size_t)L * 384; const float* sk = a->in[I_SKIP] + (size_t)L * 384;
            o[d0] = (h0 * rstd * mg[d0] + sk[d0] * XC[d0]) * silu_f(p[384 + d0]);
            if (two) o[d1] = (h1 * rstd * mg[d1] + sk[d1] * XC[d1]) * silu_f(p[384 + d1]);
        } else {
            for (int h = wave - 4; h < 6; h += 4) { const int d = h * 64 + lane;
                const float s = wave_sum(p[776 + d] * p[1160 + d]) * 0.125f; const float val = s * p[1544 + d];
                const float rstd = rsqrtf(wave_sum(val * val) * (1.f / 64.f) + EPS);
                o[CAT_R + d] = val * rstd * a->in[I_RNG][(size_t)L * 384 + d] * silu_f(p[1928 + d]); }
        }
        if (wave < 4) {
            const int g = wave; float gl[4]; float ss = 0.f;
#pragma unroll
            for (int i = 0; i < 4; ++i) { gl[i] = gelu_tanh(p[2568 + lane + 64 * i]); ss += gl[i] * gl[i]; }
            const float rstd = rsqrtf(wave_sum(ss) * (1.f / 256.f) + EPS);
            float gv = 0.f;
#pragma unroll
            for (int i = 0; i < 4; ++i) if (i == g) gv = gl[i];
            gv = gv * rstd * a->in[I_GNG][(size_t)L * 256 + g * 64 + lane];
            const float w00 = a->in[I_GWS][((size_t)L * 4 + g) * 128 * 128], b0 = a->in[I_GBS][((size_t)L * 4 + g) * 128];
            o[CAT_G + g * 64 + lane] = gelu_tanh(p[2312 + g * 64 + lane]) * (w00 * gv + b0);
        }
        __syncthreads();
    }
}

__global__ void __launch_bounds__(NTHR, 2) fwd_kernel(Args a_unused) {
    extern __shared__ __attribute__((aligned(16))) unsigned char lds_raw[];
    cg::grid_group grid = cg::this_grid();
    ldsp lds = (ldsp)lds_raw;
#define PHASE_BEGIN() int tid_o = threadIdx.x; asm volatile("" : "+v"(tid_o)); const int tid = tid_o, lane = tid & 63, wave = __builtin_amdgcn_readfirstlane(tid >> 6); (void)lane; (void)wave; \
    ArgsP a = (ArgsP)__builtin_amdgcn_kernarg_segment_ptr(); asm volatile("" : "+s"(a)); unsigned char* ws = a->ws; (void)ws; const int G = gridDim.x; (void)G;
    volatile LAS unsigned* MISC = (volatile LAS unsigned*)(lds + LDS_BYTES - 64);
    if (threadIdx.x < 16) MISC[threadIdx.x] = 0u;
    __syncthreads();
    { ArgsP a = (ArgsP)__builtin_amdgcn_kernarg_segment_ptr(); (void)xcd_barrier_post((unsigned*)(a->ws + WS_CTL), MISC); }
#define GRID_SYNC() do { ArgsP a_b = (ArgsP)__builtin_amdgcn_kernarg_segment_ptr(); asm volatile("" : "+s"(a_b)); XcdBarrier bar_; bar_.bar = (unsigned*)(a_b->ws + WS_CTL); bar_.x = xb_xcc_id(); \
        bar_.st = (volatile LAS unsigned*)(lds + LDS_BYTES - 64); xcd_barrier(bar_); } while (0)

    {
        PHASE_BEGIN();
        float* rope = (float*)(ws + WS_ROPE);
        for (int idx = blockIdx.x * NTHR + tid; idx < 4096 * 32; idx += G * NTHR) {
            const int pos = idx >> 5, j = idx & 31;
            const float freq = exp2f(-(float)j * (13.287712379549449f / 32.f));
            const double ang = (double)pos * (double)freq;
            double rev = ang * 0.15915494309189535; rev -= __builtin_rint(rev);
            const float fr = (float)rev;
            rope[idx] = __builtin_amdgcn_cosf(fr); rope[4096 * 32 + idx] = __builtin_amdgcn_sinf(fr);
        }
        {
            const int gw = blockIdx.x * NWAVES + wave, NGW = G * NWAVES;
            const float* x = a->in[I_X]; bf16* xb = (bf16*)(ws + WS_H); float* ssq = (float*)(ws + WS_SSQ);
            for (int m0 = gw; m0 < MTOK; m0 += 4 * NGW) {
                f32x4 v[4][4];
#pragma unroll
                for (int r = 0; r < 4; ++r) { const int m = m0 + r * NGW; if (m < MTOK) { const f32x4* xr = (const f32x4*)(x + (size_t)m * DM) + lane;
#pragma unroll
                    for (int j = 0; j < 4; ++j) v[r][j] = xr[64 * j]; } }
#pragma unroll
                for (int r = 0; r < 4; ++r) { const int m = m0 + r * NGW; if (m < MTOK) { float ss = 0.f;
#pragma unroll
                    for (int j = 0; j < 4; ++j) ss += (v[r][j].x * v[r][j].x + v[r][j].y * v[r][j].y) + (v[r][j].z * v[r][j].z + v[r][j].w * v[r][j].w);
                    ss = wave_sum(ss);
                    unsigned long long* o8 = (unsigned long long*)(xb + (size_t)m * DM) + lane;
#pragma unroll
                    for (int j = 0; j < 4; ++j) o8[64 * j] = (unsigned long long)pk2(v[r][j].x, v[r][j].y) | ((unsigned long long)pk2(v[r][j].z, v[r][j].w) << 32);
                    if (lane < 16) ssq[(size_t)m * 16 + lane] = lane == 0 ? ss : 0.f; } }
            }
        }
        convert_weights(a, 0, 0, lds, lane, wave);
        if (blockIdx.x == 0) { float* xP = (float*)(ws + WS_XP); for (int i = tid; i < 4 * DM; i += NTHR) xP[i] = a->in[I_X][(size_t)(i >> 10) * SEQ * DM + (i & 1023)]; }
    }
    { ArgsP a = (ArgsP)__builtin_amdgcn_kernarg_segment_ptr(); asm volatile("" : "+s"(a)); if (a->ws == nullptr) grid.sync(); }
    GRID_SYNC();

    for (int L = 0; L < DEPTH; ++L) {
        if ((int)blockIdx.x < 89) {
            PHASE_BEGIN();
            const float* xP = (const float*)(ws + WS_XP);
            LAS float* Ap = (LAS float*)(lds + 100352); LAS float* red = (LAS float*)(lds + 116736);
            precise_norm_to_lds(L == 0 ? a->in[I_X] : xP, L == 0 ? (size_t)SEQ * DM : (size_t)DM, a->in[I_NMG] + (size_t)L * DM, Ap, lane, wave);
            { const int cg_ = (int)blockIdx.x;
                gemv4_item<0, 64>(Ap, a->in[I_WIN] + (size_t)L * DM * N_IN, N_IN, cg_ * 32, cg_ == 88 ? 8 : 32, 0, (float*)(ws + WS_PROJP), N_IN, cg_ * 32, red, tid); }
        }
        {
            PHASE_BEGIN();
            const size_t wb = (L & 1) ? WS_WBUF1 : 0;
            pg8::Gemm g{(const bf16*)(ws + WS_H), (const bf16*)(ws + wb + WS_WIN), MTOK, NPAD, DM}; pg8::StaticOrder S; S.init(MTOK, NPAD, G, (int)blockIdx.x);
            pg8::EpiScaledBf16<0> E{(bf16*)(ws + WS_PROJ), NP, (const float*)(ws + WS_SSQ), 11, (float*)(ws + WS_GATES), a->in[I_IB] + L * 4, a->in[I_FB] + L * 4};
            for (int rep = 0; rep < 1 + XREP_B; ++rep) pg8::gemm_phase<pg8::EpiScaledBf16<0>, pg8::StaticOrder, GEMM_ALIGN, GEMM_SP2>(lds, g, S, E);
        }
        GRID_SYNC();
        if ((int)blockIdx.x >= (int)gridDim.x - 4) { PHASE_BEGIN(); precise_mixer(a, L, (int)blockIdx.x - (G - 4), lds, tid, lane, wave); }
        for (int rep = 0; rep < 1 + XREP_C; ++rep)
        for (int it = blockIdx.x; it < 1536; it += gridDim.x) {
            PHASE_BEGIN();
            if (it < 512) phaseC_mlstm(a, L, it, lds, tid, lane, wave);
            else if (it < 1280) phaseC_ret(a, L, it - 512, lds, tid, lane, wave);
            else phaseC_gmlp(a, L, it - 1280, lds, tid, lane, wave);
        }
        GRID_SYNC();
        {
            PHASE_BEGIN();
            phaseD(a, lds, tid);
            if ((int)blockIdx.x < 128) { const int pi = blockIdx.x, cg_ = pi & 31, ks = pi >> 5; LAS float* Ap = (LAS float*)lds; LAS float* red = (LAS float*)(lds + 16384);
                lds_copy_rows((const float*)(ws + WS_CATP), DM, ks * 256, 256, Ap, tid);
                gemv4_item<2, 16>(Ap, a->in[I_WOUT] + (size_t)L * DM * DM, DM, cg_ * 32, 32, ks * 256, (float*)(ws + WS_XP), DM, cg_ * 32, red, tid); }
            if (L + 1 < DEPTH) convert_weights(a, L + 1, ((L + 1) & 1) ? WS_WBUF1 : 0, lds, lane, wave);
        }
        GRID_SYNC();
        for (int rep = 0; rep < 1 + XREP_E; ++rep)
        for (int it = blockIdx.x; it < (rep == 0 ? 1280 + 128 : XREP_E_END); it += gridDim.x) {
            PHASE_BEGIN();
            if (it >= 1280) { const int cg_ = it - 1280; LAS float* Ap = (LAS float*)lds; LAS float* red = (LAS float*)(lds + 16384);
                precise_norm_to_lds((const float*)(ws + WS_XP), DM, a->in[I_NFG] + (size_t)L * DM, Ap, lane, wave);
                gemv4_item<1, 64>(Ap, a->in[I_WFF1] + (size_t)L * DM * DFF, DFF, cg_ * 32, 32, 0, (float*)(ws + WS_HIDP), DFF, cg_ * 32, red, tid); continue; }
            if (it < 512) phaseE_mlstm(a, L, it, lds, tid, lane, wave);
            else phaseE_ret(a, L, it - 512, lds, tid, lane, wave);
        }
        GRID_SYNC();
        {
            PHASE_BEGIN();
            const size_t wb = (L & 1) ? WS_WBUF1 : 0;
            pg8::Gemm g{(const bf16*)(ws + WS_CAT), (const bf16*)(ws + wb + WS_WOUT), MTOK, DM, DM}; pg8::StaticOrder S; S.init(MTOK, DM, G, (int)blockIdx.x);
            pg8::EpiResidNorm E{(L == 0) ? a->in[I_X] : a->out, a->out, (bf16*)(ws + WS_H), (float*)(ws + WS_SSQ), nullptr, DM};
            pg8::gemm_phase<pg8::EpiResidNorm, pg8::StaticOrder, true, GEMM_SP2>(lds, g, S, E);
        }
        GRID_SYNC();
        {
            PHASE_BEGIN();
            { const int pi = blockIdx.x, cg_ = pi & 31, ks = pi >> 5; LAS float* Ap = (LAS float*)lds; LAS float* red = (LAS float*)(lds + 16384);
              if (pi < 256) { lds_copy_rows((const float*)(ws + WS_HIDP), DFF, ks * 512, 512, Ap, tid);
                gemv4_item<2, 32>(Ap, a->in[I_WFF2] + (size_t)L * DFF * DM, DM, cg_ * 32, 32, ks * 512, (float*)(ws + WS_XP), DM, cg_ * 32, red, tid); } }
        }
        {
            PHASE_BEGIN();
            const size_t wb = (L & 1) ? WS_WBUF1 : 0;
            pg8::Gemm g{(const bf16*)(ws + WS_H), (const bf16*)(ws + wb + WS_W1), MTOK, DFF, DM}; pg8::StaticOrder S; S.init(MTOK, DFF, G, (int)blockIdx.x);
            pg8::EpiScaledBf16<2> E{(bf16*)(ws + WS_HID), DFF, (const float*)(ws + WS_SSQ), -1, nullptr, nullptr, nullptr};
            for (int rep = 0; rep < 1 + XREP_H; ++rep) pg8::gemm_phase<pg8::EpiScaledBf16<2>, pg8::StaticOrder, GEMM_ALIGN, GEMM_SP2>(lds, g, S, E);
        }
        GRID_SYNC();
        {
            PHASE_BEGIN();
            const size_t wb = (L & 1) ? WS_WBUF1 : 0;
            pg8::Gemm g{(const bf16*)(ws + WS_HID), (const bf16*)(ws + wb + WS_W2), MTOK, DM, DFF}; pg8::StaticOrder S; S.init(MTOK, DM, G, (int)blockIdx.x);
            const bool lastL = (L == DEPTH - 1);
            pg8::EpiResidNorm E{a->out, a->out, lastL ? (bf16*)nullptr : (bf16*)(ws + WS_H), lastL ? (float*)nullptr : (float*)(ws + WS_SSQ), (const float*)(ws + WS_XP), DM};
            pg8::gemm_phase<pg8::EpiResidNorm, pg8::StaticOrder, true, GEMM_SP2>(lds, g, S, E);
        }
        GRID_SYNC();
    }
    {
        PHASE_BEGIN();
        const int gw = blockIdx.x * NWAVES + wave, NGW = G * NWAVES;
        const float* g = a->in[I_FNG]; const float* xP = (const float*)(ws + WS_XP);
        f32x4 gv[4];
#pragma unroll
        for (int j = 0; j < 4; ++j) gv[j] = ((const f32x4*)g)[lane + 64 * j];
        for (int m0 = gw; m0 < MTOK; m0 += 4 * NGW) {
            f32x4 v[4][4];
#pragma unroll
            for (int r = 0; r < 4; ++r) { const int m = m0 + r * NGW; if (m < MTOK) {
                const f32x4* xs = (m & (SEQ - 1)) == 0 ? (const f32x4*)(xP + (size_t)(m >> 12) * DM) + lane : (const f32x4*)(a->out + (size_t)m * DM) + lane;
#pragma unroll
                for (int j = 0; j < 4; ++j) v[r][j] = xs[64 * j]; } }
#pragma unroll
            for (int r = 0; r < 4; ++r) { const int m = m0 + r * NGW; if (m < MTOK) { float ss = 0.f;
#pragma unroll
                for (int j = 0; j < 4; ++j) ss += (v[r][j].x * v[r][j].x + v[r][j].y * v[r][j].y) + (v[r][j].z * v[r][j].z + v[r][j].w * v[r][j].w);
                const float rstd = rsqrtf(wave_sum(ss) * (1.f / DM) + EPS);
                f32x4* xr = (f32x4*)(a->out + (size_t)m * DM) + lane;
#pragma unroll
                for (int j = 0; j < 4; ++j) xr[64 * j] = v[r][j] * rstd * gv[j]; } }
        }
    }
}

extern "C" void kernel_launch(void* const* d_in, const int* in_sizes, int n_in, void* d_out, int out_size, void* d_ws, size_t ws_size, hipStream_t stream) {
    static int grid = 0;
    if (grid == 0) {
        if (n_in != 21 || out_size != MTOK * DM || ws_size < WS_END) { fprintf(stderr, "kernel_launch: unexpected shapes (n_in %d out %d ws %zu)\n", n_in, out_size, ws_size); grid = -1; return; }
        int dev = 0, cus = 0, per_cu = 0;
        hipGetDevice(&dev);
        hipDeviceGetAttribute(&cus, hipDeviceAttributeMultiprocessorCount, dev);
        if (hipFuncSetAttribute((const void*)fwd_kernel, hipFuncAttributeMaxDynamicSharedMemorySize, LDS_BYTES) != hipSuccess) { fprintf(stderr, "kernel_launch: hipFuncSetAttribute failed\n"); grid = -1; return; }
        if (hipOccupancyMaxActiveBlocksPerMultiprocessor(&per_cu, (const void*)fwd_kernel, NTHR, LDS_BYTES) != hipSuccess || per_cu < 1) { fprintf(stderr, "kernel_launch: occupancy query says %d\n", per_cu); per_cu = 1; }
        (void)hipGetLastError();
        grid = cus;
        fprintf(stderr, "kernel_launch: cus %d per_cu %d grid %d\n", cus, per_cu, grid);
    }
    if (grid < 0) return;
    if (hipMemsetAsync((char*)d_ws + WS_CTL, 0, 16384, stream) != hipSuccess) { fprintf(stderr, "kernel_launch: memset failed\n"); return; }
    Args a{};
    for (int i = 0; i < 21; ++i) a.in[i] = (const float*)d_in[i];
    a.out = (float*)d_out; a.ws = (unsigned char*)d_ws;
    void* args[] = {&a};
    hipError_t e = hipLaunchCooperativeKernel((const void*)fwd_kernel, dim3(grid), dim3(NTHR), args, LDS_BYTES, stream);
    if (e != hipSuccess) fprintf(stderr, "cooperative launch failed: %s (grid %d)\n", hipGetErrorString(e), grid);
}
```

```cpp
#define EPI_BATCH 4
#include <hip/hip_runtime.h>
#include <hip/hip_cooperative_groups.h>
#include <cstdio>
#include <cstdint>
namespace cg = cooperative_groups;
namespace pg8 {
#define PG8_LAS __attribute__((address_space(3)))
typedef unsigned short bf16_t;
typedef short bf16x8 __attribute__((ext_vector_type(8)));
typedef float f32x4 __attribute__((ext_vector_type(4)));
typedef unsigned u32x4 __attribute__((ext_vector_type(4)));
constexpr int BM = 256, BK = 64, HALF = 128, HTB = HALF * BK * 2  , STAGE_BYTES = 8 * HTB, NXCD = 8, WGM = 8;

__host__ __device__ __forceinline__ int lds_byte(int r, int c) { const int st = (r >> 4) * 2 + (c >> 5), rr = r & 15, cc = c & 31, ob = rr * 64 + cc * 2; return st * 1024 + (ob ^ (((ob >> 9) & 1) << 5)); }
__host__ __device__ __forceinline__ void stage_rc(int b, int& R, int& C) { const int st = b / 1024, sb = b % 1024, swz = sb ^ (((sb >> 9) & 1) << 5); R = (st >> 1) * 16 + swz / 64; C = (st & 1) * 32 + (swz % 64) / 2; }
__host__ __device__ __forceinline__ int perm32(int rho) { const int n = rho >> 4, i = rho & 15; return 8 * (i >> 2) + 4 * n + (i & 3); }

struct Unit { int pm, pn; };
struct Gemm { const bf16_t* A; const bf16_t* Bt; int M, N, K; };

struct StaticOrder {
    int nM, nN, nwg, G, c;
    __host__ __device__ void init(int M, int N, int G_, int c_) { nM = M / BM; nN = N / BM; nwg = nM * nN; G = G_; c = c_; }
    __host__ __device__ bool next(int i, Unit& u) const {
        const long L = (long)i * G + c; if (L >= nwg) return false;
        int wgid = (int)L; { const int q = nwg / NXCD, r = nwg % NXCD, xcd = wgid % NXCD, off = wgid / NXCD; wgid = (xcd < r ? xcd * (q + 1) : r * (q + 1) + (xcd - r) * q) + off; }
        const int nig = WGM * nN, gid = wgid / nig, fm = gid * WGM, gsz = (nM - fm) < WGM ? (nM - fm) : WGM;
        u.pm = fm + ((wgid % nig) % gsz); u.pn = (wgid % nig) / gsz; return true;
    }
    __device__ __forceinline__ void a_ready(const Unit&) const {}
    __device__ __forceinline__ void done(const Unit&) const {}
};

__device__ __forceinline__ unsigned cvt_pk_bf16(float lo, float hi) { unsigned r; asm volatile("v_cvt_pk_bf16_f32 %0, %1, %2" : "=v"(r) : "v"(lo), "v"(hi)); return r; }
typedef float f32x2 __attribute__((ext_vector_type(2)));
template <int ACT> struct EpiBf16 {
    static constexpr bool PERM = true, AFTER_DRAIN = false;
    bf16_t* O; int ldc;
    __device__ __forceinline__ void operator()(const f32x4 (&acc)[2][2][4][2], const Unit& u, int wr, int wc, int fr, int fq) const {
        const int row0 = u.pm * BM + wr * 64 + fr; const int col0 = u.pn * BM + wc * 32 + 8 * fq;
#pragma unroll
        for (int ai = 0; ai < 2; ++ai)
#pragma unroll
            for (int m = 0; m < 4; ++m) { bf16_t* rowp = O + (size_t)(row0 + ai * HALF + m * 16) * ldc + col0;
#pragma unroll
                for (int bj = 0; bj < 2; ++bj) { f32x4 v0 = acc[ai][bj][m][0], v1 = acc[ai][bj][m][1];
                    if (ACT == 2) {
#pragma unroll
                        for (int e = 0; e < 4; ++e) { float a = fmaxf(v0[e], 0.f), b = fmaxf(v1[e], 0.f); v0[e] = a * a; v1[e] = b * b; } }
                    u32x4 w; w.x = cvt_pk_bf16(v0[0], v0[1]); w.y = cvt_pk_bf16(v0[2], v0[3]); w.z = cvt_pk_bf16(v1[0], v1[1]); w.w = cvt_pk_bf16(v1[2], v1[3]);
                    *(u32x4*)(rowp + bj * HALF) = w; } }
    }
};
struct EpiResid {
    static constexpr bool PERM = false, AFTER_DRAIN = false;
    const float* base; float* out; int ldc;
    __device__ __forceinline__ void operator()(const f32x4 (&acc)[2][2][4][2], const Unit& u, int wr, int wc, int fr, int fq) const {
        const int col0 = u.pn * BM + wc * 32 + 4 * fq;
#pragma unroll
        for (int ai = 0; ai < 2; ++ai)
#pragma unroll
            for (int m = 0; m < 4; ++m) { const size_t off = (size_t)(u.pm * BM + ai * HALF + wr * 64 + m * 16 + fr) * ldc + col0;
#pragma unroll
                for (int bj = 0; bj < 2; ++bj)
#pragma unroll
                    for (int n = 0; n < 2; ++n) { const f32x4 bs = *(const f32x4*)(base + off + bj * HALF + n * 16); *(f32x4*)(out + off + bj * HALF + n * 16) = bs + acc[ai][bj][m][n]; } }
    }
};
__device__ __forceinline__ float row_rstd(const float* ssq, int row) {
    const f32x4* p = (const f32x4*)(ssq + (size_t)row * 16);
    const f32x4 a = p[0], b = p[1], c = p[2], d = p[3];
    const float s = (((a[0] + a[1]) + (a[2] + a[3])) + ((b[0] + b[1]) + (b[2] + b[3]))) + (((c[0] + c[1]) + (c[2] + c[3])) + ((d[0] + d[1]) + (d[2] + d[3])));
    return rsqrtf(s * (1.0f / 1024.0f) + 1e-6f);
}
#ifndef EPI_BATCH
#define EPI_BATCH 2
#endif
template <int ACT> struct EpiScaledBf16 {
    static constexpr bool PERM = true, AFTER_DRAIN = false;
    bf16_t* O; int ldc; const float* ssq; int gate_pn; float* gates; const float* ib; const float* fb;
    __device__ __forceinline__ void operator()(const f32x4 (&acc)[2][2][4][2], const Unit& u, int wr, int wc, int fr, int fq) const {
        const int row0 = u.pm * BM + wr * 64 + fr; const int col0 = u.pn * BM + wc * 32 + 8 * fq;
        const bool gate_tile = (u.pn == gate_pn);
        if (gate_tile && !(wc == 0 && fq == 0)) return;
#pragma unroll
        for (int ai = 0; ai < 2; ++ai)
#pragma unroll
        for (int mh = 0; mh < 4; mh += EPI_BATCH) {
            f32x4 p[EPI_BATCH][4]; float rs[EPI_BATCH];
#pragma unroll
            for (int m = 0; m < EPI_BATCH; ++m)
#pragma unroll
                for (int q = 0; q < 4; ++q) p[m][q] = *((const f32x4*)(ssq + (size_t)(row0 + ai * HALF + (mh + m) * 16) * 16) + q);
#pragma unroll
            for (int m = 0; m < EPI_BATCH; ++m) { const f32x4 t = (p[m][0] + p[m][1]) + (p[m][2] + p[m][3]); rs[m] = rsqrtf(((t[0] + t[1]) + (t[2] + t[3])) * (1.0f / 1024.0f) + 1e-6f); }
#pragma unroll
            for (int mm = 0; mm < EPI_BATCH; ++mm) { const int m = mh + mm; const int row = row0 + ai * HALF + m * 16; const float r = rs[mm];
                if (gate_tile) {
                    const f32x4 bi = *(const f32x4*)ib, bf = *(const f32x4*)fb;
                    *(f32x4*)(gates + (size_t)row * 8) = acc[ai][0][m][0] * r + bi; *(f32x4*)(gates + (size_t)row * 8 + 4) = acc[ai][0][m][1] * r + bf;
                } else {
                    bf16_t* rowp = O + (size_t)row * ldc + col0;
#pragma unroll
                    for (int bj = 0; bj < 2; ++bj) { f32x4 v0 = acc[ai][bj][m][0] * r, v1 = acc[ai][bj][m][1] * r;
                        if (ACT == 2) {
#pragma unroll
                            for (int e = 0; e < 4; ++e) { float a = fmaxf(v0[e], 0.f), b = fmaxf(v1[e], 0.f); v0[e] = a * a; v1[e] = b * b; } }
                        u32x4 w; w.x = cvt_pk_bf16(v0[0], v0[1]); w.y = cvt_pk_bf16(v0[2], v0[3]); w.z = cvt_pk_bf16(v1[0], v1[1]); w.w = cvt_pk_bf16(v1[2], v1[3]);
                        *(u32x4*)(rowp + bj * HALF) = w; }
                }
            }
            asm volatile("" ::: "memory");
        }
    }
};
struct EpiResidNorm {
    static constexpr bool PERM = false, AFTER_DRAIN = false;
    const float* base; float* out; bf16_t* xb; float* ssq; const float* xP; int ldc;
    __device__ __forceinline__ void operator()(const f32x4 (&acc)[2][2][4][2], const Unit& u, int wr, int wc, int fr, int fq) const {
        typedef unsigned u32x2v __attribute__((ext_vector_type(2)));
        const int col0 = u.pn * BM + wc * 32 + 4 * fq;
#pragma unroll
        for (int ai = 0; ai < 2; ++ai)
#pragma unroll
        for (int mh = 0; mh < 4; mh += EPI_BATCH) {
            f32x4 pre[EPI_BATCH][2][2];
#pragma unroll
            for (int mm = 0; mm < EPI_BATCH; ++mm) { const int m = mh + mm; const int row = u.pm * BM + ai * HALF + wr * 64 + m * 16 + fr; const bool p0 = xP != nullptr && (row & 4095) == 0;
                const float* src = p0 ? xP + (size_t)(row >> 12) * ldc + col0 : base + (size_t)row * ldc + col0;
#pragma unroll
                for (int bj = 0; bj < 2; ++bj)
#pragma unroll
                    for (int n = 0; n < 2; ++n) pre[mm][bj][n] = *(const f32x4*)(src + bj * HALF + n * 16); }
#pragma unroll
            for (int mm = 0; mm < EPI_BATCH; ++mm) { const int m = mh + mm; const int row = u.pm * BM + ai * HALF + wr * 64 + m * 16 + fr; const size_t off = (size_t)row * ldc + col0; float s = 0.f;
                const bool p0 = xP != nullptr && (row & 4095) == 0;
#pragma unroll
                for (int bj = 0; bj < 2; ++bj)
#pragma unroll
                    for (int n = 0; n < 2; ++n) { const int co = bj * HALF + n * 16;
                        f32x4 v = pre[mm][bj][n]; if (!p0) v = v + acc[ai][bj][m][n];
                        *(f32x4*)(out + off + co) = v; s += (v[0] * v[0] + v[1] * v[1]) + (v[2] * v[2] + v[3] * v[3]);
                        if (xb != nullptr) { u32x2v w; w.x = cvt_pk_bf16(v[0], v[1]); w.y = cvt_pk_bf16(v[2], v[3]); *(u32x2v*)(xb + off + co) = w; } }
                s += __shfl_xor(s, 16); s += __shfl_xor(s, 32);
                if (fq == 0 && ssq != nullptr) ssq[(size_t)row * 16 + u.pn * 4 + wc] = s; }
            asm volatile("" ::: "memory");
        }
    }
};
struct EpiNull {
    static constexpr bool PERM = false, AFTER_DRAIN = false;
    float* sink;
    __device__ __forceinline__ void operator()(const f32x4 (&acc)[2][2][4][2], const Unit& u, int wr, int wc, int fr, int fq) const {
        float s = 0.f;
#pragma unroll
        for (int ai = 0; ai < 2; ++ai)
#pragma unroll
            for (int bj = 0; bj < 2; ++bj)
#pragma unroll
                for (int m = 0; m < 4; ++m)
#pragma unroll
                    for (int n = 0; n < 2; ++n) s += (acc[ai][bj][m][n][0] + acc[ai][bj][m][n][1]) + (acc[ai][bj][m][n][2] + acc[ai][bj][m][n][3]);
        if (s == 1.2345678e33f) sink[0] = s;
    }
};
template <class Epi, class Sched, bool ALIGN_EPI = false, bool SP2 = false>
__device__ __forceinline__ void gemm_phase(PG8_LAS unsigned char* lds, const Gemm g, const Sched& S, const Epi& E) {
    int tid_o = threadIdx.x; asm volatile("" : "+v"(tid_o)); const int tid = tid_o, wid = __builtin_amdgcn_readfirstlane(tid >> 6), lane = tid & 63, wr = wid >> 2, wc = wid & 3, fr = lane & 15, fq = lane >> 4;
    const int K = g.K, nt = K / BK;
    unsigned voffA[2], voffB[2];
#pragma unroll
    for (int i = 0; i < 2; ++i) { int R, C; stage_rc(tid * 16 + i * 8192, R, C); const int Rb = Epi::PERM ? ((R & ~31) + perm32(R & 31)) : R;
        voffA[i] = (unsigned)(R * K + C) * 2u; voffB[i] = (unsigned)(Rb * K + C) * 2u; }
    const size_t kstep = (size_t)(BK * 2);
    const size_t hstep = (size_t)HALF * K * 2;
    const size_t tstep = 2 * hstep;
    const unsigned ldsw = (unsigned)wid * 1024u;
    const int aoff = lds_byte(wr * 64 + fr, fq * 8), boff = lds_byte(wc * 32 + fr, fq * 8);
#define PG8_SA(b, h) (((b) * 2 + (h)) * HTB)
#define PG8_SB(b, h) ((4 + (b) * 2 + (h)) * HTB)
#define PG8_STAGE(bufoff, gbase, voff) do { _Pragma("unroll") for (int _i = 0; _i < 2; ++_i) \
        __builtin_amdgcn_global_load_lds((const unsigned*)((const char*)(gbase) + (voff)[_i]), (PG8_LAS unsigned*)(lds + (bufoff) + ldsw + _i * 8192), 16, 0, 0); } while (0)
#define PG8_LDA(dst, b, h) do { _Pragma("unroll") for (int m = 0; m < 4; ++m) _Pragma("unroll") for (int k = 0; k < 2; ++k) dst[m][k] = *(const PG8_LAS bf16x8*)(lds + PG8_SA(b, h) + aoff + m * 2048 + k * 1024); } while (0)
#define PG8_LDB(dst, b, h) do { _Pragma("unroll") for (int n = 0; n < 2; ++n) _Pragma("unroll") for (int k = 0; k < 2; ++k) dst[n][k] = *(const PG8_LAS bf16x8*)(lds + PG8_SB(b, h) + boff + n * 2048 + k * 1024); } while (0)
#define PG8_MMA(ai, bj, At, Bt) do { __builtin_amdgcn_s_setprio(1); _Pragma("unroll") for (int m = 0; m < 4; ++m) _Pragma("unroll") for (int n = 0; n < 2; ++n) _Pragma("unroll") for (int k = 0; k < 2; ++k) \
        acc[ai][bj][m][n] = __builtin_amdgcn_mfma_f32_16x16x32_bf16(Bt[n][k], At[m][k], acc[ai][bj][m][n], 0, 0, 0); __builtin_amdgcn_s_setprio(0); } while (0)
#define PG8_WAIT_V(n) asm volatile("s_waitcnt vmcnt(" #n ")" ::: "memory")
#define PG8_WAIT_L(n) asm volatile("s_waitcnt lgkmcnt(" #n ")" ::: "memory")
#define PG8_BAR __builtin_amdgcn_s_barrier()
#define PG8_SCHED __builtin_amdgcn_sched_barrier(0)
    Unit cur, nxt; int ui = 0;
    if (!S.next(0, cur)) return;
    f32x4 acc[2][2][4][2];
#pragma unroll
    for (int a = 0; a < 2; ++a)
#pragma unroll
        for (int b = 0; b < 2; ++b)
#pragma unroll
            for (int m = 0; m < 4; ++m)
#pragma unroll
                for (int n = 0; n < 2; ++n) acc[a][b][m][n] = (f32x4){0.f, 0.f, 0.f, 0.f};
    bf16x8 At[4][2], B0[2][2], B1[2][2];
    const char* cA = (const char*)g.A + (size_t)cur.pm * tstep; const char* cB = (const char*)g.Bt + (size_t)cur.pn * tstep;
    S.a_ready(cur);
    if constexpr (SP2) {
        PG8_STAGE(PG8_SB(0, 0), cB, voffB); PG8_STAGE(PG8_SB(0, 1), cB + hstep, voffB); PG8_STAGE(PG8_SA(0, 0), cA, voffA); PG8_STAGE(PG8_SA(0, 1), cA + hstep, voffA);
        if (wr == 1) PG8_BAR;
        PG8_WAIT_V(2); PG8_BAR;
        PG8_STAGE(PG8_SB(1, 0), cB + kstep, voffB); PG8_STAGE(PG8_SA(1, 0), cA + kstep, voffA); PG8_STAGE(PG8_SB(1, 1), cB + hstep + kstep, voffB);
        PG8_WAIT_V(6); PG8_BAR;
    } else {
        PG8_STAGE(PG8_SB(0, 0), cB, voffB); PG8_STAGE(PG8_SA(0, 0), cA, voffA); PG8_STAGE(PG8_SB(0, 1), cB + hstep, voffB); PG8_STAGE(PG8_SA(0, 1), cA + hstep, voffA);
        if (wr == 1) PG8_BAR;
        PG8_WAIT_V(4); PG8_BAR;
        PG8_STAGE(PG8_SB(1, 0), cB + kstep, voffB); PG8_STAGE(PG8_SA(1, 0), cA + kstep, voffA); PG8_STAGE(PG8_SB(1, 1), cB + hstep + kstep, voffB);
        PG8_WAIT_V(6); PG8_BAR;
    }
    for (;;) {
        const bool has_next = S.next(ui + 1, nxt);
        const char* nA = has_next ? (const char*)g.A + (size_t)nxt.pm * tstep : cA; const char* nB = has_next ? (const char*)g.Bt + (size_t)nxt.pn * tstep : cB;
        for (int t = 0; t < nt; t += 2) {
            const bool last = (t == nt - 2);
            const char* a1 = cA + (size_t)(t + 1) * kstep;
            const char* a2 = last ? nA : cA + (size_t)(t + 2) * kstep; const char* b2 = last ? nB : cB + (size_t)(t + 2) * kstep;
            const char* a3 = a2 + kstep; const char* b3 = b2 + kstep;
            if (last && has_next) S.a_ready(nxt);
            if constexpr (SP2) {
            PG8_LDB(B0, 0, 0); PG8_LDB(B1, 0, 1); PG8_SCHED; PG8_LDA(At, 0, 0); PG8_STAGE(PG8_SA(1, 1), a1 + hstep, voffA);
            PG8_WAIT_V(8); PG8_WAIT_L(0); PG8_BAR; PG8_MMA(0, 0, At, B0); PG8_MMA(0, 1, At, B1); PG8_BAR; PG8_SCHED;
            PG8_LDA(At, 0, 1); PG8_STAGE(PG8_SB(0, 0), b2, voffB); PG8_STAGE(PG8_SB(0, 1), b2 + hstep, voffB); PG8_STAGE(PG8_SA(0, 0), a2, voffA);
            PG8_WAIT_V(8); PG8_WAIT_L(0); PG8_BAR; PG8_MMA(1, 0, At, B0); PG8_MMA(1, 1, At, B1); PG8_BAR; PG8_SCHED;
            PG8_LDB(B0, 1, 0); PG8_LDB(B1, 1, 1); PG8_SCHED; PG8_LDA(At, 1, 0); PG8_STAGE(PG8_SA(0, 1), a2 + hstep, voffA);
            PG8_WAIT_V(8); PG8_WAIT_L(0); PG8_BAR; PG8_MMA(0, 0, At, B0); PG8_MMA(0, 1, At, B1); PG8_BAR; PG8_SCHED;
            PG8_LDA(At, 1, 1); PG8_STAGE(PG8_SB(1, 0), b3, voffB); PG8_STAGE(PG8_SB(1, 1), b3 + hstep, voffB); PG8_STAGE(PG8_SA(1, 0), a3, voffA);
            PG8_WAIT_V(8); PG8_WAIT_L(0); PG8_BAR; PG8_MMA(1, 0, At, B0); PG8_MMA(1, 1, At, B1); PG8_BAR; PG8_SCHED;
            } else {
            PG8_LDB(B0, 0, 0); PG8_SCHED; PG8_LDA(At, 0, 0); PG8_STAGE(PG8_SA(1, 1), a1 + hstep, voffA);
            PG8_WAIT_L(8); PG8_BAR; PG8_WAIT_L(0); PG8_MMA(0, 0, At, B0); PG8_BAR; PG8_SCHED;
            PG8_LDB(B1, 0, 1); PG8_STAGE(PG8_SB(0, 0), b2, voffB);
            PG8_BAR; PG8_WAIT_L(0); PG8_MMA(0, 1, At, B1); PG8_BAR;
            PG8_LDA(At, 0, 1); PG8_STAGE(PG8_SA(0, 0), a2, voffA);
            PG8_BAR; PG8_WAIT_L(0); PG8_MMA(1, 0, At, B0); PG8_BAR; PG8_SCHED;
            PG8_STAGE(PG8_SB(0, 1), b2 + hstep, voffB);
            PG8_WAIT_V(6); PG8_BAR; PG8_MMA(1, 1, At, B1); PG8_BAR;
            PG8_LDB(B0, 1, 0); PG8_SCHED; PG8_LDA(At, 1, 0); PG8_STAGE(PG8_SA(0, 1), a2 + hstep, voffA);
            PG8_WAIT_L(8); PG8_BAR; PG8_WAIT_L(0); PG8_MMA(0, 0, At, B0); PG8_BAR; PG8_SCHED;
            PG8_LDB(B1, 1, 1); PG8_STAGE(PG8_SB(1, 0), b3, voffB);
            PG8_BAR; PG8_WAIT_L(0); PG8_MMA(0, 1, At, B1); PG8_BAR;
            PG8_LDA(At, 1, 1); PG8_STAGE(PG8_SA(1, 0), a3, voffA);
            PG8_BAR; PG8_WAIT_L(0); PG8_MMA(1, 0, At, B0); PG8_BAR; PG8_SCHED;
            PG8_STAGE(PG8_SB(1, 1), b3 + hstep, voffB);
            PG8_WAIT_V(6); PG8_BAR; PG8_MMA(1, 1, At, B1); PG8_BAR;
            }
        }
        if constexpr (ALIGN_EPI) { if (wr == 0) PG8_BAR; }
        if constexpr (!Epi::AFTER_DRAIN) { E(acc, cur, wr, wc, fr, fq); S.done(cur); }
        if (!has_next) break;
#pragma unroll
        for (int a = 0; a < 2; ++a)
#pragma unroll
            for (int b = 0; b < 2; ++b)
#pragma unroll
                for (int m = 0; m < 4; ++m)
#pragma unroll
                    for (int n = 0; n < 2; ++n) acc[a][b][m][n] = (f32x4){0.f, 0.f, 0.f, 0.f};
        cur = nxt; cA = nA; cB = nB; ++ui;
        if constexpr (ALIGN_EPI) { if (wr == 1) PG8_BAR; }
    }
    PG8_WAIT_V(0);
    if constexpr (!ALIGN_EPI) { if (wr == 0) PG8_BAR; }
    PG8_BAR;
    if constexpr (Epi::AFTER_DRAIN) { E.fused(acc, cur, wr, wc, fr, fq, lds, wid, lane); S.done(cur); }
#undef PG8_SA
#undef PG8_SB
#undef PG8_STAGE
#undef PG8_LDA
#undef PG8_LDB
#undef PG8_MMA
#undef PG8_WAIT_V
#undef PG8_WAIT_L
#undef PG8_BAR
#undef PG8_SCHED
}
}

constexpr int NWAVES = 8, NTHR = 512;
constexpr int BATCH = 4, SEQ = 4096, DM = 1024, DEPTH = 4, MTOK = BATCH * SEQ;
constexpr int N_IN = 2824, NP = 2816, NPAD = 3072, DFF = 4096;
constexpr int NCH = 32;
constexpr int PC_MX = 0, PC_MZ = 384, PC_RQ = 768, PC_RK = 1152, PC_RV = 1536, PC_RG = 1920, PC_GU = 2304, PC_GV = 2560;
constexpr int CAT_R = 384, CAT_G = 768;
constexpr float EPS = 1e-6f;
constexpr int NE_M = 97 * 96;
constexpr int NE_R = 64 * 64;

constexpr size_t MiB = 1u << 20;
constexpr size_t WS_CTL = 0;
constexpr size_t WS_WIN = 1 * MiB, WS_WOUT = 7 * MiB, WS_W1 = 9 * MiB, WS_W2 = 17 * MiB;
constexpr size_t WS_ROPE = 25 * MiB;
constexpr size_t WS_GATES = 26 * MiB;
constexpr size_t WS_SCAL = 27 * MiB;
constexpr size_t WS_XP = 27 * MiB + 65536;
constexpr size_t WS_PROJP = WS_XP + 16384;
constexpr size_t WS_CATP = WS_PROJP + 49152;
constexpr size_t WS_HIDP = WS_CATP + 16384;
constexpr size_t WS_H = 28 * MiB;
constexpr size_t WS_PROJ = 60 * MiB;
constexpr size_t WS_CAT = 148 * MiB;
constexpr size_t WS_MST = 180 * MiB;
constexpr size_t WS_RST = 199 * MiB;
constexpr size_t WS_HID = 60 * MiB;
constexpr size_t WS_WBUF1 = 210 * MiB;
constexpr size_t WS_SSQ = 236 * MiB;
constexpr size_t WS_END = 237 * MiB;
static_assert(WS_MST + (size_t)512 * NE_M * 4 <= WS_RST && WS_RST + (size_t)768 * NE_R * 4 <= 211 * MiB, "ws map");
static_assert(WS_HID + (size_t)MTOK * DFF * 2 <= WS_RST, "hid overlay");

#ifndef XREP_A
#define XREP_A 0
#endif
#ifndef XREP_C
#define XREP_C 0
#endif
#ifndef XREP_E_END
#define XREP_E_END 1280
#endif
#ifndef XREP_E
#define XREP_E 0
#endif
#ifndef XREP_D
#define XREP_D 0
#endif
#ifndef XREP_B
#define XREP_B 0
#endif
#ifndef XREP_H
#define XREP_H 0
#endif
#ifndef GEMM_SP2
#define GEMM_SP2 true
#endif
#ifndef GEMM_ALIGN
#define GEMM_ALIGN true
#endif
#ifndef XREP_G
#define XREP_G 0
#endif
constexpr int LDS_BYTES = 147456;

#define LAS __attribute__((address_space(3)))
typedef unsigned short bf16;
typedef unsigned v4u __attribute__((ext_vector_type(4)));
typedef unsigned v2u __attribute__((ext_vector_type(2)));
typedef float f32x4 __attribute__((ext_vector_type(4)));
typedef short bf16x8 __attribute__((ext_vector_type(8)));
typedef LAS unsigned char* ldsp;

__device__ __forceinline__ unsigned pk2(float lo, float hi) { return pg8::cvt_pk_bf16(lo, hi); }
__device__ __forceinline__ unsigned short f2bf(float f) { return (unsigned short)(pg8::cvt_pk_bf16(f, 0.f) & 0xffffu); }
__device__ __forceinline__ float bflo(unsigned u) { return __uint_as_float(u << 16); }
__device__ __forceinline__ float bfhi(unsigned u) { return __uint_as_float(u & 0xffff0000u); }
__device__ __forceinline__ float bf2f(unsigned short h) { return __uint_as_float((unsigned)h << 16); }
__device__ __forceinline__ float fast_rcp(float x) { return __builtin_amdgcn_rcpf(x); }
__device__ __forceinline__ float silu_f(float x) { return x * fast_rcp(1.f + __expf(-x)); }
__device__ __forceinline__ float gelu_tanh(float x) { const float u = 0.7978845608f * (x + 0.044715f * x * x * x); const float r = fast_rcp(__expf(2.f * u) + 1.f); return x - x * r; }
__device__ __forceinline__ float wave_sum(float v) {
#pragma unroll
    for (int o = 1; o < 64; o <<= 1) v += __shfl_xor(v, o);
    return v;
}
#define XB_TMO      128
#define XB_XCNT(j)  (256  + 64 * (j))
#define XB_XSUB(j)  (1280 + 64 * (j))
#define XB_XGEN(j)  (2304 + 64 * (j))
#define XB_TOP      3328
#define XB_TOPGEN   3392
#define XCD_BAR_WORDS 3456
#define XB_SPIN_CAP (1u << 18)

__device__ __forceinline__ unsigned xb_ld(unsigned* p)              { return __hip_atomic_load(p, __ATOMIC_RELAXED, __HIP_MEMORY_SCOPE_AGENT); }
__device__ __forceinline__ unsigned xb_add(unsigned* p, unsigned v) { return __hip_atomic_fetch_add(p, v, __ATOMIC_RELAXED, __HIP_MEMORY_SCOPE_AGENT); }
__device__ __forceinline__ unsigned xb_xcc_id() { return (unsigned)__builtin_amdgcn_s_getreg((3 << 11) | 20) & 0xFu; }
#define XB_SPIN(cond, bar) do { unsigned _sp = 0; while (cond) { __builtin_amdgcn_s_sleep(1); \
    if ((++_sp & 255u) == 0u) { if (xb_ld(&(bar)[XB_TMO])) break; if (_sp > XB_SPIN_CAP) { atomicAdd(&(bar)[XB_TMO], 1u); break; } } } } while (0)

struct XcdBarrier {
    unsigned* bar; unsigned x;
    volatile LAS unsigned* st;
};

__device__ __forceinline__ XcdBarrier xcd_barrier_post(unsigned* bar, volatile LAS unsigned* st) {
    XcdBarrier b; b.bar = bar; b.x = xb_xcc_id(); b.st = st;
    if (threadIdx.x == 0) (void)xb_add(&bar[XB_XCNT(b.x)], 1u);
    return b;
}
__device__ __forceinline__ void xcd_barrier_complete(unsigned* bar, unsigned x, unsigned& nloc, unsigned& nx) {
    const unsigned G = gridDim.x * gridDim.y * gridDim.z;
    unsigned sum, cnt, mine, sp = 0u;
    for (;;) {
        sum = 0u; cnt = 0u; mine = 0u;
#pragma unroll
        for (unsigned j = 0; j < 16; ++j) { const unsigned c = xb_ld(&bar[XB_XCNT(j)]); sum += c; cnt += (c > 0u) ? 1u : 0u; mine = (j == x) ? c : mine; }
        if (sum == G) break;
        __builtin_amdgcn_s_sleep(1);
        if ((++sp & 255u) == 0u) { if (xb_ld(&bar[XB_TMO])) break; if (sp > XB_SPIN_CAP) { atomicAdd(&bar[XB_TMO], 1u); break; } }
    }
    nloc = mine > 0u ? mine : 1u; nx = cnt > 0u ? cnt : 1u;
}

__device__ __forceinline__ void xcd_barrier(const XcdBarrier& b) {
    asm volatile("s_waitcnt vmcnt(0)" ::: "memory");
    __syncthreads();
    if (threadIdx.x == 0) {
        unsigned* bar = b.bar;
        __builtin_amdgcn_s_waitcnt(0);
        unsigned nloc = b.st[0], nx = b.st[1];
        if (nloc == 0u) { xcd_barrier_complete(bar, b.x, nloc, nx); b.st[0] = nloc; b.st[1] = nx; }
        const unsigned old = xb_add(&bar[XB_XSUB(b.x)], 1u);
        const unsigned gen = old / nloc;
        if (old + 1u == (gen + 1u) * nloc) {
            __builtin_amdgcn_fence(__ATOMIC_RELEASE, "agent");
            asm volatile("s_waitcnt vmcnt(0)" ::: "memory");
            const unsigned og = xb_add(&bar[XB_TOP], 1u);
            const unsigned tg = og / nx;
            if (og + 1u == (tg + 1u) * nx) xb_add(&bar[XB_TOPGEN], 1u);
            else XB_SPIN(xb_ld(&bar[XB_TOPGEN]) == tg, bar);
            __builtin_amdgcn_fence(__ATOMIC_ACQUIRE, "agent");
            xb_add(&bar[XB_XGEN(b.x)], 1u);
            asm volatile("s_waitcnt vmcnt(0)" ::: "memory");
        } else {
            XB_SPIN(xb_ld(&bar[XB_XGEN(b.x)]) == gen, bar);
            __builtin_amdgcn_fence(__ATOMIC_ACQUIRE, "agent");
            asm volatile("s_waitcnt vmcnt(0)" ::: "memory");
        }
    }
    __syncthreads();
}

typedef float f32x2 __attribute__((ext_vector_type(2)));
__device__ __forceinline__ f32x2 silu2(f32x2 x) { const f32x2 t = x * (-1.4426950408889634f); f32x2 e; e.x = __builtin_amdgcn_exp2f(t.x); e.y = __builtin_amdgcn_exp2f(t.y);
    const f32x2 d = e + 1.0f; f32x2 r; r.x = __builtin_amdgcn_rcpf(d.x); r.y = __builtin_amdgcn_rcpf(d.y); return x * r; }
__device__ __forceinline__ f32x2 gelu2(f32x2 x) { const f32x2 p = (x * x) * 0.10294324f + 2.3022082f; const f32x2 w = p * x; f32x2 e; e.x = __builtin_amdgcn_exp2f(w.x); e.y = __builtin_amdgcn_exp2f(w.y);
    const f32x2 d = e + 1.0f; f32x2 r; r.x = __builtin_amdgcn_rcpf(d.x); r.y = __builtin_amdgcn_rcpf(d.y); return x - x * r; }
#define LDS_WAIT() asm volatile("s_waitcnt lgkmcnt(0)" ::: "memory")
#define MFMA16(a, b, c) __builtin_amdgcn_mfma_f32_16x16x32_bf16((a), (b), (c), 0, 0, 0)

struct Args {
    const float* in[21];
    float* out; unsigned char* ws;
};
typedef const Args __attribute__((address_space(4)))* ArgsP;
enum { I_X = 0, I_NMG, I_WIN, I_CONVW, I_CONVB, I_WQ, I_WK, I_WV, I_IB, I_FB, I_MNG, I_SKIP, I_RNG, I_GNG, I_GWS, I_GBS, I_WOUT, I_NFG, I_WFF1, I_WFF2, I_FNG };

__device__ __forceinline__ void transpose_item(const float* W, int ldw, int col_src0, int nvalid, const float* gk, int K, bf16* WT, int n0, int k0, LAS float* scr, int lane) {
    float vv[32];
    const bool val = (lane & 31) < nvalid;
    const float* wp = W + (size_t)(k0 + (lane >> 5)) * ldw + col_src0 + (lane & 31);
#pragma unroll
    for (int i = 0; i < 32; ++i) vv[i] = val ? wp[(size_t)(2 * i) * ldw] : 0.f;
    if (gk) {
        const float* gp = gk + k0 + (lane >> 5);
#pragma unroll
        for (int i = 0; i < 32; ++i) vv[i] *= gp[2 * i];
    }
#pragma unroll
    for (int i = 0; i < 32; ++i) scr[(2 * i + (lane >> 5)) * 33 + (lane & 31)] = vv[i];
    LDS_WAIT(); asm volatile("" ::: "memory");
    const int c = lane & 7;
#pragma unroll
    for (int j = 0; j < 4; ++j) { const int n = (lane >> 3) + 8 * j; const LAS float* s = scr + (8 * c) * 33 + n;
        v4u o; o.x = pk2(s[0 * 33], s[1 * 33]); o.y = pk2(s[2 * 33], s[3 * 33]); o.z = pk2(s[4 * 33], s[5 * 33]); o.w = pk2(s[6 * 33], s[7 * 33]);
        *(v4u*)(WT + (size_t)(n0 + n) * K + k0 + 8 * c) = o; }
    LDS_WAIT(); asm volatile("" ::: "memory");
}

__device__ __forceinline__ void convert_weights(ArgsP a, int L, size_t wb, ldsp lds, int lane, int wave) {
    LAS float* scr = (LAS float*)(lds + 32768 + wave * 8448);
    const int gw = blockIdx.x * NWAVES + wave, NGW = gridDim.x * NWAVES;
    constexpr int I_IN = (DM / 64) * (NPAD / 32), I_O = (DM / 64) * (DM / 32), I_1 = (DM / 64) * (DFF / 32), I_2 = (DFF / 64) * (DM / 32);
    constexpr int NITEMS = I_IN + I_O + I_1 + I_2;
    unsigned char* ws = a->ws + wb;
    for (int it = gw; it < NITEMS; it += NGW) {
        int r = it;
        if (r < I_IN) { const int nblk = NPAD / 32, kb = r / nblk, nb = r % nblk, n0 = nb * 32;
            const int src = nb < 88 ? n0 + (n0 >= 768 ? 8 : 0) : 768, nv = nb < 88 ? 32 : (nb == 88 ? 8 : 0);
            transpose_item(a->in[I_WIN] + (size_t)L * DM * N_IN, N_IN, src, nv, a->in[I_NMG] + (size_t)L * DM, DM, (bf16*)(ws + WS_WIN), n0, kb * 64, scr, lane); continue; } r -= I_IN;
        if (r < I_O) { const int nblk = DM / 32, kb = r / nblk, nb = r % nblk; transpose_item(a->in[I_WOUT] + (size_t)L * DM * DM, DM, nb * 32, 32, nullptr, DM, (bf16*)(ws + WS_WOUT), nb * 32, kb * 64, scr, lane); continue; } r -= I_O;
        if (r < I_1) { const int nblk = DFF / 32, kb = r / nblk, nb = r % nblk; transpose_item(a->in[I_WFF1] + (size_t)L * DM * DFF, DFF, nb * 32, 32, a->in[I_NFG] + (size_t)L * DM, DM, (bf16*)(ws + WS_W1), nb * 32, kb * 64, scr, lane); continue; } r -= I_1;
        { const int nblk = DM / 32, kb = r / nblk, nb = r % nblk; transpose_item(a->in[I_WFF2] + (size_t)L * DFF * DM, DM, nb * 32, 32, nullptr, DFF, (bf16*)(ws + WS_W2), nb * 32, kb * 64, scr, lane); }
    }
}

template <bool GATES>
__device__ __forceinline__ void norm_rows(const float* x, const float* g, bf16* h, const LAS float* wgT, const float* ib, const float* fb, float* gates, int lane, int wave, const float* xP, float* wb) {
    const int gw = blockIdx.x * NWAVES + wave, NGW = gridDim.x * NWAVES;
    f32x4 gv[4];
#pragma unroll
    for (int j = 0; j < 4; ++j) gv[j] = ((const f32x4*)g)[lane + 64 * j];
    for (int m = gw; m < MTOK; m += NGW) {
        const bool p0 = xP != nullptr && (m & (SEQ - 1)) == 0;
        const f32x4* xr = (const f32x4*)(p0 ? xP + (size_t)(m >> 12) * DM : x + (size_t)m * DM) + lane;
        f32x4 v[4]; float ss = 0.f;
#pragma unroll
        for (int j = 0; j < 4; ++j) { v[j] = xr[64 * j]; ss += (v[j].x * v[j].x + v[j].y * v[j].y) + (v[j].z * v[j].z + v[j].w * v[j].w); }
        if (p0 && wb != nullptr) {
#pragma unroll
            for (int j = 0; j < 4; ++j) ((f32x4*)(wb + (size_t)m * DM) + lane)[64 * j] = v[j]; }
        const float rstd = rsqrtf(wave_sum(ss) * (1.f / DM) + EPS);
        unsigned long long* o8 = (unsigned long long*)(h + (size_t)m * DM) + lane;
#pragma unroll
        for (int j = 0; j < 4; ++j) { v[j] = v[j] * rstd * gv[j]; o8[64 * j] = (unsigned long long)pk2(v[j].x, v[j].y) | ((unsigned long long)pk2(v[j].z, v[j].w) << 32); }
        if (GATES) {
            float mine = 0.f;
#pragma unroll
            for (int c = 0; c < 8; ++c) {
                float p = 0.f;
#pragma unroll
                for (int j = 0; j < 4; ++j) { const f32x4 w = *(const LAS f32x4*)(wgT + c * 1024 + 4 * lane + 256 * j); p += (v[j].x * w.x + v[j].y * w.y) + (v[j].z * w.z + v[j].w * w.w); }
                p = wave_sum(p);
                if (lane == c) mine = p;
            }
            if (lane < 8) gates[(size_t)m * 8 + lane] = mine + (lane < 4 ? ib[lane] : fb[lane - 4]);
        }
    }
}

__device__ __forceinline__ float log_sigmoid_f(float f) { return fminf(f, 0.f) - __logf(1.f + __expf(-fabsf(f))); }
__device__ __forceinline__ void gates_cumsum(float f0, float f1, float& b0, float& b1, int lane) {
    const float l0 = log_sigmoid_f(f0), l1 = log_sigmoid_f(f1);
    float p = l0 + l1;
#pragma unroll
    for (int o = 1; o < 64; o <<= 1) { const float u = __shfl_up(p, o); if (lane >= o) p += u; }
    b1 = p; b0 = p - l1;
}
__device__ __forceinline__ void gates_prefmax(float g0, float g1, float& m0, float& m1, int lane) {
    float q = fmaxf(g0, g1);
#pragma unroll
    for (int o = 1; o < 64; o <<= 1) { const float u = __shfl_up(q, o); if (lane >= o) q = fmaxf(q, u); }
    const float ex = __shfl_up(q, 1);
    m1 = q; m0 = lane == 0 ? g0 : fmaxf(ex, g0);
}

struct MStage { f32x4 cw[4]; f32x4 cb; f32x4 wq[4], wk[4], wv[4]; v2u xr[11]; };
template <bool FULL>
__device__ __forceinline__ void mlstm_stage_load(ArgsP a, int L, int h, int t0, int s0, int tid, MStage& R) {
    if (tid < 384) {
        const bf16* proj = (const bf16*)(a->ws + WS_PROJ);
        const int blk = tid % 24, rg = tid / 24, l0 = rg * 8;
        const int ch0 = h * 96 + blk * 4, nb = h * 24 + blk;
#pragma unroll
        for (int r = 0; r < 11; ++r) { const int l = l0 - 3 + r;
            if (s0 + l >= 0) R.xr[r] = *(const v2u*)(proj + (size_t)(t0 + l) * NP + PC_MX + ch0); else R.xr[r] = (v2u){0u, 0u}; }
#pragma unroll
        for (int j = 0; j < 4; ++j) R.cw[j] = *(const f32x4*)(a->in[I_CONVW] + (size_t)L * 4 * 384 + j * 384 + ch0);
        R.cb = *(const f32x4*)(a->in[I_CONVB] + (size_t)L * 384 + ch0);
#pragma unroll
        for (int i = 0; i < 4; ++i) {
            R.wk[i] = *(const f32x4*)(a->in[I_WK] + ((size_t)L * 96 + nb) * 16 + i * 4);
            R.wv[i] = *(const f32x4*)(a->in[I_WV] + ((size_t)L * 96 + nb) * 16 + i * 4);
            if (FULL) R.wq[i] = *(const f32x4*)(a->in[I_WQ] + ((size_t)L * 96 + nb) * 16 + i * 4);
        }
    }
}
template <bool FULL>
__device__ __forceinline__ void mlstm_stage_compute(const MStage& R, ldsp XC, ldsp Q, ldsp K, ldsp VT, const LAS float* eend, int tid) {
    if (tid < 384) {
        const int blk = tid % 24, rg = tid / 24, l0 = rg * 8;
        f32x4 xm[11];
#pragma unroll
        for (int r = 0; r < 11; ++r) xm[r] = (f32x4){bflo(R.xr[r].x), bfhi(R.xr[r].x), bflo(R.xr[r].y), bfhi(R.xr[r].y)};
        const float kscale = 0.10206207261596575f;
        unsigned vpk[4][4], kpk[4][4];
        float vprev[4], kprev[4];
#pragma unroll
        for (int li = 0; li < 8; ++li) {
            f32x4 xc = R.cb;
#pragma unroll
            for (int j = 0; j < 4; ++j) xc = xc + R.cw[j] * xm[li + j];
            { const f32x2 s01 = silu2((f32x2){xc.x, xc.y}), s23 = silu2((f32x2){xc.z, xc.w}); xc = (f32x4){s01.x, s01.y, s23.x, s23.y}; }
            const f32x4 xr = xm[li + 3];
            f32x4 kk = (xc.x * R.wk[0] + xc.y * R.wk[1]) + (xc.z * R.wk[2] + xc.w * R.wk[3]);
            const f32x4 vv = (xr.x * R.wv[0] + xr.y * R.wv[1]) + (xr.z * R.wv[2] + xr.w * R.wv[3]);
            const int l = l0 + li;
            if (FULL) {
                const f32x4 qq = (xc.x * R.wq[0] + xc.y * R.wq[1]) + (xc.z * R.wq[2] + xc.w * R.wq[3]);
                kk = kk * kscale;
                *(LAS v2u*)(XC + l * 192 + blk * 8) = (v2u){pk2(xc.x, xc.y), pk2(xc.z, xc.w)};
                *(LAS v2u*)(Q + l * 208 + blk * 8) = (v2u){pk2(qq.x, qq.y), pk2(qq.z, qq.w)};
                *(LAS v2u*)(K + l * 208 + blk * 8) = (v2u){pk2(kk.x, kk.y), pk2(kk.z, kk.w)};
            } else {
                kk = kk * (kscale * eend[l]);
            }
            if (li & 1) {
#pragma unroll
                for (int jj = 0; jj < 4; ++jj) { vpk[jj][li >> 1] = pk2(vprev[jj], vv[jj]); if (!FULL) kpk[jj][li >> 1] = pk2(kprev[jj], kk[jj]); }
            } else {
#pragma unroll
                for (int jj = 0; jj < 4; ++jj) { vprev[jj] = vv[jj]; kprev[jj] = kk[jj]; }
            }
        }
#pragma unroll
        for (int jj = 0; jj < 4; ++jj) {
            *(LAS v4u*)(VT + (blk * 4 + jj) * 272 + l0 * 2) = (v4u){vpk[jj][0], vpk[jj][1], vpk[jj][2], vpk[jj][3]};
            if (!FULL) *(LAS v4u*)(K + (blk * 4 + jj) * 272 + l0 * 2) = (v4u){kpk[jj][0], kpk[jj][1], kpk[jj][2], kpk[jj][3]};
        }
    }
}

__device__ __forceinline__ void fill_vt_tail(ldsp VT, int tid) {
    if (tid < 384) return;
    const int i = tid - 384;
#pragma unroll
    for (int r = 0; r < 2; ++r) { const int idx = i + 128 * r;
        const int row = idx >> 4, c16 = idx & 15; unsigned w = row == 0 ? 0x3f803f80u : 0u; asm volatile("" : "+v"(w));
        *(LAS v4u*)(VT + (96 + row) * 272 + c16 * 16) = (v4u){w, w, w, w}; }
}

__device__ __forceinline__ void phaseC_mlstm(ArgsP a, int L, int item, ldsp lds, int tid, int lane, int wave) {
    const int bh = item >> 5, c = item & 31, b = bh >> 2, h = bh & 3;
    const int t0 = b * SEQ + c * 128, s0 = c * 128;
    ldsp EKT = lds, VT = lds + 26112;
    LAS float* eend = (LAS float*)(lds + 56576);
    const float* gates = (const float*)(a->ws + WS_GATES);
    float* scal = (float*)(a->ws + WS_SCAL);
    float i0 = 0.f, i1 = 0.f, f0 = 0.f, f1 = 0.f;
    if (wave == 7) { const float* gp = gates + (size_t)(t0 + 2 * lane) * 8; i0 = gp[h]; f0 = gp[4 + h]; i1 = gp[8 + h]; f1 = gp[12 + h]; }
    MStage R; mlstm_stage_load<false>(a, L, h, t0, s0, tid, R);
    if (wave == 7) {
        float b0, b1; gates_cumsum(f0, f1, b0, b1, lane);
        const float b_end = __shfl(b1, 63);
        const float w0 = b_end - b0 + i0, w1 = b_end - b1 + i1;
        float mx = fmaxf(w0, w1);
#pragma unroll
        for (int o = 1; o < 64; o <<= 1) mx = fmaxf(mx, __shfl_xor(mx, o));
        eend[2 * lane] = __expf(w0 - mx); eend[2 * lane + 1] = __expf(w1 - mx);
        if (lane == 0) { scal[item] = b_end; scal[512 + item] = mx; }
    }
    fill_vt_tail(VT, tid);
    __syncthreads();
    mlstm_stage_compute<false>(R, lds, lds, EKT, VT, eend, tid);
    __syncthreads();
    float* st = (float*)(a->ws + WS_MST) + (size_t)item * NE_M;
    const int fr = lane & 15, fq = lane >> 4;
#pragma unroll
    for (int ti = 0; ti < 6; ++ti) { const int tile = wave + 8 * ti; if (tile >= 42) break;
        const int et = tile / 6, dt = tile % 6;
        f32x4 acc = {0.f, 0.f, 0.f, 0.f};
#pragma unroll
        for (int ks = 0; ks < 4; ++ks) {
            const bf16x8 av = *(const LAS bf16x8*)(VT + (et * 16 + fr) * 272 + ks * 64 + fq * 16);
            const bf16x8 bv = *(const LAS bf16x8*)(EKT + (dt * 16 + fr) * 272 + ks * 64 + fq * 16);
            acc = MFMA16(av, bv, acc);
        }
#pragma unroll
        for (int j = 0; j < 4; ++j) { const int e = et * 16 + fq * 4 + j; if (e < 97) st[e * 96 + dt * 16 + fr] = acc[j]; }
    }
    __syncthreads();
}

__device__ __forceinline__ float ret_log_gamma(int h) { return __logf(1.f - exp2f(-5.f - (float)h)); }

__device__ __forceinline__ void rotary16(const bf16* rowp, const float* cs, const float* sn, int j0, float scale, v4u& o1, v4u& o2) {
    const v4u u1 = *(const v4u*)(rowp + j0), u2 = *(const v4u*)(rowp + 32 + j0);
    const f32x4 c0 = *(const f32x4*)(cs + j0), c1 = *(const f32x4*)(cs + j0 + 4), s0 = *(const f32x4*)(sn + j0), s1 = *(const f32x4*)(sn + j0 + 4);
    float x1[8] = {bflo(u1.x), bfhi(u1.x), bflo(u1.y), bfhi(u1.y), bflo(u1.z), bfhi(u1.z), bflo(u1.w), bfhi(u1.w)};
    float x2[8] = {bflo(u2.x), bfhi(u2.x), bflo(u2.y), bfhi(u2.y), bflo(u2.z), bfhi(u2.z), bflo(u2.w), bfhi(u2.w)};
    float cc[8] = {c0.x, c0.y, c0.z, c0.w, c1.x, c1.y, c1.z, c1.w}, ss[8] = {s0.x, s0.y, s0.z, s0.w, s1.x, s1.y, s1.z, s1.w};
    float y1[8], y2[8];
#pragma unroll
    for (int i = 0; i < 8; ++i) { y1[i] = (x1[i] * cc[i] - x2[i] * ss[i]) * scale; y2[i] = (x2[i] * cc[i] + x1[i] * ss[i]) * scale; }
    o1 = (v4u){pk2(y1[0], y1[1]), pk2(y1[2], y1[3]), pk2(y1[4], y1[5]), pk2(y1[6], y1[7])};
    o2 = (v4u){pk2(y2[0], y2[1]), pk2(y2[2], y2[3]), pk2(y2[4], y2[5]), pk2(y2[6], y2[7])};
}

__device__ __forceinline__ void store_T8(ldsp dst, int e0, int stride, int l, v4u u) {
    const unsigned w[4] = {u.x, u.y, u.z, u.w};
#pragma unroll
    for (int i = 0; i < 4; ++i) {
        *(LAS unsigned short*)(dst + (e0 + 2 * i) * stride + l * 2) = (unsigned short)(w[i] & 0xffffu);
        *(LAS unsigned short*)(dst + (e0 + 2 * i + 1) * stride + l * 2) = (unsigned short)(w[i] >> 16);
    }
}

__device__ __forceinline__ void phaseC_ret(ArgsP a, int L, int item, ldsp lds, int tid, int lane, int wave) {
    const int bh = item >> 5, c = item & 31, b = bh / 6, h = bh % 6;
    const int t0 = b * SEQ + c * 128, s0 = c * 128;
    ldsp ZKT = lds, VT = lds + 17408;
    const bf16* proj = (const bf16*)(a->ws + WS_PROJ);
    const float* rope = (const float*)(a->ws + WS_ROPE);
    const float lg = ret_log_gamma(h);
    {
        const int l = tid >> 2, jc = tid & 3, j0 = jc * 8;
        const float zeta = __expf((127.f - (float)l) * lg);
        v4u o1, o2;
        rotary16(proj + (size_t)(t0 + l) * NP + PC_RK + h * 64, rope + (size_t)(s0 + l) * 32, rope + 4096 * 32 + (size_t)(s0 + l) * 32, j0, 0.125f * zeta, o1, o2);
        store_T8(ZKT, j0, 272, l, o1); store_T8(ZKT, 32 + j0, 272, l, o2);
        const bf16* vp = proj + (size_t)(t0 + l) * NP + PC_RV + h * 64 + jc * 16;
        const v4u v0 = *(const v4u*)vp, v1 = *(const v4u*)(vp + 8);
        store_T8(VT, jc * 16, 272, l, v0); store_T8(VT, jc * 16 + 8, 272, l, v1);
    }
    __syncthreads();
    float* st = (float*)(a->ws + WS_RST) + (size_t)item * NE_R;
    const int fr = lane & 15, fq = lane >> 4;
#pragma unroll
    for (int tt = 0; tt < 2; ++tt) {
        const int tile = wave * 2 + tt, et = tile >> 2, dt = tile & 3;
        f32x4 acc = {0.f, 0.f, 0.f, 0.f};
#pragma unroll
        for (int ks = 0; ks < 4; ++ks) {
            const bf16x8 av = *(const LAS bf16x8*)(VT + (et * 16 + fr) * 272 + ks * 64 + fq * 16);
            const bf16x8 bv = *(const LAS bf16x8*)(ZKT + (dt * 16 + fr) * 272 + ks * 64 + fq * 16);
            acc = MFMA16(av, bv, acc);
        }
#pragma unroll
        for (int j = 0; j < 4; ++j) st[(et * 16 + fq * 4 + j) * 64 + dt * 16 + fr] = acc[j];
    }
    __syncthreads();
}

__device__ __forceinline__ void phaseC_gmlp(ArgsP a, int L, int item, ldsp lds, int tid, int lane, int wave) {
    const int gp = item & 1, bc = item >> 1, b = bc >> 5, c = bc & 31;
    const int t0 = b * SEQ + c * 128;
    ldsp W = lds, GVT = lds + 34816;
    const bf16* proj = (const bf16*)(a->ws + WS_PROJ);
    bf16* cat = (bf16*)(a->ws + WS_CAT);
    const int l = tid >> 2, part = tid & 3;
    const bf16* vp = proj + (size_t)(t0 + l) * NP + PC_GV;
    float rstd;
    {
        float ss = 0.f;
#pragma unroll
        for (int i = 0; i < 8; ++i) { const v4u u = *(const v4u*)(vp + part * 64 + i * 8); const unsigned w[4] = {u.x, u.y, u.z, u.w};
#pragma unroll
            for (int q = 0; q < 4; ++q) { const f32x2 g = gelu2((f32x2){bflo(w[q]), bfhi(w[q])}); ss += g.x * g.x + g.y * g.y; } }
        ss += __shfl_xor(ss, 1); ss += __shfl_xor(ss, 2);
        rstd = rsqrtf(ss * (1.f / 256.f) + EPS);
    }
#pragma unroll
    for (int gi = 0; gi < 2; ++gi) {
        const int g = 2 * gp + gi;
        {
            const float* gn = a->in[I_GNG] + (size_t)L * 256 + g * 64 + part * 16;
#pragma unroll
            for (int i = 0; i < 2; ++i) { const v4u u = *(const v4u*)(vp + g * 64 + part * 16 + i * 8); const unsigned w[4] = {u.x, u.y, u.z, u.w}; unsigned o[4];
#pragma unroll
                for (int q = 0; q < 4; ++q) { const f32x2 gg = gelu2((f32x2){bflo(w[q]), bfhi(w[q])}) * rstd; o[q] = pk2(gg.x * gn[i * 8 + 2 * q], gg.y * gn[i * 8 + 2 * q + 1]); }
                store_T8(GVT, part * 16 + i * 8, 272, l, (v4u){o[0], o[1], o[2], o[3]}); }
        }
        {
            const float* wsrc = a->in[I_GWS] + ((size_t)L * 4 + g) * 128 * 128;
#pragma unroll
            for (int i = 0; i < 8; ++i) { const int idx4 = tid + 512 * i, t = idx4 >> 5, s4 = (idx4 & 31) * 4;
                f32x4 w = *(const f32x4*)(wsrc + (size_t)t * 128 + s4);
                if (s4 + 0 > t) w.x = 0.f; if (s4 + 1 > t) w.y = 0.f; if (s4 + 2 > t) w.z = 0.f; if (s4 + 3 > t) w.w = 0.f;
                *(LAS v2u*)(W + t * 272 + s4 * 2) = (v2u){pk2(w.x, w.y), pk2(w.z, w.w)}; }
        }
        __syncthreads();
        const int fr = lane & 15, fq = lane >> 4;
        const float* bs = a->in[I_GBS] + ((size_t)L * 4 + g) * 128;
        float bbv[4]; unsigned short uv[4][4];
#pragma unroll
        for (int j = 0; j < 4; ++j) { bbv[j] = bs[wave * 16 + fq * 4 + j];
#pragma unroll
            for (int n = 0; n < 4; ++n) uv[j][n] = proj[(size_t)(t0 + wave * 16 + fq * 4 + j) * NP + PC_GU + g * 64 + n * 16 + fr]; }
        f32x4 acc[4];
#pragma unroll
        for (int n = 0; n < 4; ++n) acc[n] = (f32x4){0.f, 0.f, 0.f, 0.f};
#pragma unroll
        for (int ks = 0; ks < 4; ++ks) {
            if (ks * 32 <= wave * 16 + 15) {
                const bf16x8 av = *(const LAS bf16x8*)(W + (wave * 16 + fr) * 272 + ks * 64 + fq * 16);
#pragma unroll
                for (int n = 0; n < 4; ++n) { const bf16x8 bv = *(const LAS bf16x8*)(GVT + (n * 16 + fr) * 272 + ks * 64 + fq * 16); acc[n] = MFMA16(av, bv, acc[n]); }
            }
        }
#pragma unroll
        for (int j = 0; j < 4; ++j) { const int t = wave * 16 + fq * 4 + j; const float bb = bbv[j];
#pragma unroll
            for (int n = 0; n < 4; n += 2) { const int e = n * 16 + fr;
                const f32x2 gu = gelu2((f32x2){bf2f(uv[j][n]), bf2f(uv[j][n + 1])});
                cat[(size_t)(t0 + t) * DM + CAT_G + g * 64 + e] = f2bf(gu.x * (acc[n][j] + bb));
                cat[(size_t)(t0 + t) * DM + CAT_G + g * 64 + e + 16] = f2bf(gu.y * (acc[n + 1][j] + bb)); } }
        __syncthreads();
    }
}

__device__ __forceinline__ void phaseD(ArgsP a, ldsp lds, int tid) {
    LAS float* so = (LAS float*)lds; LAS float* sn = so + 512;
    float* scal = (float*)(a->ws + WS_SCAL);
    const int gt = blockIdx.x * NTHR + tid, NT = gridDim.x * NTHR;
    constexpr int TOT_M = 16 * NE_M, TOT_R = 24 * NE_R;
    float v0[32]; float* p0 = nullptr; int bh0 = 0; float dec0 = 0.f; const bool m0 = gt < TOT_M;
    if (m0) { bh0 = gt / NE_M; p0 = (float*)(a->ws + WS_MST) + (size_t)bh0 * NCH * NE_M + (gt - bh0 * NE_M);
#pragma unroll
        for (int c = 0; c < 32; ++c) v0[c] = p0[(size_t)c * NE_M];
    } else if (gt < TOT_M + TOT_R) { const int j = gt - TOT_M; bh0 = j >> 12; dec0 = __expf(128.f * ret_log_gamma(bh0 % 6)); p0 = (float*)(a->ws + WS_RST) + (size_t)bh0 * NCH * NE_R + (j & 4095);
#pragma unroll
        for (int c = 0; c < 32; ++c) v0[c] = p0[(size_t)c * NE_R];
    }
    if (tid < 16) {
        float be[32], ac[32];
#pragma unroll
        for (int c = 0; c < 32; ++c) { be[c] = scal[tid * 32 + c]; ac[c] = scal[512 + tid * 32 + c]; }
        float m = 0.f;
#pragma unroll
        for (int c = 0; c < 32; ++c) { const float mn = fmaxf(be[c] + m, ac[c]); so[tid * 32 + c] = __expf(be[c] + m - mn); sn[tid * 32 + c] = __expf(ac[c] - mn);
            if (blockIdx.x == 0) scal[1024 + tid * 32 + c] = m; m = mn; }
    }
    __syncthreads();
    if (p0 != nullptr) {
        float st = 0.f;
        if (m0) {
#pragma unroll
            for (int c = 0; c < 32; ++c) { p0[(size_t)c * NE_M] = st; st = so[bh0 * 32 + c] * st + sn[bh0 * 32 + c] * v0[c]; }
        } else {
#pragma unroll
            for (int c = 0; c < 32; ++c) { p0[(size_t)c * NE_R] = st; st = dec0 * st + v0[c]; }
        }
    }
    for (int idx = gt + NT; idx < TOT_M + TOT_R; idx += NT) {
        float v[32];
        if (idx < TOT_M) {
            const int bh = idx / NE_M, e = idx - bh * NE_M;
            float* p = (float*)(a->ws + WS_MST) + (size_t)bh * NCH * NE_M + e;
#pragma unroll
            for (int c = 0; c < 32; ++c) v[c] = p[(size_t)c * NE_M];
            float st = 0.f;
#pragma unroll
            for (int c = 0; c < 32; ++c) { p[(size_t)c * NE_M] = st; st = so[bh * 32 + c] * st + sn[bh * 32 + c] * v[c]; }
        } else {
            const int j = idx - TOT_M, bh = j >> 12, e = j & 4095, h = bh % 6;
            const float dec = __expf(128.f * ret_log_gamma(h));
            float* p = (float*)(a->ws + WS_RST) + (size_t)bh * NCH * NE_R + e;
#pragma unroll
            for (int c = 0; c < 32; ++c) v[c] = p[(size_t)c * NE_R];
            float st = 0.f;
#pragma unroll
            for (int c = 0; c < 32; ++c) { p[(size_t)c * NE_R] = st; st = dec * st + v[c]; }
        }
    }
    __syncthreads();
}

__device__ __forceinline__ void phaseE_mlstm(ArgsP a, int L, int item, ldsp lds, int tid, int lane, int wave) {
    const int bh = item >> 5, c = item & 31, b = bh >> 2, h = bh & 3;
    const int t0 = b * SEQ + c * 128, s0 = c * 128;
    ldsp XC = lds, Q = lds + 24576, K = lds + 51200, VT = lds + 77824, SC = lds + 108288, CT = SC;
    LAS float* fl = (LAS float*)(lds + 143104);
    LAS float* bcum = fl, *gsv = fl + 256, *mmv = fl + 384;
    const float* gates = (const float*)(a->ws + WS_GATES);
    const float* scal = (const float*)(a->ws + WS_SCAL);
    const bf16* proj = (const bf16*)(a->ws + WS_PROJ);
    bf16* cat = (bf16*)(a->ws + WS_CAT);
    const float m_prev = scal[1024 + item];
    float i0 = 0.f, i1 = 0.f, f0 = 0.f, f1 = 0.f;
    if (wave == 7) { const float* gp = gates + (size_t)(t0 + 2 * lane) * 8; i0 = gp[h]; f0 = gp[4 + h]; i1 = gp[8 + h]; f1 = gp[12 + h]; }
    MStage R; mlstm_stage_load<true>(a, L, h, t0, s0, tid, R);
    f32x4 ctv[6];
    {   const float* st = (const float*)(a->ws + WS_MST) + (size_t)item * NE_M;
#pragma unroll
        for (int i = 0; i < 6; ++i) { const int idx4 = tid + 512 * i, e = idx4 / 24, d4 = (idx4 % 24) * 4;
            ctv[i] = (f32x4){0.f, 0.f, 0.f, 0.f}; if (e < 97) ctv[i] = *(const f32x4*)(st + e * 96 + d4); } }
    if (wave == 7) {
        float b0, b1; gates_cumsum(f0, f1, b0, b1, lane);
        const float g0 = i0 - b0, g1 = i1 - b1; float p0, p1; gates_prefmax(g0, g1, p0, p1, lane);
        bcum[2 * lane] = b0; bcum[2 * lane + 1] = b1; gsv[2 * lane] = g0; gsv[2 * lane + 1] = g1;
        mmv[2 * lane] = fmaxf(m_prev, p0); mmv[2 * lane + 1] = fmaxf(m_prev, p1);
    }
    mlstm_stage_compute<true>(R, XC, Q, K, VT, nullptr, tid);
    fill_vt_tail(VT, tid);
#pragma unroll
    for (int i = 0; i < 6; ++i) { const int idx4 = tid + 512 * i, e = idx4 / 24, d4 = (idx4 % 24) * 4;
        if (idx4 < 112 * 24) *(LAS v2u*)(CT + e * 208 + d4 * 2) = (v2u){pk2(ctv[i].x, ctv[i].y), pk2(ctv[i].z, ctv[i].w)}; }
    __syncthreads();
    const int fr = lane & 15, fq = lane >> 4;
    const float* mng = a->in[I_MNG] + (size_t)L * 384 + h * 96;
    const float* skp = a->in[I_SKIP] + (size_t)L * 384 + h * 96;
    float gcol[6], scol[6];
#pragma unroll
    for (int n = 0; n < 6; ++n) { gcol[n] = mng[n * 16 + fr]; scol[n] = skp[n * 16 + fr]; }
    v4u zc[3];
#pragma unroll
    for (int i = 0; i < 3; ++i) { const int q = lane + 64 * i, r = q / 12, cc = q % 12; zc[i] = *(const v4u*)(proj + (size_t)(t0 + wave * 16 + r) * NP + PC_MZ + h * 96 + cc * 8); }
    bf16x8 aq[3];
#pragma unroll
    for (int ks = 0; ks < 3; ++ks) aq[ks] = *(const LAS bf16x8*)(Q + (wave * 16 + fr) * 208 + ks * 64 + fq * 16);
    f32x4 acc2[7];
#pragma unroll
    for (int n = 0; n < 7; ++n) { acc2[n] = (f32x4){0.f, 0.f, 0.f, 0.f};
#pragma unroll
        for (int ks = 0; ks < 3; ++ks) { const bf16x8 bv = *(const LAS bf16x8*)(CT + (n * 16 + fr) * 208 + ks * 64 + fq * 16); acc2[n] = MFMA16(aq[ks], bv, acc2[n]); } }
    f32x4 sacc[8];
#pragma unroll
    for (int st = 0; st < 8; ++st) { sacc[st] = (f32x4){0.f, 0.f, 0.f, 0.f};
        if (st <= wave) {
#pragma unroll
            for (int ks = 0; ks < 3; ++ks) { const bf16x8 bv = *(const LAS bf16x8*)(K + (st * 16 + fr) * 208 + ks * 64 + fq * 16); sacc[st] = MFMA16(aq[ks], bv, sacc[st]); } } }
    float mmr[4];
#pragma unroll
    for (int j = 0; j < 4; ++j) mmr[j] = mmv[wave * 16 + fq * 4 + j];
    __syncthreads();
#pragma unroll
    for (int st = 0; st < 8; ++st) {
        if (st <= (wave | 1)) {
            const int s = st * 16 + fr; const float gsl = gsv[s];
#pragma unroll
            for (int j = 0; j < 4; ++j) { const int l = wave * 16 + fq * 4 + j;
                const float wgt = (s <= l) ? __expf(gsl - mmr[j]) : 0.f;
                *(LAS unsigned short*)(SC + l * 272 + s * 2) = f2bf(sacc[st][j] * wgt); }
        }
    }
    asm volatile("" ::: "memory");
    f32x4 acc1[7];
#pragma unroll
    for (int n = 0; n < 7; ++n) acc1[n] = (f32x4){0.f, 0.f, 0.f, 0.f};
#pragma unroll
    for (int ks = 0; ks < 4; ++ks) {
        if (ks * 2 <= wave) {
            const bf16x8 av = *(const LAS bf16x8*)(SC + (wave * 16 + fr) * 272 + ks * 64 + fq * 16);
#pragma unroll
            for (int n = 0; n < 7; ++n) { const bf16x8 bv = *(const LAS bf16x8*)(VT + (n * 16 + fr) * 272 + ks * 64 + fq * 16); acc1[n] = MFMA16(av, bv, acc1[n]); }
        }
    }
#pragma unroll
    for (int i = 0; i < 3; ++i) { const int q = lane + 64 * i, r = q / 12, cc = q % 12; *(LAS v4u*)(Q + (wave * 16 + r) * 208 + cc * 16) = zc[i]; }
#pragma unroll
    for (int j = 0; j < 4; ++j) {
        const int l = wave * 16 + fq * 4 + j;
        const float sint = __expf(m_prev - mmr[j]);
        float den = acc1[6][j] + sint * acc2[6][j];
        den = __shfl(den, lane & 48);
        const float flo = __expf(-(bcum[l] + mmr[j]));
        const float inv = fast_rcp(fmaxf(fabsf(den), flo));
        float hv[6]; float ss = 0.f;
#pragma unroll
        for (int n = 0; n < 6; ++n) { hv[n] = (acc1[n][j] + sint * acc2[n][j]) * inv; ss += hv[n] * hv[n]; }
        ss += __shfl_xor(ss, 1); ss += __shfl_xor(ss, 2); ss += __shfl_xor(ss, 4); ss += __shfl_xor(ss, 8);
        const float rstd = rsqrtf(ss * (1.f / 96.f) + EPS);
#pragma unroll
        for (int n = 0; n < 6; n += 2) { const int e = n * 16 + fr;
            const float xc0 = bf2f(*(const LAS unsigned short*)(XC + l * 192 + e * 2)), xc1 = bf2f(*(const LAS unsigned short*)(XC + l * 192 + (e + 16) * 2));
            const f32x2 sz = silu2((f32x2){bf2f(*(const LAS unsigned short*)(Q + l * 208 + e * 2)), bf2f(*(const LAS unsigned short*)(Q + l * 208 + (e + 16) * 2))});
            *(LAS unsigned short*)(SC + l * 272 + e * 2) = f2bf((hv[n] * rstd * gcol[n] + scol[n] * xc0) * sz.x);
            *(LAS unsigned short*)(SC + l * 272 + (e + 16) * 2) = f2bf((hv[n + 1] * rstd * gcol[n + 1] + scol[n + 1] * xc1) * sz.y); }
    }
#pragma unroll
    for (int i = 0; i < 3; ++i) { const int q = lane + 64 * i, r = q / 12, cc = q % 12;
        *(v4u*)(cat + (size_t)(t0 + wave * 16 + r) * DM + h * 96 + cc * 8) = *(const LAS v4u*)(SC + (wave * 16 + r) * 272 + cc * 16); }
    __syncthreads();
}

__device__ __forceinline__ void phaseE_ret(ArgsP a, int L, int item, ldsp lds, int tid, int lane, int wave) {
    const int bh = item >> 5, c = item & 31, b = bh / 6, h = bh % 6;
    const int t0 = b * SEQ + c * 128, s0 = c * 128;
    ldsp Q = lds, K = lds + 18432, VT = lds + 36864, SC = lds + 54272, RT = lds + 89088;
    const bf16* proj = (const bf16*)(a->ws + WS_PROJ);
    const float* rope = (const float*)(a->ws + WS_ROPE);
    bf16* cat = (bf16*)(a->ws + WS_CAT);
    const float lg = ret_log_gamma(h);
    {
        const int l = tid >> 2, jc = tid & 3, j0 = jc * 8;
        const float* cs = rope + (size_t)(s0 + l) * 32; const float* sn = rope + 4096 * 32 + (size_t)(s0 + l) * 32;
        v4u o1, o2;
        rotary16(proj + (size_t)(t0 + l) * NP + PC_RQ + h * 64, cs, sn, j0, 1.f, o1, o2);
        *(LAS v4u*)(Q + l * 144 + j0 * 2) = o1; *(LAS v4u*)(Q + l * 144 + (32 + j0) * 2) = o2;
        rotary16(proj + (size_t)(t0 + l) * NP + PC_RK + h * 64, cs, sn, j0, 0.125f, o1, o2);
        *(LAS v4u*)(K + l * 144 + j0 * 2) = o1; *(LAS v4u*)(K + l * 144 + (32 + j0) * 2) = o2;
        const bf16* vp = proj + (size_t)(t0 + l) * NP + PC_RV + h * 64 + jc * 16;
        const v4u v0 = *(const v4u*)vp, v1 = *(const v4u*)(vp + 8);
        store_T8(VT, jc * 16, 272, l, v0); store_T8(VT, jc * 16 + 8, 272, l, v1);
        const float* st = (const float*)(a->ws + WS_RST) + (size_t)item * NE_R;
#pragma unroll
        for (int i = 0; i < 2; ++i) { const int idx4 = tid + 512 * i, e = idx4 >> 4, d4 = (idx4 & 15) * 4;
            const f32x4 w = *(const f32x4*)(st + e * 64 + d4);
            *(LAS v2u*)(RT + e * 144 + d4 * 2) = (v2u){pk2(w.x, w.y), pk2(w.z, w.w)}; }
    }
    __syncthreads();
    const int fr = lane & 15, fq = lane >> 4;
    const float* rng = a->in[I_RNG] + (size_t)L * 384 + h * 64;
    float gcol[4];
#pragma unroll
    for (int n = 0; n < 4; ++n) gcol[n] = rng[n * 16 + fr];
    v4u gc[2];
#pragma unroll
    for (int i = 0; i < 2; ++i) { const int q = lane + 64 * i, r = q >> 3, cc = q & 7; gc[i] = *(const v4u*)(proj + (size_t)(t0 + wave * 16 + r) * NP + PC_RG + h * 64 + cc * 8); }
    bf16x8 aq[2];
#pragma unroll
    for (int ks = 0; ks < 2; ++ks) aq[ks] = *(const LAS bf16x8*)(Q + (wave * 16 + fr) * 144 + ks * 64 + fq * 16);
    f32x4 acc2[4];
#pragma unroll
    for (int n = 0; n < 4; ++n) { acc2[n] = (f32x4){0.f, 0.f, 0.f, 0.f};
#pragma unroll
        for (int ks = 0; ks < 2; ++ks) { const bf16x8 bv = *(const LAS bf16x8*)(RT + (n * 16 + fr) * 144 + ks * 64 + fq * 16); acc2[n] = MFMA16(aq[ks], bv, acc2[n]); } }
    f32x4 sacc[8];
#pragma unroll
    for (int st = 0; st < 8; ++st) { sacc[st] = (f32x4){0.f, 0.f, 0.f, 0.f};
        if (st <= wave) {
#pragma unroll
            for (int ks = 0; ks < 2; ++ks) { const bf16x8 bv = *(const LAS bf16x8*)(K + (st * 16 + fr) * 144 + ks * 64 + fq * 16); sacc[st] = MFMA16(aq[ks], bv, sacc[st]); } } }
    float rowf[4];
#pragma unroll
    for (int j = 0; j < 4; ++j) rowf[j] = __expf((float)(fq * 4 + j - fr) * lg);
#pragma unroll
    for (int st = 0; st < 8; ++st) {
        if (st <= (wave | 1)) {
            const int s = st * 16 + fr; const float tf = __expf((float)((wave - st) * 16) * lg);
#pragma unroll
            for (int j = 0; j < 4; ++j) { const int l = wave * 16 + fq * 4 + j;
                const float wgt = (s <= l) ? rowf[j] * tf : 0.f;
                *(LAS unsigned short*)(SC + l * 272 + s * 2) = f2bf(sacc[st][j] * wgt); }
        }
    }
    asm volatile("" ::: "memory");
    f32x4 acc1[4];
#pragma unroll
    for (int n = 0; n < 4; ++n) acc1[n] = (f32x4){0.f, 0.f, 0.f, 0.f};
#pragma unroll
    for (int ks = 0; ks < 4; ++ks) {
        if (ks * 2 <= wave) {
            const bf16x8 av = *(const LAS bf16x8*)(SC + (wave * 16 + fr) * 272 + ks * 64 + fq * 16);
#pragma unroll
            for (int n = 0; n < 4; ++n) { const bf16x8 bv = *(const LAS bf16x8*)(VT + (n * 16 + fr) * 272 + ks * 64 + fq * 16); acc1[n] = MFMA16(av, bv, acc1[n]); }
        }
    }
#pragma unroll
    for (int i = 0; i < 2; ++i) { const int q = lane + 64 * i, r = q >> 3, cc = q & 7; *(LAS v4u*)(Q + (wave * 16 + r) * 144 + cc * 16) = gc[i]; }
#pragma unroll
    for (int j = 0; j < 4; ++j) {
        const int l = wave * 16 + fq * 4 + j;
        const float xi = __expf((float)(l + 1) * lg);
        float hv[4]; float ss = 0.f;
#pragma unroll
        for (int n = 0; n < 4; ++n) { hv[n] = acc1[n][j] + xi * acc2[n][j]; ss += hv[n] * hv[n]; }
        ss += __shfl_xor(ss, 1); ss += __shfl_xor(ss, 2); ss += __shfl_xor(ss, 4); ss += __shfl_xor(ss, 8);
        const float rstd = rsqrtf(ss * (1.f / 64.f) + EPS);
#pragma unroll
        for (int n = 0; n < 4; n += 2) { const int e = n * 16 + fr;
            const f32x2 sg = silu2((f32x2){bf2f(*(const LAS unsigned short*)(Q + l * 144 + e * 2)), bf2f(*(const LAS unsigned short*)(Q + l * 144 + (e + 16) * 2))});
            *(LAS unsigned short*)(SC + l * 272 + e * 2) = f2bf(hv[n] * rstd * gcol[n] * sg.x);
            *(LAS unsigned short*)(SC + l * 272 + (e + 16) * 2) = f2bf(hv[n + 1] * rstd * gcol[n + 1] * sg.y); }
    }
#pragma unroll
    for (int i = 0; i < 2; ++i) { const int q = lane + 64 * i, r = q >> 3, cc = q & 7;
        *(v4u*)(cat + (size_t)(t0 + wave * 16 + r) * DM + CAT_R + h * 64 + cc * 8) = *(const LAS v4u*)(SC + (wave * 16 + r) * 272 + cc * 16); }
    __syncthreads();
}


template <int PER> struct GemvPre { static constexpr int CH = PER < 32 ? PER : 32; float w[CH]; };
template <int PER>
__device__ __forceinline__ void gemv4_preload(const float* W, int ldw, int ncol0, int nvalid, int kb, int tid, GemvPre<PER>& P) {
    const int kq = tid >> 5, c = tid & 31, k0 = kq * PER;
    const float* wp = W + (size_t)(kb + k0) * ldw + ncol0 + (c < nvalid ? c : 0);
#pragma unroll
    for (int i = 0; i < GemvPre<PER>::CH; ++i) P.w[i] = wp[(size_t)i * ldw];
}
template <int MODE, int PER>
__device__ __forceinline__ void gemv4_item(const LAS float* A, const float* W, int ldw, int ncol0, int nvalid, int kb, float* out, int ldo, int ocol0, LAS float* red, int tid, const GemvPre<PER>& P) {
    constexpr int klen = PER * 16, CH = PER < 32 ? PER : 32;
    const int kq = tid >> 5, c = tid & 31, k0 = kq * PER;
    float acc[4] = {0.f, 0.f, 0.f, 0.f};
    if (c < nvalid) {
        const float* wp = W + (size_t)(kb + k0) * ldw + ncol0 + c;
#pragma unroll
        for (int kk = 0; kk < PER; kk += CH) {
            float w[CH];
#pragma unroll
            for (int i = 0; i < CH; ++i) w[i] = (kk == 0) ? P.w[i] : wp[(size_t)(kk + i) * ldw];
#pragma unroll
            for (int i = 0; i < CH; ++i)
#pragma unroll
                for (int r = 0; r < 4; ++r) acc[r] += A[r * klen + k0 + kk + i] * w[i];
        }
    }
#pragma unroll
    for (int r = 0; r < 4; ++r) red[(kq * 4 + r) * 32 + c] = acc[r];
    __syncthreads();
    if (tid < 128) { const int r = tid >> 5; float s = 0.f;
#pragma unroll
        for (int q = 0; q < 16; ++q) s += red[(q * 4 + r) * 32 + c];
        if (c < nvalid) { float* o = out + (size_t)r * ldo + ocol0 + c;
            if (MODE == 0) *o = s; else if (MODE == 1) { const float t = fmaxf(s, 0.f); *o = t * t; } else atomicAdd(o, s); } }
    __syncthreads();
}
__device__ __forceinline__ void precise_norm_to_lds(const float* x0, size_t row_stride, const float* g, LAS float* A, int lane, int wave) {
    if (wave < 4) { const f32x4* xr = (const f32x4*)(x0 + (size_t)wave * row_stride) + lane; f32x4 v[4]; float ss = 0.f;
#pragma unroll
        for (int j = 0; j < 4; ++j) { v[j] = xr[64 * j]; ss += (v[j].x * v[j].x + v[j].y * v[j].y) + (v[j].z * v[j].z + v[j].w * v[j].w); }
        const float rstd = rsqrtf(wave_sum(ss) * (1.f / DM) + EPS);
#pragma unroll
        for (int j = 0; j < 4; ++j) { const f32x4 gv = ((const f32x4*)g)[lane + 64 * j]; *(LAS f32x4*)(A + wave * 1024 + 4 * lane + 256 * j) = v[j] * rstd * gv; } }
    __syncthreads();
}
__device__ __forceinline__ void lds_copy_rows(const float* src, int ld, int kb, int klen, LAS float* A, int tid) {
    for (int i = tid; i < 4 * klen; i += NTHR) { const int r = i / klen, k = i - r * klen; A[i] = src[(size_t)r * ld + kb + k]; }
    __syncthreads();
}
__device__ __forceinline__ void precise_mixer(ArgsP a, int L, int b, ldsp lds, int tid, int lane, int wave) {
    LAS float* XC = (LAS float*)lds, *XM = XC + 384, *Qs = XC + 768, *Ks = XC + 1152, *Vs = XC + 1536;
    const float* projP = (const float*)(a->ws + WS_PROJP); float* catP = (float*)(a->ws + WS_CATP);
    {
        const float* p = projP + (size_t)b * N_IN; float* o = catP + (size_t)b * DM;
        if (tid < 384) { const float x = p[tid]; XM[tid] = x; XC[tid] = silu_f(a->in[I_CONVW][(size_t)L * 4 * 384 + 3 * 384 + tid] * x + a->in[I_CONVB][(size_t)L * 384 + tid]); }
        __syncthreads();
        if (tid < 384) { const int nb = tid >> 2, j = tid & 3; float q = 0.f, k = 0.f, v = 0.f;
#pragma unroll
            for (int i = 0; i < 4; ++i) { const size_t wi = ((size_t)L * 96 + nb) * 16 + i * 4 + j; q += XC[nb * 4 + i] * a->in[I_WQ][wi]; k += XC[nb * 4 + i] * a->in[I_WK][wi]; v += XM[nb * 4 + i] * a->in[I_WV][wi]; }
            Qs[tid] = q; Ks[tid] = k * 0.10206207261596575f; Vs[tid] = v; }
        __syncthreads();
        if (wave < 4) {
            const int h = wave; const int d0 = h * 96 + lane, d1 = h * 96 + 64 + lane; const bool two = lane < 32;
            float s = Qs[d0] * Ks[d0] + (two ? Qs[d1] * Ks[d1] : 0.f); s = wave_sum(s);
            const float ig = p[768 + h] + a->in[I_IB][L * 4 + h], f = p[772 + h] + a->in[I_FB][L * 4 + h];
            const float logf = fminf(f, 0.f) - __logf(1.f + __expf(-fabsf(f)));
            const float mt = fmaxf(logf, ig), wts = __expf(ig - mt), den = s * wts, inv = 1.f / fmaxf(fabsf(den), __expf(-mt));
            const float h0 = den * Vs[d0] * inv, h1 = two ? den * Vs[d1] * inv : 0.f;
            const float rstd = rsqrtf(wave_sum(h0 * h0 + h1 * h1) * (1.f / 96.f) + EPS);
            const float* mg = a->in[I_MNG] + (size_t)L * 384; const float* sk = a->in[I_SKIP] + (size_t)L * 384;
            o[d0] = (h0 * rstd * mg[d0] + sk[d0] * XC[d0]) * silu_f(p[384 + d0]);
            if (two) o[d1] = (h1 * rstd * mg[d1] + sk[d1] * XC[d1]) * silu_f(p[384 + d1]);
        } else {
            for (int h = wave - 4; h < 6; h += 4) { const int d = h * 64 + lane;
                const float s = wave_sum(p[776 + d] * p[1160 + d]) * 0.125f; const float val = s * p[1544 + d];
                const float rstd = rsqrtf(wave_sum(val * val) * (1.f / 64.f) + EPS);
                o[CAT_R + d] = val * rstd * a->in[I_RNG][(size_t)L * 384 + d] * silu_f(p[1928 + d]); }
        }
        if (wave < 4) {
            const int g = wave; float gl[4]; float ss = 0.f;
#pragma unroll
            for (int i = 0; i < 4; ++i) { gl[i] = gelu_tanh(p[2568 + lane + 64 * i]); ss += gl[i] * gl[i]; }
            const float rstd = rsqrtf(wave_sum(ss) * (1.f / 256.f) + EPS);
            float gv = 0.f;
#pragma unroll
            for (int i = 0; i < 4; ++i) if (i == g) gv = gl[i];
            gv = gv * rstd * a->in[I_GNG][(size_t)L * 256 + g * 64 + lane];
            const float w00 = a->in[I_GWS][((size_t)L * 4 + g) * 128 * 128], b0 = a->in[I_GBS][((size_t)L * 4 + g) * 128];
            o[CAT_G + g * 64 + lane] = gelu_tanh(p[2312 + g * 64 + lane]) * (w00 * gv + b0);
        }
        __syncthreads();
    }
}

__global__ void __launch_bounds__(NTHR, 2) fwd_kernel(Args a_unused) {
    extern __shared__ __attribute__((aligned(16))) unsigned char lds_raw[];
    cg::grid_group grid = cg::this_grid();
    ldsp lds = (ldsp)lds_raw;
#define PHASE_BEGIN() int tid_o = threadIdx.x; asm volatile("" : "+v"(tid_o)); const int tid = tid_o, lane = tid & 63, wave = __builtin_amdgcn_readfirstlane(tid >> 6); (void)lane; (void)wave; \
    ArgsP a = (ArgsP)__builtin_amdgcn_kernarg_segment_ptr(); asm volatile("" : "+s"(a)); unsigned char* ws = a->ws; (void)ws; const int G = gridDim.x; (void)G;
    volatile LAS unsigned* MISC = (volatile LAS unsigned*)(lds + LDS_BYTES - 64);
    if (threadIdx.x < 16) MISC[threadIdx.x] = 0u;
    __syncthreads();
    { ArgsP a = (ArgsP)__builtin_amdgcn_kernarg_segment_ptr(); (void)xcd_barrier_post((unsigned*)(a->ws + WS_CTL), MISC); }
#define GRID_SYNC() do { ArgsP a_b = (ArgsP)__builtin_amdgcn_kernarg_segment_ptr(); asm volatile("" : "+s"(a_b)); XcdBarrier bar_; bar_.bar = (unsigned*)(a_b->ws + WS_CTL); bar_.x = xb_xcc_id(); \
        bar_.st = (volatile LAS unsigned*)(lds + LDS_BYTES - 64); xcd_barrier(bar_); } while (0)

    {
        PHASE_BEGIN();
        float* rope = (float*)(ws + WS_ROPE);
        for (int idx = blockIdx.x * NTHR + tid; idx < 4096 * 32; idx += G * NTHR) {
            const int pos = idx >> 5, j = idx & 31;
            const float freq = exp2f(-(float)j * (13.287712379549449f / 32.f));
            const double ang = (double)pos * (double)freq;
            double rev = ang * 0.15915494309189535; rev -= __builtin_rint(rev);
            const float fr = (float)rev;
            rope[idx] = __builtin_amdgcn_cosf(fr); rope[4096 * 32 + idx] = __builtin_amdgcn_sinf(fr);
        }
        {
            const int gw = blockIdx.x * NWAVES + wave, NGW = G * NWAVES;
            const float* x = a->in[I_X]; bf16* xb = (bf16*)(ws + WS_H); float* ssq = (float*)(ws + WS_SSQ);
            for (int m0 = gw; m0 < MTOK; m0 += 4 * NGW) {
                f32x4 v[4][4];
#pragma unroll
                for (int r = 0; r < 4; ++r) { const int m = m0 + r * NGW; if (m < MTOK) { const f32x4* xr = (const f32x4*)(x + (size_t)m * DM) + lane;
#pragma unroll
                    for (int j = 0; j < 4; ++j) v[r][j] = xr[64 * j]; } }
#pragma unroll
                for (int r = 0; r < 4; ++r) { const int m = m0 + r * NGW; if (m < MTOK) { float ss = 0.f;
#pragma unroll
                    for (int j = 0; j < 4; ++j) ss += (v[r][j].x * v[r][j].x + v[r][j].y * v[r][j].y) + (v[r][j].z * v[r][j].z + v[r][j].w * v[r][j].w);
                    ss = wave_sum(ss);
                    unsigned long long* o8 = (unsigned long long*)(xb + (size_t)m * DM) + lane;
#pragma unroll
                    for (int j = 0; j < 4; ++j) o8[64 * j] = (unsigned long long)pk2(v[r][j].x, v[r][j].y) | ((unsigned long long)pk2(v[r][j].z, v[r][j].w) << 32);
                    if (lane < 16) ssq[(size_t)m * 16 + lane] = lane == 0 ? ss : 0.f; } }
            }
        }
        convert_weights(a, 0, 0, lds, lane, wave);
        if (blockIdx.x == 0) { float* xP = (float*)(ws + WS_XP); for (int i = tid; i < 4 * DM; i += NTHR) xP[i] = a->in[I_X][(size_t)(i >> 10) * SEQ * DM + (i & 1023)]; }
    }
    { ArgsP a = (ArgsP)__builtin_amdgcn_kernarg_segment_ptr(); asm volatile("" : "+s"(a)); if (a->ws == nullptr) grid.sync(); }
    GRID_SYNC();

    for (int L = 0; L < DEPTH; ++L) {
        if ((int)blockIdx.x < 89) {
            PHASE_BEGIN();
            const float* xP = (const float*)(ws + WS_XP);
            LAS float* Ap = (LAS float*)(lds + 100352); LAS float* red = (LAS float*)(lds + 116736);
            { const int cg_ = (int)blockIdx.x; GemvPre<64> gp_;
                gemv4_preload<64>(a->in[I_WIN] + (size_t)L * DM * N_IN, N_IN, cg_ * 32, cg_ == 88 ? 8 : 32, 0, tid, gp_);
                precise_norm_to_lds(L == 0 ? a->in[I_X] : xP, L == 0 ? (size_t)SEQ * DM : (size_t)DM, a->in[I_NMG] + (size_t)L * DM, Ap, lane, wave);
                gemv4_item<0, 64>(Ap, a->in[I_WIN] + (size_t)L * DM * N_IN, N_IN, cg_ * 32, cg_ == 88 ? 8 : 32, 0, (float*)(ws + WS_PROJP), N_IN, cg_ * 32, red, tid, gp_); }
        }
        {
            PHASE_BEGIN();
            const size_t wb = (L & 1) ? WS_WBUF1 : 0;
            pg8::Gemm g{(const bf16*)(ws + WS_H), (const bf16*)(ws + wb + WS_WIN), MTOK, NPAD, DM}; pg8::StaticOrder S; S.init(MTOK, NPAD, G, (int)blockIdx.x);
            pg8::EpiScaledBf16<0> E{(bf16*)(ws + WS_PROJ), NP, (const float*)(ws + WS_SSQ), 11, (float*)(ws + WS_GATES), a->in[I_IB] + L * 4, a->in[I_FB] + L * 4};
            for (int rep = 0; rep < 1 + XREP_B; ++rep) pg8::gemm_phase<pg8::EpiScaledBf16<0>, pg8::StaticOrder, GEMM_ALIGN, GEMM_SP2>(lds, g, S, E);
        }
        GRID_SYNC();
        if ((int)blockIdx.x >= (int)gridDim.x - 4) { PHASE_BEGIN(); precise_mixer(a, L, (int)blockIdx.x - (G - 4), lds, tid, lane, wave); }
        for (int rep = 0; rep < 1 + XREP_C; ++rep)
        for (int it = blockIdx.x; it < 1536; it += gridDim.x) {
            PHASE_BEGIN();
            if (it < 512) phaseC_mlstm(a, L, it, lds, tid, lane, wave);
            else if (it < 1280) phaseC_ret(a, L, it - 512, lds, tid, lane, wave);
            else phaseC_gmlp(a, L, it - 1280, lds, tid, lane, wave);
        }
        GRID_SYNC();
        {
            PHASE_BEGIN();
            phaseD(a, lds, tid);
            if ((int)blockIdx.x < 128) { const int pi = blockIdx.x, cg_ = pi & 31, ks = pi >> 5; LAS float* Ap = (LAS float*)lds; LAS float* red = (LAS float*)(lds + 16384);
                GemvPre<16> gp_; gemv4_preload<16>(a->in[I_WOUT] + (size_t)L * DM * DM, DM, cg_ * 32, 32, ks * 256, tid, gp_);
                lds_copy_rows((const float*)(ws + WS_CATP), DM, ks * 256, 256, Ap, tid);
                gemv4_item<2, 16>(Ap, a->in[I_WOUT] + (size_t)L * DM * DM, DM, cg_ * 32, 32, ks * 256, (float*)(ws + WS_XP), DM, cg_ * 32, red, tid, gp_); }
            if (L + 1 < DEPTH) convert_weights(a, L + 1, ((L + 1) & 1) ? WS_WBUF1 : 0, lds, lane, wave);
        }
        GRID_SYNC();
        for (int rep = 0; rep < 1 + XREP_E; ++rep)
        for (int it = blockIdx.x; it < (rep == 0 ? 1280 + 128 : XREP_E_END); it += gridDim.x) {
            PHASE_BEGIN();
            if (it >= 1280) { const int cg_ = it - 1280; LAS float* Ap = (LAS float*)lds; LAS float* red = (LAS float*)(lds + 16384);
                GemvPre<64> gp_; gemv4_preload<64>(a->in[I_WFF1] + (size_t)L * DM * DFF, DFF, cg_ * 32, 32, 0, tid, gp_);
                precise_norm_to_lds((const float*)(ws + WS_XP), DM, a->in[I_NFG] + (size_t)L * DM, Ap, lane, wave);
                gemv4_item<1, 64>(Ap, a->in[I_WFF1] + (size_t)L * DM * DFF, DFF, cg_ * 32, 32, 0, (float*)(ws + WS_HIDP), DFF, cg_ * 32, red, tid, gp_); continue; }
            if (it < 512) phaseE_mlstm(a, L, it, lds, tid, lane, wave);
            else phaseE_ret(a, L, it - 512, lds, tid, lane, wave);
        }
        GRID_SYNC();
        {
            PHASE_BEGIN();
            const size_t wb = (L & 1) ? WS_WBUF1 : 0;
            pg8::Gemm g{(const bf16*)(ws + WS_CAT), (const bf16*)(ws + wb + WS_WOUT), MTOK, DM, DM}; pg8::StaticOrder S; S.init(MTOK, DM, G, (int)blockIdx.x);
            pg8::EpiResidNorm E{(L == 0) ? a->in[I_X] : a->out, a->out, (bf16*)(ws + WS_H), (float*)(ws + WS_SSQ), nullptr, DM};
            pg8::gemm_phase<pg8::EpiResidNorm, pg8::StaticOrder, true, GEMM_SP2>(lds, g, S, E);
        }
        GRID_SYNC();
        {
            PHASE_BEGIN();
            { const int pi = blockIdx.x, cg_ = pi & 31, ks = pi >> 5; LAS float* Ap = (LAS float*)lds; LAS float* red = (LAS float*)(lds + 16384);
              if (pi < 256) { GemvPre<32> gp_; gemv4_preload<32>(a->in[I_WFF2] + (size_t)L * DFF * DM, DM, cg_ * 32, 32, ks * 512, tid, gp_);
                lds_copy_rows((const float*)(ws + WS_HIDP), DFF, ks * 512, 512, Ap, tid);
                gemv4_item<2, 32>(Ap, a->in[I_WFF2] + (size_t)L * DFF * DM, DM, cg_ * 32, 32, ks * 512, (float*)(ws + WS_XP), DM, cg_ * 32, red, tid, gp_); } }
        }
        {
            PHASE_BEGIN();
            const size_t wb = (L & 1) ? WS_WBUF1 : 0;
            pg8::Gemm g{(const bf16*)(ws + WS_H), (const bf16*)(ws + wb + WS_W1), MTOK, DFF, DM}; pg8::StaticOrder S; S.init(MTOK, DFF, G, (int)blockIdx.x);
            pg8::EpiScaledBf16<2> E{(bf16*)(ws + WS_HID), DFF, (const float*)(ws + WS_SSQ), -1, nullptr, nullptr, nullptr};
            for (int rep = 0; rep < 1 + XREP_H; ++rep) pg8::gemm_phase<pg8::EpiScaledBf16<2>, pg8::StaticOrder, GEMM_ALIGN, GEMM_SP2>(lds, g, S, E);
        }
        GRID_SYNC();
        {
            PHASE_BEGIN();
            const size_t wb = (L & 1) ? WS_WBUF1 : 0;
            pg8::Gemm g{(const bf16*)(ws + WS_HID), (const bf16*)(ws + wb + WS_W2), MTOK, DM, DFF}; pg8::StaticOrder S; S.init(MTOK, DM, G, (int)blockIdx.x);
            const bool lastL = (L == DEPTH - 1);
            pg8::EpiResidNorm E{a->out, a->out, lastL ? (bf16*)nullptr : (bf16*)(ws + WS_H), lastL ? (float*)nullptr : (float*)(ws + WS_SSQ), (const float*)(ws + WS_XP), DM};
            pg8::gemm_phase<pg8::EpiResidNorm, pg8::StaticOrder, true, GEMM_SP2>(lds, g, S, E);
        }
        GRID_SYNC();
    }
    {
        PHASE_BEGIN();
        const int gw = blockIdx.x * NWAVES + wave, NGW = G * NWAVES;
        const float* g = a->in[I_FNG]; const float* xP = (const float*)(ws + WS_XP);
        f32x4 gv[4];
#pragma unroll
        for (int j = 0; j < 4; ++j) gv[j] = ((const f32x4*)g)[lane + 64 * j];
        for (int m0 = gw; m0 < MTOK; m0 += 4 * NGW) {
            f32x4 v[4][4];
#pragma unroll
            for (int r = 0; r < 4; ++r) { const int m = m0 + r * NGW; if (m < MTOK) {
                const f32x4* xs = (m & (SEQ - 1)) == 0 ? (const f32x4*)(xP + (size_t)(m >> 12) * DM) + lane : (const f32x4*)(a->out + (size_t)m * DM) + lane;
#pragma unroll
                for (int j = 0; j < 4; ++j) v[r][j] = xs[64 * j]; } }
#pragma unroll
            for (int r = 0; r < 4; ++r) { const int m = m0 + r * NGW; if (m < MTOK) { float ss = 0.f;
#pragma unroll
                for (int j = 0; j < 4; ++j) ss += (v[r][j].x * v[r][j].x + v[r][j].y * v[r][j].y) + (v[r][j].z * v[r][j].z + v[r][j].w * v[r][j].w);
                const float rstd = rsqrtf(wave_sum(ss) * (1.f / DM) + EPS);
                f32x4* xr = (f32x4*)(a->out + (size_t)m * DM) + lane;
#pragma unroll
                for (int j = 0; j < 4; ++j) xr[64 * j] = v[r][j] * rstd * gv[j]; } }
        }
    }
}

extern "C" void kernel_launch(void* const* d_in, const int* in_sizes, int n_in, void* d_out, int out_size, void* d_ws, size_t ws_size, hipStream_t stream) {
    static int grid = 0;
    if (grid == 0) {
        if (n_in != 21 || out_size != MTOK * DM || ws_size < WS_END) { fprintf(stderr, "kernel_launch: unexpected shapes (n_in %d out %d ws %zu)\n", n_in, out_size, ws_size); grid = -1; return; }
        int dev = 0, cus = 0, per_cu = 0;
        hipGetDevice(&dev);
        hipDeviceGetAttribute(&cus, hipDeviceAttributeMultiprocessorCount, dev);
        if (hipFuncSetAttribute((const void*)fwd_kernel, hipFuncAttributeMaxDynamicSharedMemorySize, LDS_BYTES) != hipSuccess) { fprintf(stderr, "kernel_launch: hipFuncSetAttribute failed\n"); grid = -1; return; }
        if (hipOccupancyMaxActiveBlocksPerMultiprocessor(&per_cu, (const void*)fwd_kernel, NTHR, LDS_BYTES) != hipSuccess || per_cu < 1) { fprintf(stderr, "kernel_launch: occupancy query says %d\n", per_cu); per_cu = 1; }
        (void)hipGetLastError();
        grid = cus;
        fprintf(stderr, "kernel_launch: cus %d per_cu %d grid %d\n", cus, per_cu, grid);
    }
    if (grid < 0) return;
    if (hipMemsetAsync((char*)d_ws + WS_CTL, 0, 16384, stream) != hipSuccess) { fprintf(stderr, "kernel_launch: memset failed\n"); return; }
    Args a{};
    for (int i = 0; i < 21; ++i) a.in[i] = (const float*)d_in[i];
    a.out = (float*)d_out; a.ws = (unsigned char*)d_ws;
    void* args[] = {&a};
    hipError_t e = hipLaunchCooperativeKernel((const void*)fwd_kernel, dim3(grid), dim3(NTHR), args, LDS_BYTES, stream);
    if (e != hipSuccess) fprintf(stderr, "cooperative launch failed: %s (grid %d)\n", hipGetErrorString(e), grid);
}
```
